# Optimizing an MI355X kernel written in HIP

```python
import jax, jax.numpy as jnp
from jax import lax
import numpy as np

D_MODEL = 1024
BATCH = 4
SEQ = 4096
DEPTH = 2

PLE_DIM = 256
R_HEADS = 4
R_DK = 64
R_DV = 128
R_CHUNK = 128
ROPE_BASE = 10000.0
M_HEADS = 4
M_DK = 64
M_DV = 128
M_CHUNK = 64
M_CONV = 4
AB_MIX = R_HEADS * R_DV + M_HEADS * M_DV
AB_SIZES = (R_HEADS * R_DK, R_HEADS * R_DK, R_HEADS * R_DV, R_HEADS * R_DV,
            M_HEADS * M_DK, M_HEADS * M_DK, M_HEADS * M_DV, M_HEADS * M_DV,
            M_HEADS, M_HEADS)
AB_COLS = sum(AB_SIZES)
N_HEADS = 16
N_KV_GROUPS = 2
HEAD_DIM = 64
CMP_BLOCK = 32
CMP_STRIDE = 16
CMP_HIDDEN = 256
SLC_BLOCK = 64
N_SELECT = 16
WINDOW = 512
Q_BLOCK = 128
NSA_SIZES = (N_HEADS * HEAD_DIM,) + (N_KV_GROUPS * HEAD_DIM,) * 6 + (N_HEADS * 3,)
NSA_COLS = sum(NSA_SIZES)
D_FF = 2816
FFN_CONV = 3

NEG = -1e30
BIG = 1e30
EPS = 1e-6

kernel_name = 'hybrid_retnet_mlstm_nsa_convffn'


def rms_norm(x, g):
    xf = x.astype(jnp.float32)
    y = xf * lax.rsqrt(jnp.mean(xf * xf, axis=-1, keepdims=True) + EPS)
    return (y * g.astype(jnp.float32)).astype(x.dtype)


def split_cols(z, sizes):
    return jnp.split(z, np.cumsum(sizes)[:-1].tolist(), axis=-1)


def causal_dwconv(x, w, b):
    K = w.shape[0]
    T = x.shape[1]
    xp = jnp.pad(x, ((0, 0), (K - 1, 0), (0, 0)))
    y = b
    for j in range(K):
        y = y + xp[:, j:j + T] * w[j]
    return y


def to_chunks(x, L):
    B, T = x.shape[:2]
    x = x.reshape((B, T // L, L) + x.shape[2:])
    return jnp.moveaxis(x, (1, 2), (0, 3))


def from_chunks(y):
    y = jnp.moveaxis(y, (0, 3), (1, 2))
    return y.reshape((y.shape[0], y.shape[1] * y.shape[2]) + y.shape[3:])


def rotary(x, pos):
    half = x.shape[-1] // 2
    inv = ROPE_BASE ** (-jnp.arange(half, dtype=jnp.float32) / half)
    ang = pos[:, None] * inv[None, :]
    cos = jnp.cos(ang)[:, None, :]
    sin = jnp.sin(ang)[:, None, :]
    x1, x2 = x[..., :half], x[..., half:]
    return jnp.concatenate([x1 * cos - x2 * sin, x1 * sin + x2 * cos], axis=-1)


def retention_chunkwise(q, k, v):
    B, T, H, DK = q.shape
    DV = v.shape[-1]
    L = R_CHUNK
    log_g = jnp.log1p(-jnp.exp2(-5.0 - jnp.arange(H, dtype=jnp.float32)))
    idx = jnp.arange(L, dtype=jnp.float32)
    diff = idx[:, None] - idx[None, :]
    causal = diff >= 0
    dmask = jnp.where(causal, jnp.exp(jnp.where(causal, diff, 0.0)[None] * log_g[:, None, None]), 0.0)
    q_dec = jnp.exp((idx + 1.0)[None, :] * log_g[:, None])
    k_dec = jnp.exp((L - 1.0 - idx)[None, :] * log_g[:, None])
    c_dec = jnp.exp(L * log_g)

    def step(R, xs):
        qc, kc, vc = xs
        s = jnp.einsum('bhld,bhmd->bhlm', qc, kc) * dmask
        o = (jnp.einsum('bhlm,bhme->bhle', s, vc)
             + jnp.einsum('bhld,bhde->bhle', qc, R) * q_dec[..., None])
        R = c_dec[:, None, None] * R + jnp.einsum('bhmd,bhme->bhde', kc * k_dec[..., None], vc)
        return R, o

    R0 = jnp.zeros((B, H, DK, DV), jnp.float32)
    _, o = lax.scan(step, R0, (to_chunks(q, L), to_chunks(k, L), to_chunks(v, L)))
    return from_chunks(o)


def mlstm_chunkwise(q, k, v, ig, lf):
    B, T, H, DK = q.shape
    DV = v.shape[-1]
    L = M_CHUNK
    causal = jnp.tril(jnp.ones((L, L), dtype=bool))

    def step(carry, xs):
        C, n, m = carry
        qc, kc, vc, ic, fc = xs
        b = jnp.cumsum(fc, axis=-1)
        dlog = jnp.where(causal, b[..., :, None] - b[..., None, :] + ic[..., None, :], NEG)
        inter = b + m[..., None]
        m_t = jnp.maximum(inter, jnp.max(dlog, axis=-1))
        s = jnp.einsum('bhld,bhsd->bhls', qc, kc) * jnp.exp(dlog - m_t[..., None])
        w_inter = jnp.exp(inter - m_t)
        num = (jnp.einsum('bhls,bhse->bhle', s, vc)
               + w_inter[..., None] * jnp.einsum('bhld,bhde->bhle', qc, C))
        den = jnp.sum(s, axis=-1) + w_inter * jnp.einsum('bhld,bhd->bhl', qc, n)
        h = num / jnp.maximum(jnp.abs(den), jnp.exp(-m_t))[..., None]
        b_last = b[..., -1]
        wlog = b_last[..., None] - b + ic
        m_new = jnp.maximum(b_last + m, jnp.max(wlog, axis=-1))
        decay = jnp.exp(b_last + m - m_new)
        wk = kc * jnp.exp(wlog - m_new[..., None])[..., None]
        C = decay[..., None, None] * C + jnp.einsum('bhsd,bhse->bhde', wk, vc)
        n = decay[..., None] * n + jnp.sum(wk, axis=2)
        return (C, n, m_new), h

    init = (jnp.zeros((B, H, DK, DV), jnp.float32), jnp.zeros((B, H, DK), jnp.float32),
            jnp.zeros((B, H), jnp.float32))
    xs = (to_chunks(q, L), to_chunks(k, L), to_chunks(v, L), to_chunks(ig, L), to_chunks(lf, L))
    _, h = lax.scan(step, init, xs)
    return from_chunks(h)


def ab_mixer(h, w_in, conv_w, conv_b, ret_g, ig_b, fg_b, m_g, w_out):
    B, T, _ = h.shape
    z = (h @ w_in).astype(jnp.float32)
    rq, rk, rv, rg, mq, mk, mv, mo, mi, mf = split_cols(z, AB_SIZES)
    pos = jnp.arange(T, dtype=jnp.float32)
    rq = rotary(rq.reshape(B, T, R_HEADS, R_DK), pos)
    rk = rotary(rk.reshape(B, T, R_HEADS, R_DK), pos) * (R_DK ** -0.5)
    ret = retention_chunkwise(rq, rk, rv.reshape(B, T, R_HEADS, R_DV))
    ret = rms_norm(ret, ret_g.reshape(R_HEADS, R_DV)).reshape(B, T, -1) * jax.nn.silu(rg)
    mqk = jax.nn.silu(causal_dwconv(jnp.concatenate([mq, mk], axis=-1), conv_w, conv_b))
    mq, mk = jnp.split(mqk, 2, axis=-1)
    hm = mlstm_chunkwise(mq.reshape(B, T, M_HEADS, M_DK) * (M_DK ** -0.5),
                         mk.reshape(B, T, M_HEADS, M_DK),
                         mv.reshape(B, T, M_HEADS, M_DV),
                         mi + ig_b,
                         jax.nn.log_sigmoid(mf + fg_b))
    mlstm = jax.nn.sigmoid(mo) * rms_norm(hm, m_g.reshape(M_HEADS, M_DV)).reshape(B, T, -1)
    y = jnp.concatenate([ret, mlstm], axis=-1) @ w_out
    return y.astype(h.dtype)


def nsa_mixer(h, w_in, q_g, k_g, pos_k, pos_v, w1k, w2k, w1v, w2v, gate_b, w_out):
    B, T, _ = h.shape
    G, HG, HD = N_KV_GROUPS, N_HEADS // N_KV_GROUPS, HEAD_DIM
    z = (h @ w_in).astype(jnp.float32)
    q, kc, vc, ks, vs, kw, vw, gt = split_cols(z, NSA_SIZES)
    q = rms_norm(q.reshape(B, T, G, HG, HD), q_g).transpose(0, 2, 3, 1, 4)

    def kv(t):
        return t.reshape(B, T, G, HD)

    nc = (T - CMP_BLOCK) // CMP_STRIDE + 1
    c_start = jnp.arange(nc) * CMP_STRIDE
    cidx = c_start[:, None] + jnp.arange(CMP_BLOCK)[None, :]

    def compress(t, pos, w1, w2):
        blk = kv(t)[:, cidx] + pos[:, None, :]
        blk = blk.transpose(0, 3, 1, 2, 4).reshape(B, G, nc, CMP_BLOCK * HD)
        return jax.nn.gelu(blk @ w1) @ w2

    kc = rms_norm(compress(kc, pos_k, w1k, w2k), k_g[0])
    vc = compress(vc, pos_v, w1v, w2v)
    ks = rms_norm(kv(ks), k_g[1]).transpose(0, 2, 1, 3)
    vs = kv(vs).transpose(0, 2, 1, 3)
    kw = rms_norm(kv(kw), k_g[2]).transpose(0, 2, 1, 3)
    vw = kv(vw).transpose(0, 2, 1, 3)
    ns = T // SLC_BLOCK
    n_sel = min(N_SELECT, ns)
    ks_blk = ks.reshape(B, G, ns, SLC_BLOCK, HD)
    vs_blk = vs.reshape(B, G, ns, SLC_BLOCK, HD)
    pad = ((0, 0), (0, 0), (WINDOW, 0), (0, 0))
    kw_pad = jnp.pad(kw, pad)
    vw_pad = jnp.pad(vw, pad)
    gates = jax.nn.sigmoid(gt.reshape(B, T, G, HG, 3) + gate_b.reshape(G, HG, 3)).transpose(0, 2, 3, 1, 4)
    cmp_end = c_start + CMP_BLOCK - 1
    sj = jnp.arange(ns)
    overlap = ((c_start[:, None] < (sj[None, :] + 1) * SLC_BLOCK)
               & (c_start[:, None] + CMP_BLOCK > sj[None, :] * SLC_BLOCK)).astype(jnp.float32)
    scale = HD ** -0.5
    bi = jnp.arange(B)[:, None, None, None]
    gi = jnp.arange(G)[None, :, None, None]

    def query_block(qb):
        t0 = qb * Q_BLOCK
        tpos = t0 + jnp.arange(Q_BLOCK)
        qq = lax.dynamic_slice_in_dim(q, t0, Q_BLOCK, axis=3)
        s = jnp.einsum('bghqd,bgnd->bghqn', qq, kc) * scale
        cvalid = cmp_end[None, :] <= tpos[:, None]
        p_c = jnp.where(cvalid, jax.nn.softmax(jnp.where(cvalid, s, NEG), axis=-1), 0.0)
        o_cmp = jnp.einsum('bghqn,bgnd->bghqd', p_c, vc)
        imp = jnp.einsum('bghqn,ns->bgqs', p_c, overlap)
        cur = tpos // SLC_BLOCK
        forced = (sj[None, :] == 0) | (sj[None, :] == cur[:, None]) | (sj[None, :] == cur[:, None] - 1)
        bvalid = sj[None, :] <= cur[:, None]
        score = jnp.where(forced, BIG, jnp.where(bvalid, imp, NEG))
        _, sel = lax.top_k(score, n_sel)
        kg = ks_blk[bi, gi, sel]
        vg = vs_blk[bi, gi, sel]
        kpos = sel[..., None] * SLC_BLOCK + jnp.arange(SLC_BLOCK)
        smask = (kpos <= tpos[:, None, None])[:, :, None]
        s = jnp.einsum('bghqd,bgqnkd->bghqnk', qq, kg) * scale
        s = jnp.where(smask, s, NEG).reshape(B, G, HG, Q_BLOCK, n_sel * SLC_BLOCK)
        p_s = jax.nn.softmax(s, axis=-1).reshape(B, G, HG, Q_BLOCK, n_sel, SLC_BLOCK)
        o_slc = jnp.einsum('bghqnk,bgqnkd->bghqd', p_s, vg)
        kwb = lax.dynamic_slice_in_dim(kw_pad, t0, WINDOW + Q_BLOCK, axis=2)
        vwb = lax.dynamic_slice_in_dim(vw_pad, t0, WINDOW + Q_BLOCK, axis=2)
        wpos = t0 - WINDOW + jnp.arange(WINDOW + Q_BLOCK)
        wmask = ((wpos[None, :] <= tpos[:, None]) & (wpos[None, :] > tpos[:, None] - WINDOW)
                 & (wpos[None, :] >= 0))
        s = jnp.einsum('bghqd,bgkd->bghqk', qq, kwb) * scale
        p_w = jax.nn.softmax(jnp.where(wmask, s, NEG), axis=-1)
        o_win = jnp.einsum('bghqk,bgkd->bghqd', p_w, vwb)
        g = lax.dynamic_slice_in_dim(gates, t0, Q_BLOCK, axis=3)
        return g[..., 0:1] * o_cmp + g[..., 1:2] * o_slc + g[..., 2:3] * o_win

    o = lax.map(query_block, jnp.arange(T // Q_BLOCK))
    o = o.transpose(1, 0, 4, 2, 3, 5).reshape(B, T, N_HEADS * HD)
    return (o @ w_out).astype(h.dtype)


def conv_ffn(h, w_up, conv_w, conv_b, w_down):
    a, b = jnp.split(h @ w_up, 2, axis=-1)
    a = causal_dwconv(a, conv_w, conv_b)
    return (jax.nn.gelu(a) * b) @ w_down


def setup_inputs(seed: int = 0) -> dict:
    key = jax.random.key(seed)
    keys = iter(jax.random.split(key, 64))
    f32 = jnp.float32
    NE = (DEPTH + 1) // 2
    NO = DEPTH // 2

    def nrm(shape, scale):
        return scale * jax.random.normal(next(keys), shape, f32)

    def gain(shape):
        return 1.0 + nrm(shape, 0.02)

    return {
        'x': nrm((BATCH, SEQ, D_MODEL), 1.0),
        'p': nrm((DEPTH, BATCH, SEQ, PLE_DIM), 1.0),
        'ab_norm_g': gain((NE, D_MODEL)),
        'ab_w_in': nrm((NE, D_MODEL, AB_COLS), D_MODEL ** -0.5),
        'ab_conv_w': nrm((NE, M_CONV, 2 * M_HEADS * M_DK), M_CONV ** -0.5),
        'ab_conv_b': nrm((NE, 2 * M_HEADS * M_DK), 0.02),
        'ab_ret_norm_g': gain((NE, R_HEADS * R_DV)),
        'ab_ig_b': nrm((NE, M_HEADS), 0.1),
        'ab_fg_b': jnp.linspace(3.0, 6.0, M_HEADS, dtype=f32)[None, :] + nrm((NE, M_HEADS), 0.1),
        'ab_m_norm_g': gain((NE, M_HEADS * M_DV)),
        'ab_w_out': nrm((NE, AB_MIX, D_MODEL), AB_MIX ** -0.5),
        'nsa_norm_g': gain((NO, D_MODEL)),
        'nsa_w_in': nrm((NO, D_MODEL, NSA_COLS), D_MODEL ** -0.5),
        'nsa_q_norm_g': gain((NO, HEAD_DIM)),
        'nsa_k_norm_g': gain((NO, 3, HEAD_DIM)),
        'nsa_cmp_pos_k': nrm((NO, CMP_BLOCK, HEAD_DIM), 0.1),
        'nsa_cmp_pos_v': nrm((NO, CMP_BLOCK, HEAD_DIM), 0.1),
        'nsa_cmp_w1k': nrm((NO, CMP_BLOCK * HEAD_DIM, CMP_HIDDEN), (CMP_BLOCK * HEAD_DIM) ** -0.5),
        'nsa_cmp_w2k': nrm((NO, CMP_HIDDEN, HEAD_DIM), CMP_HIDDEN ** -0.5),
        'nsa_cmp_w1v': nrm((NO, CMP_BLOCK * HEAD_DIM, CMP_HIDDEN), (CMP_BLOCK * HEAD_DIM) ** -0.5),
        'nsa_cmp_w2v': nrm((NO, CMP_HIDDEN, HEAD_DIM), CMP_HIDDEN ** -0.5),
        'nsa_gate_b': nrm((NO, N_HEADS * 3), 0.1),
        'nsa_w_out': nrm((NO, N_HEADS * HEAD_DIM, D_MODEL), (N_HEADS * HEAD_DIM) ** -0.5),
        'ffn_norm_g': gain((DEPTH, D_MODEL)),
        'ffn_w_up': nrm((DEPTH, D_MODEL, 2 * D_FF), D_MODEL ** -0.5),
        'ffn_conv_w': nrm((DEPTH, FFN_CONV, D_FF), FFN_CONV ** -0.5),
        'ffn_conv_b': nrm((DEPTH, D_FF), 0.02),
        'ffn_w_down': nrm((DEPTH, D_FF, D_MODEL), D_FF ** -0.5),
        'ple_w': nrm((DEPTH, PLE_DIM, D_MODEL), PLE_DIM ** -0.5),
        'ple_norm_g': gain((DEPTH, D_MODEL)),
        'ple_gate_norm_g': gain((DEPTH, D_MODEL)),
        'ple_w_gate': nrm((DEPTH, D_MODEL, D_MODEL), D_MODEL ** -0.5),
    }


def reference(x, p, ab_norm_g, ab_w_in, ab_conv_w, ab_conv_b, ab_ret_norm_g, ab_ig_b, ab_fg_b,
              ab_m_norm_g, ab_w_out, nsa_norm_g, nsa_w_in, nsa_q_norm_g, nsa_k_norm_g,
              nsa_cmp_pos_k, nsa_cmp_pos_v, nsa_cmp_w1k, nsa_cmp_w2k, nsa_cmp_w1v, nsa_cmp_w2v,
              nsa_gate_b, nsa_w_out, ffn_norm_g, ffn_w_up, ffn_conv_w, ffn_conv_b, ffn_w_down,
              ple_w, ple_norm_g, ple_gate_norm_g, ple_w_gate):
    h = x
    for i in range(DEPTH):
        j = i // 2
        if i % 2 == 0:
            h = h + ab_mixer(rms_norm(h, ab_norm_g[j]), ab_w_in[j], ab_conv_w[j], ab_conv_b[j],
                             ab_ret_norm_g[j], ab_ig_b[j], ab_fg_b[j], ab_m_norm_g[j], ab_w_out[j])
        else:
            h = h + nsa_mixer(rms_norm(h, nsa_norm_g[j]), nsa_w_in[j], nsa_q_norm_g[j], nsa_k_norm_g[j],
                              nsa_cmp_pos_k[j], nsa_cmp_pos_v[j], nsa_cmp_w1k[j], nsa_cmp_w2k[j],
                              nsa_cmp_w1v[j], nsa_cmp_w2v[j], nsa_gate_b[j], nsa_w_out[j])
        h = h + conv_ffn(rms_norm(h, ffn_norm_g[i]), ffn_w_up[i], ffn_conv_w[i], ffn_conv_b[i], ffn_w_down[i])
        e = rms_norm(p[i] @ ple_w[i], ple_norm_g[i])
        gate = jax.nn.sigmoid(rms_norm(h, ple_gate_norm_g[i]) @ ple_w_gate[i])
        h = h + gate * e
    return h
```

```cpp
#include <hip/hip_runtime.h>
#include <hip/hip_cooperative_groups.h>
#include <cstdio>
#include <type_traits>
namespace cg = cooperative_groups;

#define DI __device__ __forceinline__
typedef unsigned short u16;
typedef unsigned long long u64;
typedef __attribute__((ext_vector_type(8))) short bf16x8;
typedef __attribute__((ext_vector_type(16))) float f32x16;
typedef __attribute__((ext_vector_type(4))) unsigned u32x4;
typedef __attribute__((ext_vector_type(2))) unsigned u32x2;
#define MFMA(a, b, c) __builtin_amdgcn_mfma_f32_32x32x16_bf16((a), (b), (c), 0, 0, 0)

#ifndef USE_CG
#define USE_CG 0
#endif
#if USE_CG
#define GSYNC() grid.sync()
#else
#define GSYNC() ctr_barrier((unsigned*)(P.ws + O_BAR) + 4096 - 64, bar_gen)
#endif
#ifndef RESTRICT
#define RESTRICT 0
#endif
#define RB(k, id, n) ((((RESTRICT) >> (k)) & 1) && (n) > 256 ? ((id) < 256 ? (id) : 0x3fffffff) : (id))
#define RS(k, n) ((((RESTRICT) >> (k)) & 1) && (n) > 256 ? 256 : (n))
#ifndef P1REP
#define P1REP 1
#endif
#ifndef DUPMASK
#define DUPMASK 0
#endif
#ifndef XCD_CONSEC
#define XCD_CONSEC 1
#endif
#ifndef MINW
#define MINW 1
#endif
#ifndef ONLY
#define PH(k) true
#else
#define PH(k) ((ONLY) == (k))
#endif
constexpr int MT = 16384, DM = 1024, TS = 4096;
constexpr float EPS = 1e-6f;

constexpr size_t O_WABIN = 0;
constexpr size_t O_WABOUT = O_WABIN + 3200ull * 1024 * 2;
constexpr size_t O_WNSAIN = O_WABOUT + 1024ull * 1024 * 2;
constexpr size_t O_WC1K = O_WNSAIN + 1920ull * 1024 * 2;
constexpr size_t O_WC1V = O_WC1K + 256ull * 2048 * 2;
constexpr size_t O_WC2K = O_WC1V + 256ull * 2048 * 2;
constexpr size_t O_WC2V = O_WC2K + 128ull * 256 * 2;
constexpr size_t O_WNSAOUT = O_WC2V + 128ull * 256 * 2;
constexpr size_t O_WUP = O_WNSAOUT + 1024ull * 1024 * 2;
constexpr size_t SZ_WUP = 5632ull * 1024 * 2;
constexpr size_t O_WDOWN = O_WUP + 2 * SZ_WUP;
constexpr size_t SZ_WDOWN = 1024ull * 2816 * 2;
constexpr size_t O_WPLE = O_WDOWN + 2 * SZ_WDOWN;
constexpr size_t SZ_WPLE = 1024ull * 256 * 2;
constexpr size_t O_WGATE = O_WPLE + 2 * SZ_WPLE;
constexpr size_t SZ_WGATE = 1024ull * 1024 * 2;
constexpr size_t O_ROPEC = O_WGATE + 2 * SZ_WGATE;
constexpr size_t O_ROPES = O_ROPEC + 4096ull * 32 * 4;
constexpr size_t O_BIAS1 = O_ROPES + 4096ull * 32 * 4;
constexpr size_t O_BAR = O_BIAS1 + 4096;
constexpr size_t O_SS = O_BAR + 16384;
constexpr size_t O_HB0 = O_SS + 8ull * MT * 8;
constexpr size_t O_HB1 = O_HB0 + (size_t)MT * DM * 2;
constexpr size_t O_BIG = O_HB1 + (size_t)MT * DM * 2;
constexpr size_t O_VT0 = O_BIG;
constexpr size_t O_KT = O_VT0 + 4ull * 1024 * 4096 * 2;
constexpr size_t O_QM = O_KT + 4ull * 256 * 4096 * 2;
constexpr size_t O_KM = O_QM + (size_t)MT * 256 * 2;
constexpr size_t O_KWT = O_KM + (size_t)MT * 256 * 2;
constexpr size_t O_GS = O_KWT + 4ull * 256 * 4096 * 2;
constexpr size_t O_BL = O_GS + 16ull * 4096 * 4;
constexpr size_t O_PM = O_BL + 16ull * 4096 * 4;
constexpr size_t O_BLAST = O_PM + 16ull * 4096 * 4;
constexpr size_t O_GC = O_BLAST + 4096;
constexpr size_t O_MS = O_GC + 4096;
constexpr size_t O_NC = O_MS + 4096;
constexpr size_t O_NS = O_NC + 1024ull * 64 * 4;
constexpr size_t O_GF = O_NS + 1024ull * 64 * 4;
constexpr size_t O_KVT = O_GF + (size_t)MT * 8 * 4;
constexpr size_t O_RT = O_KVT + 512ull * 8192 * 4;
constexpr size_t O_UT = O_RT + 512ull * 8192 * 2;
constexpr size_t O_L0END = O_UT + 1024ull * 8192 * 4;
constexpr size_t O_CT = O_HB1;
constexpr size_t O_ACT = O_BIG;
constexpr size_t O_ERAW = O_ACT + (size_t)MT * 2816 * 2;
constexpr size_t O_FFNEND = O_ERAW + (size_t)MT * DM * 2;
constexpr size_t O_QN = O_BIG;
constexpr size_t O_KCVC = O_QN + (size_t)MT * DM * 2;
constexpr size_t O_KSN = O_KCVC + (size_t)MT * 256 * 2;
constexpr size_t O_KWN = O_KSN + (size_t)MT * 128 * 2;
constexpr size_t O_VST = O_KWN + (size_t)MT * 128 * 2;
constexpr size_t O_VWT = O_VST + (size_t)MT * 128 * 2;
constexpr size_t O_GT1 = O_VWT + (size_t)MT * 128 * 2;
constexpr size_t O_HID = O_GT1 + (size_t)MT * 48 * 4;
constexpr size_t O_KCN = O_HID + 2ull * 2048 * 256 * 2;
constexpr size_t O_VCT = O_KCN + 8ull * 256 * 64 * 2;
constexpr size_t O_SEL = O_VCT + 8ull * 64 * 256 * 2;
constexpr size_t O_OBUF = O_SEL + 8ull * 4096 * 8;
constexpr size_t O_L1END = O_OBUF + (size_t)MT * DM * 2;
constexpr size_t O_OCMP = O_HB1;
constexpr size_t WS_NEED = 256ull << 20;
static_assert(O_L0END <= WS_NEED && O_FFNEND <= WS_NEED && O_L1END <= WS_NEED, "workspace overflow");

struct Params {
    const float *x, *p, *ab_norm_g, *ab_w_in, *ab_conv_w, *ab_conv_b, *ab_ret_norm_g, *ab_ig_b, *ab_fg_b, *ab_m_norm_g, *ab_w_out;
    const float *nsa_norm_g, *nsa_w_in, *nsa_q_norm_g, *nsa_k_norm_g, *nsa_cmp_pos_k, *nsa_cmp_pos_v, *w1k, *w2k, *w1v, *w2v, *nsa_gate_b, *nsa_w_out;
    const float *ffn_norm_g, *ffn_w_up, *ffn_conv_w, *ffn_conv_b, *ffn_w_down, *ple_w, *ple_norm_g, *ple_gate_norm_g, *ple_w_gate;
    float* out;
    char* ws;
};

DI float bf2f(u16 b) { return __uint_as_float(((unsigned)b) << 16); }
typedef float f32x2_t __attribute__((ext_vector_type(2)));
typedef __bf16 bf16x2_t __attribute__((ext_vector_type(2)));
DI unsigned pk2(float a, float b) { f32x2_t v = {a, b}; bf16x2_t o = __builtin_convertvector(v, bf16x2_t); return __builtin_bit_cast(unsigned, o); }
DI u16 f2bf(float x) { return (u16)(pk2(x, 0.f) & 0xffffu); }
DI float bflo(unsigned u) { return __uint_as_float(u << 16); }
DI float bfhi(unsigned u) { return __uint_as_float(u & 0xffff0000u); }
DI int crow(int i, int h) { return (i & 3) + 8 * (i >> 2) + 4 * h; }
DI float sigmoidf_(float x) { return 1.f / (1.f + __expf(-x)); }
DI float gelu_tanh(float x) { float y = 0.7978845608028654f * (x + 0.044715f * x * x * x); float t = 1.f - 2.f / (__expf(2.f * y) + 1.f); return 0.5f * x * (1.f + t); }
DI float red32(float v) { v += __shfl_xor(v, 1); v += __shfl_xor(v, 2); v += __shfl_xor(v, 4); v += __shfl_xor(v, 8); v += __shfl_xor(v, 16); return v; }
DI bf16x8 ld16(const u16* p) { return *(const bf16x8*)p; }
DI bf16x8 ld8x2(const u16* p0, const u16* p1) { u32x2 a = *(const u32x2*)p0, b = *(const u32x2*)p1; u32x4 v = {a.x, a.y, b.x, b.y}; return __builtin_bit_cast(bf16x8, v); }
DI bf16x8 packp(const f32x16& x, int s) {
    u32x4 v = {pk2(x[8 * s + 0], x[8 * s + 1]), pk2(x[8 * s + 2], x[8 * s + 3]), pk2(x[8 * s + 4], x[8 * s + 5]), pk2(x[8 * s + 6], x[8 * s + 7])};
    return __builtin_bit_cast(bf16x8, v);
}
DI f32x16 zero16() { f32x16 z; for (int i = 0; i < 16; ++i) z[i] = 0.f; return z; }
DI u64 ss_fix(float s) { return (u64)(s * 1048576.f + 0.5f); }
DI float ss_rstd(u64 v) { return rsqrtf((float)v * (1.f / (1048576.f * 1024.f)) + EPS); }
DI float gamma_log(int h) { return log1pf(-exp2f(-5.f - (float)h)); }


#define XB_TMO      128
#define XB_XCNT(j)  (256  + 64 * (j))
#define XB_XSUB(j)  (1280 + 64 * (j))
#define XB_XGEN(j)  (2304 + 64 * (j))
#define XB_TOP      3328
#define XB_TOPGEN   3392
#define XCD_BAR_WORDS 3456
#define XB_SPIN_CAP (1u << 22)
#define LAS __attribute__((address_space(3)))
DI unsigned xb_ld(unsigned* p) { return __hip_atomic_load(p, __ATOMIC_RELAXED, __HIP_MEMORY_SCOPE_AGENT); }
DI unsigned xb_add(unsigned* p, unsigned v) { return __hip_atomic_fetch_add(p, v, __ATOMIC_RELAXED, __HIP_MEMORY_SCOPE_AGENT); }
DI unsigned xb_xcc_id() { return (unsigned)__builtin_amdgcn_s_getreg((3 << 11) | 20) & 0xFu; }
#define XB_SPIN(cond, bar) do { unsigned _sp = 0; while (cond) { __builtin_amdgcn_s_sleep(1); \
    if ((++_sp & 255u) == 0u) { if (xb_ld(&(bar)[XB_TMO])) break; if (_sp > XB_SPIN_CAP) { atomicAdd(&(bar)[XB_TMO], 1u); break; } } } } while (0)
struct XcdBarrier { unsigned* bar; unsigned x; volatile LAS unsigned* st; };
DI XcdBarrier xcd_barrier_post(unsigned* bar, volatile LAS unsigned* st) {
    XcdBarrier b; b.bar = bar; b.x = xb_xcc_id(); b.st = st;
    if (threadIdx.x == 0) (void)xb_add(&bar[XB_XCNT(b.x)], 1u);
    return b;
}
DI void xcd_barrier_complete(unsigned* bar, unsigned x, unsigned& nloc, unsigned& nx) {
    const unsigned G = gridDim.x * gridDim.y * gridDim.z;
    unsigned sum, cnt, mine, sp = 0u;
    for (;;) {
        sum = 0u; cnt = 0u; mine = 0u;
#pragma unroll
        for (unsigned j = 0; j < 16; ++j) { const unsigned c = xb_ld(&bar[XB_XCNT(j)]); sum += c; cnt += (c > 0u) ? 1u : 0u; mine = (j == x) ? c : mine; }
        if (sum == G) break;
        __builtin_amdgcn_s_sleep(1);
        if ((++sp & 255u) == 0u) { if (xb_ld(&bar[XB_TMO])) break; if (sp > XB_SPIN_CAP) { atomicAdd(&bar[XB_TMO], 1u); break; } }
    }
    nloc = mine > 0u ? mine : 1u; nx = cnt > 0u ? cnt : 1u;
}
DI void xcd_barrier(const XcdBarrier& b) {
    asm volatile("s_waitcnt vmcnt(0)" ::: "memory");
    __syncthreads();
    if (threadIdx.x == 0) {
        unsigned* bar = b.bar;
        __builtin_amdgcn_s_waitcnt(0);
        unsigned nloc = b.st[0], nx = b.st[1];
        if (nloc == 0u) { xcd_barrier_complete(bar, b.x, nloc, nx); b.st[0] = nloc; b.st[1] = nx; }
        const unsigned old = xb_add(&bar[XB_XSUB(b.x)], 1u);
        const unsigned gen = old / nloc;
        if (old + 1u == (gen + 1u) * nloc) {
            __builtin_amdgcn_fence(__ATOMIC_RELEASE, "agent");
            asm volatile("s_waitcnt vmcnt(0)" ::: "memory");
            const unsigned og = xb_add(&bar[XB_TOP], 1u);
            const unsigned tg = og / nx;
            if (og + 1u == (tg + 1u) * nx) xb_add(&bar[XB_TOPGEN], 1u);
            else XB_SPIN(xb_ld(&bar[XB_TOPGEN]) == tg, bar);
            __builtin_amdgcn_fence(__ATOMIC_ACQUIRE, "agent");
            xb_add(&bar[XB_XGEN(b.x)], 1u);
            asm volatile("s_waitcnt vmcnt(0)" ::: "memory");
        } else {
            XB_SPIN(xb_ld(&bar[XB_XGEN(b.x)]) == gen, bar);
            __builtin_amdgcn_fence(__ATOMIC_ACQUIRE, "agent");
            asm volatile("s_waitcnt vmcnt(0)" ::: "memory");
        }
    }
    __syncthreads();
}

DI void ctr_barrier(unsigned* ctr, unsigned& gen) {
    asm volatile("s_waitcnt vmcnt(0)" ::: "memory");
    __syncthreads();
    gen += 1u;
    if (threadIdx.x == 0) {
        __builtin_amdgcn_fence(__ATOMIC_RELEASE, "agent");
        asm volatile("s_waitcnt vmcnt(0)" ::: "memory");
        (void)__hip_atomic_fetch_add(ctr, 1u, __ATOMIC_RELAXED, __HIP_MEMORY_SCOPE_AGENT);
        const unsigned target = gen * gridDim.x;
        unsigned sp = 0;
        while (__hip_atomic_load(ctr, __ATOMIC_RELAXED, __HIP_MEMORY_SCOPE_AGENT) < target) {
            __builtin_amdgcn_s_sleep(1);
            if (++sp > (1u << 24)) break;
        }
        __builtin_amdgcn_fence(__ATOMIC_ACQUIRE, "agent");
        asm volatile("s_waitcnt vmcnt(0)" ::: "memory");
    }
    __syncthreads();
}

constexpr int LDT = 72;
constexpr int LDS_BYTES = 2 * 2 * 128 * LDT * 2;

template <bool AF32, class RowA>
DI void gemm_main(f32x16 (&acc)[2][2], RowA rowA, const int kmulA, const u16* __restrict__ Bf, int ldb, int n0, int K, u16* As, u16*  ) {
    constexpr int PD = 2;
    constexpr int BUFE = 128 * LDT;
    const int tid = threadIdx.x, lane = tid & 63, wave = tid >> 6;
    const int wm = wave >> 1, wn = wave & 1, r = lane & 31, hh = lane >> 5;
#pragma unroll
    for (int mi = 0; mi < 2; ++mi)
#pragma unroll
        for (int ni = 0; ni < 2; ++ni) acc[mi][ni] = zero16();
    typedef typename std::conditional<AF32, float, u16>::type TA;
    const int row0 = tid >> 3, kc = (tid & 7) * 8;
    const TA* pa[4];
#pragma unroll
    for (int i = 0; i < 4; ++i) pa[i] = (const TA*)rowA(row0 + 32 * i) + kc;
    const int kbn = ldb >> 4;
    const u16* pb = Bf + ((size_t)((n0 + wn * 64) >> 5) * kbn * 64 + lane) * 8;
    u32x4 ra[PD][4];
    bf16x8 rb[PD][8];
    auto loadA = [&](u32x4 (&xa)[4], int k0) __attribute__((always_inline)) {
#pragma unroll
        for (int i = 0; i < 4; ++i) {
            if constexpr (AF32) {
                const float* q = (const float*)pa[i] + k0 * kmulA;
                const float4 v0 = *(const float4*)q, v1 = *(const float4*)(q + 4);
                u32x4 t = {pk2(v0.x, v0.y), pk2(v0.z, v0.w), pk2(v1.x, v1.y), pk2(v1.z, v1.w)};
                xa[i] = t;
            } else {
                xa[i] = *(const u32x4*)((const u16*)pa[i] + k0 * kmulA);
            }
        }
    };
    auto loadB = [&](bf16x8 (&xb)[8], int k0) __attribute__((always_inline)) {
#pragma unroll
        for (int ni = 0; ni < 2; ++ni)
#pragma unroll
            for (int ks = 0; ks < 4; ++ks) xb[ni * 4 + ks] = *(const bf16x8*)(pb + ((size_t)ni * kbn + (k0 >> 4) + ks) * 512);
    };
    auto stores = [&](const u32x4 (&xa)[4], int p) __attribute__((always_inline)) {
        u16* sa = As + p * BUFE + row0 * LDT + kc;
#pragma unroll
        for (int i = 0; i < 4; ++i) *(u32x4*)(sa + 32 * i * LDT) = xa[i];
    };
    const int nk = K >> 6;
#pragma unroll
    for (int d = 0; d < PD; ++d) { loadA(ra[d], d * 64); loadB(rb[d], d * 64); }
    __syncthreads();
    stores(ra[0], 0);
    if (PD < nk) loadA(ra[0], PD * 64);
    __syncthreads();
    const u16* fa = As + (wm * 64 + r) * LDT + hh * 8;
    for (int kb = 0; kb < nk; kb += PD) {
#pragma unroll
        for (int u = 0; u < PD; ++u) {
            const int k = kb + u, p = u & 1;
#pragma unroll
            for (int ks = 0; ks < 4; ++ks) {
                bf16x8 a[2];
#pragma unroll
                for (int mi = 0; mi < 2; ++mi) a[mi] = *(const bf16x8*)(fa + p * BUFE + mi * 32 * LDT + ks * 16);
#pragma unroll
                for (int mi = 0; mi < 2; ++mi)
#pragma unroll
                    for (int ni = 0; ni < 2; ++ni) acc[mi][ni] = MFMA(a[mi], rb[u][ni * 4 + ks], acc[mi][ni]);
            }
            if (k + PD < nk) loadB(rb[u], (k + PD) * 64);
            if (k + 1 < nk) {
                stores(ra[(u + 1) % PD], p ^ 1);
                if (k + 1 + PD < nk) loadA(ra[(u + 1) % PD], (k + 1 + PD) * 64);
            }
            __syncthreads();
        }
    }
}

DI bool tile_decode(int v, int MTl, int NTl, int& mt, int& nt) {
    mt = v / NTl; nt = v - mt * NTl;
    return v < MTl * NTl;
}
DI int tile_bound(int MTl, int NTl) { return MTl * NTl; }

template <class RowMap>
DI void tconv(const float* __restrict__ W, int K, int N, int Npad, const float* __restrict__ g, u16* __restrict__ out, RowMap rm, int gtid, int gsz) {
    const int total = (K / 32) * Npad, kb_per_n = K >> 4;
    for (int u = gtid; u < total; u += gsz) {
        const int n = u % Npad, k32 = u / Npad;
        float v[32];
        if (n < N) {
            const float* wp = W + (size_t)(k32 * 32) * N + n;
#pragma unroll
            for (int j = 0; j < 32; ++j) v[j] = wp[(size_t)j * N];
            if (g) {
#pragma unroll
                for (int j = 0; j < 32; ++j) v[j] *= g[k32 * 32 + j];
            }
        } else {
#pragma unroll
            for (int j = 0; j < 32; ++j) v[j] = 0.f;
        }
        const int np = rm(n), nb = np >> 5, rr = np & 31;
#pragma unroll
        for (int q = 0; q < 4; ++q) {
            u32x4 o = {pk2(v[8 * q + 0], v[8 * q + 1]), pk2(v[8 * q + 2], v[8 * q + 3]), pk2(v[8 * q + 4], v[8 * q + 5]), pk2(v[8 * q + 6], v[8 * q + 7])};
            const size_t blkid = (size_t)nb * kb_per_n + k32 * 2 + (q >> 1);
            *(u32x4*)(out + (blkid * 64 + (q & 1) * 32 + rr) * 8) = o;
        }
    }
}
DI void zfill16(u16* p, size_t n_elems, int gtid, int gsz) {
    u32x4 z = {0u, 0u, 0u, 0u};
    for (size_t u = gtid; u < n_elems / 8; u += gsz) *(u32x4*)(p + u * 8) = z;
}

__global__ void __launch_bounds__(256, MINW) fwd_megakernel(Params P) {
    cg::grid_group grid = cg::this_grid();
    __shared__ __attribute__((aligned(16))) char smem[LDS_BYTES];
    __shared__ uint4 xb_words;
    if (threadIdx.x == 0) xb_words = make_uint4(0u, 0u, 0u, 0u);
    __syncthreads();
    unsigned bar_gen = 0u;
    const XcdBarrier xbar = xcd_barrier_post((unsigned*)(P.ws + O_BAR), (volatile LAS unsigned*)&xb_words);
    u16* As = (u16*)smem;
    u16* Bs = As + 128 * LDT;
    const int tid = threadIdx.x, lane = tid & 63, wave = tid >> 6;
    const int wm = wave >> 1, wn = wave & 1, r = lane & 31, hh = lane >> 5;
    const int nblk = gridDim.x, blk = blockIdx.x;
    const int gtid = blk * 256 + tid, gsz = nblk * 256;
    const int gw = blk * 4 + wave, ngw = nblk * 4;
    char* ws = P.ws;
    u64* SS = (u64*)(ws + O_SS);
    u16* HB0 = (u16*)(ws + O_HB0);
    u16* HB1 = (u16*)(ws + O_HB1);
    const float* ROPEC = (const float*)(ws + O_ROPEC);
    const float* ROPES = (const float*)(ws + O_ROPES);

    auto ph_0 = [&]() __attribute__((always_inline)) {
        auto idm = [](int n) { return n; };
        auto upm = [](int n) { return n < 2816 ? (n >> 6) * 128 + (n & 63) : ((n - 2816) >> 6) * 128 + 64 + ((n - 2816) & 63); };
        tconv(P.ab_w_in, 1024, 3080, 3200, P.ab_norm_g, (u16*)(ws + O_WABIN), idm, gtid, gsz);
        tconv(P.ab_w_out, 1024, 1024, 1024, (const float*)nullptr, (u16*)(ws + O_WABOUT), idm, gtid, gsz);
        tconv(P.nsa_w_in, 1024, 1840, 1920, P.nsa_norm_g, (u16*)(ws + O_WNSAIN), idm, gtid, gsz);
        tconv(P.w1k, 2048, 256, 256, (const float*)nullptr, (u16*)(ws + O_WC1K), idm, gtid, gsz);
        tconv(P.w1v, 2048, 256, 256, (const float*)nullptr, (u16*)(ws + O_WC1V), idm, gtid, gsz);
        tconv(P.w2k, 256, 64, 128, (const float*)nullptr, (u16*)(ws + O_WC2K), idm, gtid, gsz);
        tconv(P.w2v, 256, 64, 128, (const float*)nullptr, (u16*)(ws + O_WC2V), idm, gtid, gsz);
        tconv(P.nsa_w_out, 1024, 1024, 1024, (const float*)nullptr, (u16*)(ws + O_WNSAOUT), idm, gtid, gsz);
        for (int i = 0; i < 2; ++i) {
            tconv(P.ffn_w_up + (size_t)i * 1024 * 5632, 1024, 5632, 5632, P.ffn_norm_g + i * 1024, (u16*)(ws + O_WUP + i * SZ_WUP), upm, gtid, gsz);
            tconv(P.ffn_w_down + (size_t)i * 2816 * 1024, 2816, 1024, 1024, (const float*)nullptr, (u16*)(ws + O_WDOWN + i * SZ_WDOWN), idm, gtid, gsz);
            tconv(P.ple_w + (size_t)i * 256 * 1024, 256, 1024, 1024, (const float*)nullptr, (u16*)(ws + O_WPLE + i * SZ_WPLE), idm, gtid, gsz);
            tconv(P.ple_w_gate + (size_t)i * 1024 * 1024, 1024, 1024, 1024, P.ple_gate_norm_g + i * 1024, (u16*)(ws + O_WGATE + i * SZ_WGATE), idm, gtid, gsz);
        }
        {
            float* rc = (float*)(ws + O_ROPEC);
            float* rs = (float*)(ws + O_ROPES);
            for (int u = gtid; u < 4096 * 32; u += gsz) {
                const int pos = u >> 5, d = u & 31;
                const float inv = powf(10000.f, -(float)d / 32.f);
                const float ang = (float)pos * inv;
                const double a = (double)ang;
                const double n = rint(a * 0.15915494309189535);
                const float rr = (float)(a - n * 6.283185307179586);
                rc[u] = cosf(rr);
                rs[u] = sinf(rr);
            }
        }
        for (int u = gw; u < 512; u += ngw) {
            const int kv = u >> 8, j = u & 255;
            const float* pos = kv ? P.nsa_cmp_pos_v : P.nsa_cmp_pos_k;
            const float* W1 = kv ? P.w1v : P.w1k;
            float s = 0.f;
            for (int k = lane; k < 2048; k += 64) s += pos[k] * W1[(size_t)k * 256 + j];
            s = red32(s); s += __shfl_xor(s, 32);
            if (lane == 0) ((float*)(ws + O_BIAS1))[u] = s;
        }
        for (int u = gtid; u < 7 * MT; u += gsz) SS[MT + u] = 0ull;
        for (int row = gw; row < MT; row += ngw) {
            const float4* xr = (const float4*)(P.x + (size_t)row * DM);
            float s = 0.f;
#pragma unroll
            for (int j = 0; j < 4; ++j) {
                const float4 v = xr[lane + 64 * j];
                s += v.x * v.x + v.y * v.y + v.z * v.z + v.w * v.w;
                u32x2 o = {pk2(v.x, v.y), pk2(v.z, v.w)};
                *(u32x2*)(HB0 + (size_t)row * DM + (lane + 64 * j) * 4) = o;
            }
            s = red32(s); s += __shfl_xor(s, 32);
            if (lane == 0) SS[row] = ss_fix(s);
        }
    };

    auto ph_1 = [&]() __attribute__((always_inline)) {
        u16* Z0 = (u16*)P.out;
        u16* VT0 = (u16*)(ws + O_VT0);
        u16* KT = (u16*)(ws + O_KT);
        float* GF = (float*)(ws + O_GF);
        const u16* Wt = (const u16*)(ws + O_WABIN);
        for (int tile = blk; tile < tile_bound(128, 25); tile += nblk) {
            int mt, nt; if (!tile_decode(tile, 128, 25, mt, nt)) continue;
            const int m0 = mt * 128, n0 = nt * 128;
            f32x16 acc[2][2];
            const u16* Ab = HB0 + (size_t)m0 * DM;
            gemm_main<false>(acc, [&](int row) { return Ab + (size_t)row * DM; }, 1, Wt, 1024, n0, 1024, As, Bs);
            const int colw = n0 + wn * 64;
            float rsv[2][16], cv[2][16], sv[2][16];
#pragma unroll
            for (int mi = 0; mi < 2; ++mi)
#pragma unroll
                for (int i = 0; i < 16; ++i) {
                    const int row = m0 + wm * 64 + mi * 32 + crow(i, hh);
                    rsv[mi][i] = ss_rstd(SS[row]);
                    cv[mi][i] = (nt < 4) ? ROPEC[(row & 4095) * 32 + r] : 0.f;
                    sv[mi][i] = (nt < 4) ? ROPES[(row & 4095) * 32 + r] : 0.f;
                }
#pragma unroll
            for (int mi = 0; mi < 2; ++mi) {
#pragma unroll
                for (int i4 = 0; i4 < 4; ++i4) {
                    float v0[4], v1[4];
                    const int rowb = m0 + wm * 64 + mi * 32 + 8 * i4 + 4 * hh;
#pragma unroll
                    for (int j = 0; j < 4; ++j) {
                        const float rs = rsv[mi][i4 * 4 + j];
                        v0[j] = acc[mi][0][i4 * 4 + j] * rs;
                        v1[j] = acc[mi][1][i4 * 4 + j] * rs;
                    }
                    const int bb = rowb >> 12, t = rowb & 4095;
                    if (nt < 4) {
                        const int head = (colw & 255) >> 6;
                        const float lg = gamma_log(head);
#pragma unroll
                        for (int j = 0; j < 4; ++j) {
                            const float c = cv[mi][i4 * 4 + j], s = sv[mi][i4 * 4 + j];
                            float y0 = v0[j] * c - v1[j] * s, y1 = v0[j] * s + v1[j] * c;
                            if (nt >= 2) { const float sc = 0.125f * __expf(-(float)(((t + j) & 127) + 1) * lg); y0 *= sc; y1 *= sc; }
                            v0[j] = y0; v1[j] = y1;
                            Z0[(size_t)(rowb + j) * 2048 + colw + r] = f2bf(y0);
                            Z0[(size_t)(rowb + j) * 2048 + colw + 32 + r] = f2bf(y1);
                        }
                        if (nt >= 2) {
                            const int kc = colw - 256;
                            u32x2 o0 = {pk2(v0[0], v0[1]), pk2(v0[2], v0[3])}, o1 = {pk2(v1[0], v1[1]), pk2(v1[2], v1[3])};
                            *(u32x2*)(KT + ((size_t)(bb * 256 + kc + r)) * 4096 + t) = o0;
                            *(u32x2*)(KT + ((size_t)(bb * 256 + kc + 32 + r)) * 4096 + t) = o1;
                        }
                    } else if ((nt >= 4 && nt < 8) || (nt >= 16 && nt < 20)) {
                        const int vc = (nt < 8) ? (colw - 512) : (512 + colw - 2048);
                        u32x2 o0 = {pk2(v0[0], v0[1]), pk2(v0[2], v0[3])}, o1 = {pk2(v1[0], v1[1]), pk2(v1[2], v1[3])};
                        *(u32x2*)(VT0 + ((size_t)(bb * 1024 + vc + r)) * 4096 + t) = o0;
                        *(u32x2*)(VT0 + ((size_t)(bb * 1024 + vc + 32 + r)) * 4096 + t) = o1;
                    } else if (nt < 24) {
                        const int zc = (nt < 12) ? (512 + colw - 1024) : (nt < 16) ? (1024 + colw - 1536) : (1536 + colw - 2560);
#pragma unroll
                        for (int j = 0; j < 4; ++j) {
                            Z0[(size_t)(rowb + j) * 2048 + zc + r] = f2bf(v0[j]);
                            Z0[(size_t)(rowb + j) * 2048 + zc + 32 + r] = f2bf(v1[j]);
                        }
                    } else {
                        if (wn == 0 && r < 8) {
#pragma unroll
                            for (int j = 0; j < 4; ++j) GF[(size_t)(rowb + j) * 8 + r] = v0[j];
                        }
                    }
                }
            }
        }
    };

    auto ph_2 = [&]() __attribute__((always_inline)) {
        const u16* Z0 = (const u16*)P.out;
        const float* GF = (const float*)(ws + O_GF);
        float* GS = (float*)(ws + O_GS); float* BL = (float*)(ws + O_BL); float* PM = (float*)(ws + O_PM);
        float* BLAST = (float*)(ws + O_BLAST); float* GC = (float*)(ws + O_GC); float* NC = (float*)(ws + O_NC);
        u16* QM = (u16*)(ws + O_QM); u16* KM = (u16*)(ws + O_KM); u16* KWT = (u16*)(ws + O_KWT);
        for (int u = gw; u < 1024; u += ngw) {
            const int bh = u >> 6, c = u & 63, b = bh >> 2, h = bh & 3, t0 = c * 64;
            const size_t rowb = (size_t)b * 4096;
            const size_t row = rowb + t0 + lane;
            const float f = GF[row * 8 + 4 + h] + P.ab_fg_b[h];
            const float fc = fminf(f, 0.f) - log1pf(__expf(-fabsf(f)));
            const float ic = GF[row * 8 + h] + P.ab_ig_b[h];
            float bcs = fc;
#pragma unroll
            for (int off = 1; off < 64; off <<= 1) { const float o = __shfl_up(bcs, off); if (lane >= off) bcs += o; }
            const float g = ic - bcs;
            float pm = g;
#pragma unroll
            for (int off = 1; off < 64; off <<= 1) { const float o = __shfl_up(pm, off); if (lane >= off) pm = fmaxf(pm, o); }
            const float G = __shfl(pm, 63), bl = __shfl(bcs, 63);
            const float w = __expf(g - G);
            GS[bh * 4096 + t0 + lane] = g; BL[bh * 4096 + t0 + lane] = bcs; PM[bh * 4096 + t0 + lane] = pm;
            if (lane == 0) { BLAST[bh * 64 + c] = bl; GC[bh * 64 + c] = G; }
            {
                const int ch = 256 + h * 64 + lane;
                const float w0 = P.ab_conv_w[ch], w1 = P.ab_conv_w[512 + ch], w2 = P.ab_conv_w[1024 + ch], w3 = P.ab_conv_w[1536 + ch], cb = P.ab_conv_b[ch];
                const u16* zp = Z0 + 1024 + ch;
                float x0 = 0.f, x1 = 0.f, x2 = 0.f;
                if (t0 > 0) { x0 = bf2f(zp[(rowb + t0 - 3) * 2048]); x1 = bf2f(zp[(rowb + t0 - 2) * 2048]); x2 = bf2f(zp[(rowb + t0 - 1) * 2048]); }
                float nsum = 0.f;
                float xr[64];
#pragma unroll
                for (int s = 0; s < 64; ++s) xr[s] = bf2f(zp[(rowb + t0 + s) * 2048]);
#pragma unroll
                for (int s8 = 0; s8 < 8; ++s8) {
                    float vw[8];
#pragma unroll
                    for (int j = 0; j < 8; ++j) {
                        const int s = s8 * 8 + j;
                        const float x3 = xr[s];
                        float v = cb + w0 * x0 + w1 * x1 + w2 * x2 + w3 * x3;
                        v = v / (1.f + __expf(-v));
                        x0 = x1; x1 = x2; x2 = x3;
                        KM[(rowb + t0 + s) * 256 + h * 64 + lane] = f2bf(v);
                        const float wsv = __shfl(w, s);
                        vw[j] = v * wsv; nsum += vw[j];
                    }
                    u32x4 o = {pk2(vw[0], vw[1]), pk2(vw[2], vw[3]), pk2(vw[4], vw[5]), pk2(vw[6], vw[7])};
                    *(u32x4*)(KWT + ((size_t)(b * 256 + h * 64 + lane)) * 4096 + t0 + s8 * 8) = o;
                }
                NC[(size_t)u * 64 + lane] = nsum;
            }
            {
                const int ch = h * 64 + lane;
                const float w0 = P.ab_conv_w[ch], w1 = P.ab_conv_w[512 + ch], w2 = P.ab_conv_w[1024 + ch], w3 = P.ab_conv_w[1536 + ch], cb = P.ab_conv_b[ch];
                const u16* zp = Z0 + 1024 + ch;
                float x0 = 0.f, x1 = 0.f, x2 = 0.f;
                if (t0 > 0) { x0 = bf2f(zp[(rowb + t0 - 3) * 2048]); x1 = bf2f(zp[(rowb + t0 - 2) * 2048]); x2 = bf2f(zp[(rowb + t0 - 1) * 2048]); }
                float xr[64];
#pragma unroll
                for (int s = 0; s < 64; ++s) xr[s] = bf2f(zp[(rowb + t0 + s) * 2048]);
#pragma unroll
                for (int s = 0; s < 64; ++s) {
                    const float x3 = xr[s];
                    float v = cb + w0 * x0 + w1 * x1 + w2 * x2 + w3 * x3;
                    v = v / (1.f + __expf(-v));
                    x0 = x1; x1 = x2; x2 = x3;
                    QM[(rowb + t0 + s) * 256 + h * 64 + lane] = f2bf(v * 0.125f);
                }
            }
        }
    };

    auto ph_3 = [&]() __attribute__((always_inline)) {
        const u16* VT0 = (const u16*)(ws + O_VT0);
        const u16* KT = (const u16*)(ws + O_KT);
        const u16* KWT = (const u16*)(ws + O_KWT);
        float* KVT = (float*)(ws + O_KVT);
        float* UT = (float*)(ws + O_UT);
        for (int u = gw; u < 2048 + 4096; u += ngw) {
            f32x16 a0 = zero16(), a1 = zero16();
            if (u < 2048) {
                const int dt = u & 3, c = (u >> 2) & 31, bh = u >> 7, b = bh >> 2, h = bh & 3, t0 = c * 128;
                const u16* va = VT0 + ((size_t)(b * 1024 + h * 128 + dt * 32 + r)) * 4096 + t0 + 8 * hh;
                const u16* kb = KT + ((size_t)(b * 256 + h * 64 + r)) * 4096 + t0 + 8 * hh;
#pragma unroll
                for (int st = 0; st < 8; ++st) {
                    const bf16x8 a = ld16(va + 16 * st);
                    a0 = MFMA(a, ld16(kb + 16 * st), a0);
                    a1 = MFMA(a, ld16(kb + 32 * 4096 + 16 * st), a1);
                }
                const float cdec = __expf(128.f * gamma_log(h));
                float* o = KVT + (size_t)(bh * 32 + c) * 8192;
#pragma unroll
                for (int i = 0; i < 16; ++i) {
                    o[(dt * 32 + crow(i, hh)) * 64 + r] = cdec * a0[i];
                    o[(dt * 32 + crow(i, hh)) * 64 + 32 + r] = cdec * a1[i];
                }
            } else {
                const int v = u - 2048;
                const int dt = v & 3, c = (v >> 2) & 63, bh = v >> 8, b = bh >> 2, h = bh & 3, t0 = c * 64;
                const u16* va = VT0 + ((size_t)(b * 1024 + 512 + h * 128 + dt * 32 + r)) * 4096 + t0 + 8 * hh;
                const u16* kb = KWT + ((size_t)(b * 256 + h * 64 + r)) * 4096 + t0 + 8 * hh;
#pragma unroll
                for (int st = 0; st < 4; ++st) {
                    const bf16x8 a = ld16(va + 16 * st);
                    a0 = MFMA(a, ld16(kb + 16 * st), a0);
                    a1 = MFMA(a, ld16(kb + 32 * 4096 + 16 * st), a1);
                }
                float* o = UT + (size_t)(bh * 64 + c) * 8192;
#pragma unroll
                for (int i = 0; i < 16; ++i) {
                    o[(dt * 32 + crow(i, hh)) * 64 + r] = a0[i];
                    o[(dt * 32 + crow(i, hh)) * 64 + 32 + r] = a1[i];
                }
            }
        }
    };

    auto ph_4 = [&]() __attribute__((always_inline)) {
        const float* KVT = (const float*)(ws + O_KVT);
        const float* UT = (const float*)(ws + O_UT);
        const float* NC = (const float*)(ws + O_NC);
        const float* BLAST = (const float*)(ws + O_BLAST);
        const float* GC = (const float*)(ws + O_GC);
        u16* RT = (u16*)(ws + O_RT);
        u16* CT = (u16*)(ws + O_CT);
        float* MS = (float*)(ws + O_MS);
        float* NS = (float*)(ws + O_NS);
        for (int e = gtid; e < 131072 * 2 + 1024; e += gsz) {
            if (e < 131072) {
                const int bh = e >> 13, idx = e & 8191;
                const float cdec = __expf(128.f * gamma_log(bh & 3));
                float R = 0.f;
                float kvv[32];
#pragma unroll
                for (int c = 0; c < 32; ++c) kvv[c] = KVT[(size_t)(bh * 32 + c) * 8192 + idx];
#pragma unroll
                for (int c = 0; c < 32; ++c) {
                    RT[(size_t)(bh * 32 + c) * 8192 + idx] = f2bf(R);
                    R = cdec * R + kvv[c];
                }
            } else if (e < 262144) {
                const int e2 = e - 131072, bh = e2 >> 13, idx = e2 & 8191;
                float C = 0.f, m = 0.f;
                float utv[64];
#pragma unroll
                for (int c = 0; c < 64; ++c) utv[c] = UT[(size_t)(bh * 64 + c) * 8192 + idx];
#pragma unroll
                for (int c = 0; c < 64; ++c) {
                    const float G = GC[bh * 64 + c];
                    const float M = fmaxf(m, G);
                    const float dC = __expf(m - M), dU = __expf(G - M);
                    CT[(size_t)(bh * 64 + c) * 8192 + idx] = f2bf(C);
                    if (idx == 0) MS[bh * 64 + c] = m;
                    C = dC * C + dU * utv[c];
                    m = BLAST[bh * 64 + c] + M;
                }
            } else {
                const int e2 = e - 262144, bh = e2 >> 6, dk = e2 & 63;
                float n = 0.f, m = 0.f;
                for (int c = 0; c < 64; ++c) {
                    const float G = GC[bh * 64 + c];
                    const float M = fmaxf(m, G);
                    const float dC = __expf(m - M), dU = __expf(G - M);
                    NS[(size_t)(bh * 64 + c) * 64 + dk] = n;
                    n = dC * n + dU * NC[(size_t)(bh * 64 + c) * 64 + dk];
                    m = BLAST[bh * 64 + c] + M;
                }
            }
        }
    };

    auto ph_5 = [&]() __attribute__((always_inline)) {
        const u16* Z0 = (const u16*)P.out;
        const u16* VT0 = (const u16*)(ws + O_VT0);
        const u16* RT = (const u16*)(ws + O_RT);
        const u16* CT = (const u16*)(ws + O_CT);
        const u16* QM = (const u16*)(ws + O_QM);
        const u16* KM = (const u16*)(ws + O_KM);
        const float* GS = (const float*)(ws + O_GS); const float* BL = (const float*)(ws + O_BL); const float* PM = (const float*)(ws + O_PM);
        const float* MS = (const float*)(ws + O_MS); const float* NS = (const float*)(ws + O_NS);
        u16* MIX = HB0;
        for (int u = gw; u < 4096; u += ngw) {
            f32x16 o[4];
            if (u < 2048) {
                const int qt = u & 3, c = (u >> 2) & 31, bh = u >> 7, b = bh >> 2, h = bh & 3, t0 = c * 128, tq = t0 + qt * 32;
                const size_t rowb = (size_t)b * 4096;
                bf16x8 bq[4];
#pragma unroll
                for (int st = 0; st < 4; ++st) bq[st] = ld16(Z0 + (rowb + tq + r) * 2048 + h * 64 + 16 * st + 8 * hh);
                const u16* rt = RT + (size_t)(bh * 32 + c) * 8192;
#pragma unroll
                for (int dt = 0; dt < 4; ++dt) {
                    o[dt] = zero16();
#pragma unroll
                    for (int st = 0; st < 4; ++st) o[dt] = MFMA(ld16(rt + (dt * 32 + r) * 64 + 16 * st + 8 * hh), bq[st], o[dt]);
                }
                for (int kt = 0; kt <= qt; ++kt) {
                    f32x16 s = zero16();
#pragma unroll
                    for (int st = 0; st < 4; ++st) s = MFMA(ld16(Z0 + (rowb + t0 + kt * 32 + r) * 2048 + 256 + h * 64 + 16 * st + 8 * hh), bq[st], s);
                    if (kt == qt) {
#pragma unroll
                        for (int i = 0; i < 16; ++i) if (crow(i, hh) > r) s[i] = 0.f;
                    }
#pragma unroll
                    for (int s2 = 0; s2 < 2; ++s2) {
                        const bf16x8 pb = packp(s, s2);
#pragma unroll
                        for (int dt = 0; dt < 4; ++dt) {
                            const u16* vp = VT0 + ((size_t)(b * 1024 + h * 128 + dt * 32 + r)) * 4096 + t0 + kt * 32 + 16 * s2 + 4 * hh;
                            o[dt] = MFMA(ld8x2(vp, vp + 8), pb, o[dt]);
                        }
                    }
                }
                const float qdec = __expf((float)(qt * 32 + r + 1) * gamma_log(h));
                float ss = 0.f;
#pragma unroll
                for (int dt = 0; dt < 4; ++dt)
#pragma unroll
                    for (int i = 0; i < 16; ++i) { o[dt][i] *= qdec; ss += o[dt][i] * o[dt][i]; }
                ss += __shfl_xor(ss, 32);
                const float rs = rsqrtf(ss * (1.f / 128.f) + EPS);
                const size_t row = rowb + tq + r;
#pragma unroll
                for (int dt = 0; dt < 4; ++dt)
#pragma unroll
                    for (int i4 = 0; i4 < 4; ++i4) {
                        const int dv = dt * 32 + 8 * i4 + 4 * hh;
                        const u32x2 gv = *(const u32x2*)(Z0 + row * 2048 + 512 + h * 128 + dv);
                        const float g0 = bflo(gv.x), g1 = bfhi(gv.x), g2 = bflo(gv.y), g3 = bfhi(gv.y);
                        const float4 ng = *(const float4*)(P.ab_ret_norm_g + h * 128 + dv);
                        const float y0 = o[dt][i4 * 4 + 0] * rs * ng.x * (g0 * sigmoidf_(g0));
                        const float y1 = o[dt][i4 * 4 + 1] * rs * ng.y * (g1 * sigmoidf_(g1));
                        const float y2 = o[dt][i4 * 4 + 2] * rs * ng.z * (g2 * sigmoidf_(g2));
                        const float y3 = o[dt][i4 * 4 + 3] * rs * ng.w * (g3 * sigmoidf_(g3));
                        u32x2 ov = {pk2(y0, y1), pk2(y2, y3)};
                        *(u32x2*)(MIX + row * 1024 + h * 128 + dv) = ov;
                    }
            } else {
                const int v = u - 2048;
                const int qt = v & 1, c = (v >> 1) & 63, bh = v >> 7, b = bh >> 2, h = bh & 3, t0 = c * 64, tq = t0 + qt * 32;
                const size_t rowb = (size_t)b * 4096;
                const size_t row = rowb + tq + r;
                const float mc = MS[bh * 64 + c];
                const float Ml = fmaxf(mc, PM[bh * 4096 + tq + r]);
                const float bl = BL[bh * 4096 + tq + r];
                const float wint = __expf(mc - Ml);
                bf16x8 bq[4];
#pragma unroll
                for (int st = 0; st < 4; ++st) bq[st] = ld16(QM + row * 256 + h * 64 + 16 * st + 8 * hh);
                const u16* ct = CT + (size_t)(bh * 64 + c) * 8192;
#pragma unroll
                for (int dt = 0; dt < 4; ++dt) {
                    o[dt] = zero16();
#pragma unroll
                    for (int st = 0; st < 4; ++st) o[dt] = MFMA(ld16(ct + (dt * 32 + r) * 64 + 16 * st + 8 * hh), bq[st], o[dt]);
#pragma unroll
                    for (int i = 0; i < 16; ++i) o[dt][i] *= wint;
                }
                float qn = 0.f;
                {
                    const u16* qp = QM + row * 256 + h * 64 + 32 * hh;
                    const float* np = NS + (size_t)(bh * 64 + c) * 64 + 32 * hh;
#pragma unroll
                    for (int j = 0; j < 32; ++j) qn += bf2f(qp[j]) * np[j];
                    qn += __shfl_xor(qn, 32);
                }
                float den = 0.f;
                for (int kt = 0; kt <= qt; ++kt) {
                    f32x16 s = zero16();
#pragma unroll
                    for (int st = 0; st < 4; ++st) s = MFMA(ld16(KM + (rowb + t0 + kt * 32 + r) * 256 + h * 64 + 16 * st + 8 * hh), bq[st], s);
#pragma unroll
                    for (int i4 = 0; i4 < 4; ++i4) {
                        const float4 gg = *(const float4*)(GS + bh * 4096 + t0 + kt * 32 + 8 * i4 + 4 * hh);
                        const float ga[4] = {gg.x, gg.y, gg.z, gg.w};
#pragma unroll
                        for (int j = 0; j < 4; ++j) {
                            const int i = i4 * 4 + j;
                            float d = __expf(ga[j] - Ml);
                            if (kt == qt && crow(i, hh) > r) d = 0.f;
                            s[i] *= d; den += s[i];
                        }
                    }
#pragma unroll
                    for (int s2 = 0; s2 < 2; ++s2) {
                        const bf16x8 pb = packp(s, s2);
#pragma unroll
                        for (int dt = 0; dt < 4; ++dt) {
                            const u16* vp = VT0 + ((size_t)(b * 1024 + 512 + h * 128 + dt * 32 + r)) * 4096 + t0 + kt * 32 + 16 * s2 + 4 * hh;
                            o[dt] = MFMA(ld8x2(vp, vp + 8), pb, o[dt]);
                        }
                    }
                }
                den += __shfl_xor(den, 32);
                den += wint * qn;
                const float dinv = 1.f / fmaxf(fabsf(den), __expf(-(bl + Ml)));
                float ss = 0.f;
#pragma unroll
                for (int dt = 0; dt < 4; ++dt)
#pragma unroll
                    for (int i = 0; i < 16; ++i) { o[dt][i] *= dinv; ss += o[dt][i] * o[dt][i]; }
                ss += __shfl_xor(ss, 32);
                const float rs = rsqrtf(ss * (1.f / 128.f) + EPS);
#pragma unroll
                for (int dt = 0; dt < 4; ++dt)
#pragma unroll
                    for (int i4 = 0; i4 < 4; ++i4) {
                        const int dv = dt * 32 + 8 * i4 + 4 * hh;
                        const u32x2 gv = *(const u32x2*)(Z0 + row * 2048 + 1536 + h * 128 + dv);
                        const float4 ng = *(const float4*)(P.ab_m_norm_g + h * 128 + dv);
                        const float y0 = o[dt][i4 * 4 + 0] * rs * ng.x * sigmoidf_(bflo(gv.x));
                        const float y1 = o[dt][i4 * 4 + 1] * rs * ng.y * sigmoidf_(bfhi(gv.x));
                        const float y2 = o[dt][i4 * 4 + 2] * rs * ng.z * sigmoidf_(bflo(gv.y));
                        const float y3 = o[dt][i4 * 4 + 3] * rs * ng.w * sigmoidf_(bfhi(gv.y));
                        u32x2 ov = {pk2(y0, y1), pk2(y2, y3)};
                        *(u32x2*)(MIX + row * 1024 + 512 + h * 128 + dv) = ov;
                    }
            }
        }
    };

    auto resid_gemm = [&](const u16* A, int lda, const u16* Wt, int K, const float* resid, u16* hb_out, u64* ss_out, float scale) __attribute__((always_inline)) {
        for (int tile = blk; tile < tile_bound(128, 8); tile += nblk) {
            int mt, nt; if (!tile_decode(tile, 128, 8, mt, nt)) continue;
            const int m0 = mt * 128, n0 = nt * 128;
            f32x16 acc[2][2];
            const u16* Ab = A + (size_t)m0 * lda;
            gemm_main<false>(acc, [&](int row) { return Ab + (size_t)row * lda; }, 1, Wt, K, n0, K, As, Bs);
            const size_t rbase = (size_t)(m0 + wm * 64 + 4 * hh) * 1024 + n0 + wn * 64 + r;
            float rv[2][2][16];
#pragma unroll
            for (int mi = 0; mi < 2; ++mi)
#pragma unroll
                for (int ni = 0; ni < 2; ++ni)
#pragma unroll
                    for (int i = 0; i < 16; ++i) rv[mi][ni][i] = resid[rbase + (size_t)(mi * 32 + (i & 3) + 8 * (i >> 2)) * 1024 + ni * 32];
            float sqv[2][16];
#pragma unroll
            for (int mi = 0; mi < 2; ++mi)
#pragma unroll
                for (int i = 0; i < 16; ++i) {
                    float sq = 0.f;
#pragma unroll
                    for (int ni = 0; ni < 2; ++ni) {
                        const size_t o = rbase + (size_t)(mi * 32 + (i & 3) + 8 * (i >> 2)) * 1024 + ni * 32;
                        const float hv = rv[mi][ni][i] + scale * acc[mi][ni][i];
                        P.out[o] = hv;
                        if (hb_out) hb_out[o] = f2bf(hv);
                        sq += hv * hv;
                    }
                    sqv[mi][i] = sq;
                }
            if (ss_out) {
#pragma unroll
                for (int mi = 0; mi < 2; ++mi)
#pragma unroll
                    for (int i = 0; i < 16; ++i) {
                        const float s = red32(sqv[mi][i]);
                        if (r == 0) atomicAdd(ss_out + (m0 + wm * 64 + mi * 32 + crow(i, hh)), ss_fix(s));
                    }
            }
        }
    };
    auto ffn_up_phase = [&](int li, const u16* hb, const u64* ss_in, u64* sse, bool do_ss) __attribute__((always_inline)) {
        const u16* Wt = (const u16*)(ws + O_WUP + li * SZ_WUP);
        const u16* Wp = (const u16*)(ws + O_WPLE + li * SZ_WPLE);
        u16* ACT = (u16*)(ws + O_ACT);
        u16* ERAW = (u16*)(ws + O_ERAW);
        const float* cw = P.ffn_conv_w + li * 3 * 2816;
        const float* cb = P.ffn_conv_b + li * 2816;
        const float* pin = P.p + (size_t)li * MT * 256;
        u16* SA = (u16*)smem;
        u16* SB = SA + 128 * 66;
        for (int pass = 0; pass < 2; ++pass)
        for (int tile = blk; tile < (pass ? tile_bound(128, 8) : tile_bound(132, 44)); tile += nblk) {
            f32x16 acc[2][2];
            int mt, nt; if (!tile_decode(tile, pass ? 128 : 132, pass ? 8 : 44, mt, nt)) continue;
            if (pass == 0) {
                const int b = mt / 33, jt = mt % 33, tok0 = jt * 126 - 2, n0 = nt * 128;
                const u16* Ab = hb + (size_t)b * 4096 * DM;
                gemm_main<false>(acc, [&](int row) { int tk = tok0 + row; tk = tk < 0 ? 0 : (tk > 4095 ? 4095 : tk); return Ab + (size_t)tk * DM; }, 1, Wt, 1024, n0, 1024, As, Bs);
                __syncthreads();
#pragma unroll
                for (int mi = 0; mi < 2; ++mi)
#pragma unroll
                    for (int i = 0; i < 16; ++i) {
                        const int rl = wm * 64 + mi * 32 + crow(i, hh);
                        const int tok = tok0 + rl;
                        const int tkc = tok < 0 ? 0 : (tok > 4095 ? 4095 : tok);
                        const float rs = ss_rstd(ss_in[b * 4096 + tkc]);
#pragma unroll
                        for (int ni = 0; ni < 2; ++ni) {
                            float v = acc[mi][ni][i] * rs;
                            if (tok < 0) v = 0.f;
                            (wn == 0 ? SA : SB)[rl * 66 + ni * 32 + r] = f2bf(v);
                        }
                    }
                __syncthreads();
                for (int e = tid; e < 126 * 64; e += 256) {
                    const int rl = 2 + (e >> 6), cl = e & 63, tok = tok0 + rl;
                    if (tok < 4096) {
                        const int f = nt * 64 + cl;
                        const float a = cb[f] + cw[f] * bf2f(SA[(rl - 2) * 66 + cl]) + cw[2816 + f] * bf2f(SA[(rl - 1) * 66 + cl]) + cw[5632 + f] * bf2f(SA[rl * 66 + cl]);
                        ACT[((size_t)b * 4096 + tok) * 2816 + f] = f2bf(gelu_tanh(a) * bf2f(SB[rl * 66 + cl]));
                    }
                }
            } else {
                const int m0 = mt * 128, n0 = nt * 128;
                const float* Ab = pin + (size_t)m0 * 256;
                gemm_main<true>(acc, [&](int row) { return Ab + (size_t)row * 256; }, 1, Wp, 256, n0, 256, As, Bs);
#pragma unroll
                for (int mi = 0; mi < 2; ++mi)
#pragma unroll
                    for (int i = 0; i < 16; ++i) {
                        const size_t row = m0 + wm * 64 + mi * 32 + crow(i, hh);
                        float sq = 0.f;
#pragma unroll
                        for (int ni = 0; ni < 2; ++ni) {
                            const int col = n0 + wn * 64 + ni * 32 + r;
                            const float v = acc[mi][ni][i];
                            ERAW[row * 1024 + col] = f2bf(v);
                            sq += v * v;
                        }
                        sq = red32(sq); if (do_ss && r == 0) atomicAdd(sse + row, ss_fix(sq));
                    }
            }
        }
    };
    auto gate_phase = [&](int li, const u16* hb, const u64* ss_in, const u64* sse, u16* hb_out, u64* ss_out, float scale) __attribute__((always_inline)) {
        const u16* Wt = (const u16*)(ws + O_WGATE + li * SZ_WGATE);
        const u16* ERAW = (const u16*)(ws + O_ERAW);
        const float* eg = P.ple_norm_g + li * 1024;
        for (int tile = blk; tile < tile_bound(128, 8); tile += nblk) {
            int mt, nt; if (!tile_decode(tile, 128, 8, mt, nt)) continue;
            const int m0 = mt * 128, n0 = nt * 128;
            f32x16 acc[2][2];
            const u16* Ab = hb + (size_t)m0 * DM;
            gemm_main<false>(acc, [&](int row) { return Ab + (size_t)row * DM; }, 1, Wt, 1024, n0, 1024, As, Bs);
            const size_t rbase = (size_t)(m0 + wm * 64 + 4 * hh) * 1024 + n0 + wn * 64 + r;
            float ov[2][2][16], ev[2][2][16], rsv[2][16], rev[2][16];
#pragma unroll
            for (int mi = 0; mi < 2; ++mi)
#pragma unroll
                for (int i = 0; i < 16; ++i) {
                    const int row = m0 + wm * 64 + mi * 32 + crow(i, hh);
                    rsv[mi][i] = ss_rstd(ss_in[row]);
                    rev[mi][i] = ss_rstd(sse[row]);
#pragma unroll
                    for (int ni = 0; ni < 2; ++ni) {
                        const size_t o = rbase + (size_t)(mi * 32 + (i & 3) + 8 * (i >> 2)) * 1024 + ni * 32;
                        ov[mi][ni][i] = P.out[o];
                        ev[mi][ni][i] = bf2f(ERAW[o]);
                    }
                }
            const float eg0 = eg[n0 + wn * 64 + r], eg1 = eg[n0 + wn * 64 + 32 + r];
            float sqv[2][16];
#pragma unroll
            for (int mi = 0; mi < 2; ++mi)
#pragma unroll
                for (int i = 0; i < 16; ++i) {
                    float sq = 0.f;
#pragma unroll
                    for (int ni = 0; ni < 2; ++ni) {
                        const size_t o = rbase + (size_t)(mi * 32 + (i & 3) + 8 * (i >> 2)) * 1024 + ni * 32;
                        const float gt = sigmoidf_(acc[mi][ni][i] * rsv[mi][i]);
                        const float e = ev[mi][ni][i] * rev[mi][i] * (ni ? eg1 : eg0);
                        const float hv = ov[mi][ni][i] + scale * gt * e;
                        P.out[o] = hv;
                        if (hb_out) hb_out[o] = f2bf(hv);
                        sq += hv * hv;
                    }
                    sqv[mi][i] = sq;
                }
            if (ss_out) {
#pragma unroll
                for (int mi = 0; mi < 2; ++mi)
#pragma unroll
                    for (int i = 0; i < 16; ++i) {
                        const float s = red32(sqv[mi][i]);
                        if (r == 0) atomicAdd(ss_out + (m0 + wm * 64 + mi * 32 + crow(i, hh)), ss_fix(s));
                    }
            }
        }
    };

    auto ph_6 = [&](bool dry) __attribute__((always_inline)) { if (!dry) resid_gemm(HB0, 1024, (const u16*)(ws + O_WABOUT), 1024, P.x, HB1, SS + 1 * MT, 1.f); else resid_gemm(HB0, 1024, (const u16*)(ws + O_WABOUT), 1024, P.out, (u16*)nullptr, (u64*)nullptr, 0.f); };
    auto ph_7 = [&](bool dry) __attribute__((always_inline)) { ffn_up_phase(0, HB1, SS + 1 * MT, SS + 6 * MT, !dry); };
    auto ph_8 = [&](bool dry) __attribute__((always_inline)) { if (!dry) resid_gemm((const u16*)(ws + O_ACT), 2816, (const u16*)(ws + O_WDOWN), 2816, P.out, HB0, SS + 2 * MT, 1.f); else resid_gemm((const u16*)(ws + O_ACT), 2816, (const u16*)(ws + O_WDOWN), 2816, P.out, (u16*)nullptr, (u64*)nullptr, 0.f); };
    auto ph_9 = [&](bool dry) __attribute__((always_inline)) { if (!dry) gate_phase(0, HB0, SS + 2 * MT, SS + 6 * MT, HB1, SS + 3 * MT, 1.f); else gate_phase(0, HB0, SS + 2 * MT, SS + 6 * MT, (u16*)nullptr, (u64*)nullptr, 0.f); };

    auto ph_10 = [&]() __attribute__((always_inline)) {
        const u16* Wt = (const u16*)(ws + O_WNSAIN);
        u16* QN = (u16*)(ws + O_QN); u16* KCVC = (u16*)(ws + O_KCVC); u16* KSN = (u16*)(ws + O_KSN); u16* KWN = (u16*)(ws + O_KWN);
        u16* VST = (u16*)(ws + O_VST); u16* VWT = (u16*)(ws + O_VWT); float* GT1 = (float*)(ws + O_GT1);
        const u64* ssin = SS + 3 * MT;
        for (int tile = blk; tile < tile_bound(128, 15); tile += nblk) {
            int mt, nt; if (!tile_decode(tile, 128, 15, mt, nt)) continue;
            const int m0 = mt * 128, n0 = nt * 128;
            f32x16 acc[2][2];
            const u16* Ab = HB1 + (size_t)m0 * DM;
            gemm_main<false>(acc, [&](int row) { return Ab + (size_t)row * DM; }, 1, Wt, 1024, n0, 1024, As, Bs);
            const int colw = n0 + wn * 64;
            float rsv[2][16];
#pragma unroll
            for (int mi = 0; mi < 2; ++mi)
#pragma unroll
                for (int i = 0; i < 16; ++i) rsv[mi][i] = ss_rstd(ssin[m0 + wm * 64 + mi * 32 + crow(i, hh)]);
#pragma unroll
            for (int mi = 0; mi < 2; ++mi) {
#pragma unroll
                for (int i4 = 0; i4 < 4; ++i4) {
                    float v0[4], v1[4];
                    const int rowb = m0 + wm * 64 + mi * 32 + 8 * i4 + 4 * hh;
#pragma unroll
                    for (int j = 0; j < 4; ++j) {
                        const float rs = rsv[mi][i4 * 4 + j];
                        v0[j] = acc[mi][0][i4 * 4 + j] * rs;
                        v1[j] = acc[mi][1][i4 * 4 + j] * rs;
                    }
                    const int bb = rowb >> 12, t = rowb & 4095;
                    if (nt < 8 || nt == 10 || nt == 12) {
                        const float* gn = (nt < 8) ? P.nsa_q_norm_g : (nt == 10 ? P.nsa_k_norm_g + 64 : P.nsa_k_norm_g + 128);
                        const float g0 = gn[r], g1 = gn[32 + r];
                        const float sc = (nt < 8) ? 0.125f * 1.4426950408889634f : 1.f;
#pragma unroll
                        for (int j = 0; j < 4; ++j) {
                            const float ss = red32(v0[j] * v0[j] + v1[j] * v1[j]);
                            const float rn = rsqrtf(ss * (1.f / 64.f) + EPS) * sc;
                            const u16 y0 = f2bf(v0[j] * rn * g0), y1 = f2bf(v1[j] * rn * g1);
                            if (nt < 8) { QN[(size_t)(rowb + j) * 1024 + colw + r] = y0; QN[(size_t)(rowb + j) * 1024 + colw + 32 + r] = y1; }
                            else {
                                u16* dst = (nt == 10) ? KSN : KWN;
                                dst[(size_t)(rowb + j) * 128 + wn * 64 + r] = y0; dst[(size_t)(rowb + j) * 128 + wn * 64 + 32 + r] = y1;
                            }
                        }
                    } else if (nt == 8 || nt == 9) {
                        const int cc = (nt - 8) * 128 + wn * 64;
#pragma unroll
                        for (int j = 0; j < 4; ++j) {
                            KCVC[(size_t)(rowb + j) * 256 + cc + r] = f2bf(v0[j]);
                            KCVC[(size_t)(rowb + j) * 256 + cc + 32 + r] = f2bf(v1[j]);
                        }
                    } else if (nt == 11 || nt == 13) {
                        u16* dst = (nt == 11) ? VST : VWT;
                        u32x2 o0 = {pk2(v0[0], v0[1]), pk2(v0[2], v0[3])}, o1 = {pk2(v1[0], v1[1]), pk2(v1[2], v1[3])};
                        *(u32x2*)(dst + ((size_t)(bb * 128 + wn * 64 + r)) * 4096 + t) = o0;
                        *(u32x2*)(dst + ((size_t)(bb * 128 + wn * 64 + 32 + r)) * 4096 + t) = o1;
                    } else {
                        if (wn == 0) {
#pragma unroll
                            for (int j = 0; j < 4; ++j) {
                                GT1[(size_t)(rowb + j) * 48 + r] = sigmoidf_(v0[j] + P.nsa_gate_b[r]);
                                if (r < 16) GT1[(size_t)(rowb + j) * 48 + 32 + r] = sigmoidf_(v1[j] + P.nsa_gate_b[32 + r]);
                            }
                        }
                    }
                }
            }
        }
    };

    auto ph_11 = [&]() __attribute__((always_inline)) {
        const u16* KCVC = (const u16*)(ws + O_KCVC);
        u16* HID = (u16*)(ws + O_HID);
        const float* B1 = (const float*)(ws + O_BIAS1);
        for (int tile = RB(5, blk, nblk); tile < 64; tile += RS(5, nblk)) {
            const int kv = tile >> 5, mt = (tile >> 1) & 15, nt = tile & 1, m0 = mt * 128, n0 = nt * 128;
            const u16* Wt = (const u16*)(ws + (kv ? O_WC1V : O_WC1K));
            f32x16 acc[2][2];
            gemm_main<false>(acc, [&](int row) {
                int R = m0 + row; R = R > 2039 ? 2039 : R;
                const int bg = R / 255, n = R - bg * 255, b = bg >> 1, g = bg & 1;
                return KCVC + ((size_t)b * 4096 + 16 * n) * 256 + kv * 128 + g * 64;
            }, 4, Wt, 2048, n0, 2048, As, Bs);
#pragma unroll
            for (int mi = 0; mi < 2; ++mi)
#pragma unroll
                for (int i = 0; i < 16; ++i) {
                    const int R = m0 + wm * 64 + mi * 32 + crow(i, hh);
#pragma unroll
                    for (int ni = 0; ni < 2; ++ni) {
                        const int col = n0 + wn * 64 + ni * 32 + r;
                        if (R < 2040) HID[((size_t)kv * 2048 + R) * 256 + col] = f2bf(gelu_tanh(acc[mi][ni][i] + B1[kv * 256 + col]));
                    }
                }
        }
    };

    auto ph_12 = [&]() __attribute__((always_inline)) {
        const u16* HID = (const u16*)(ws + O_HID);
        u16* KCN = (u16*)(ws + O_KCN);
        u16* VCT = (u16*)(ws + O_VCT);
        for (int tile = RB(6, blk, nblk); tile < 32; tile += RS(6, nblk)) {
            const int kv = tile >> 4, mt = tile & 15, m0 = mt * 128;
            const u16* Wt = (const u16*)(ws + (kv ? O_WC2V : O_WC2K));
            const u16* Ab = HID + ((size_t)kv * 2048 + m0) * 256;
            f32x16 acc[2][2];
            gemm_main<false>(acc, [&](int row) { return Ab + (size_t)row * 256; }, 1, Wt, 256, 0, 256, As, Bs);
            if (wn == 0) {
#pragma unroll
                for (int mi = 0; mi < 2; ++mi)
#pragma unroll
                    for (int i = 0; i < 16; ++i) {
                        const int R = m0 + wm * 64 + mi * 32 + crow(i, hh);
                        const float v0 = acc[mi][0][i], v1 = acc[mi][1][i];
                        const float ss = red32(v0 * v0 + v1 * v1);
                        if (R < 2040) {
                            const int bg = R / 255, n = R - bg * 255;
                            if (kv == 0) {
                                const float rn = rsqrtf(ss * (1.f / 64.f) + EPS);
                                KCN[((size_t)bg * 256 + n) * 64 + r] = f2bf(v0 * rn * P.nsa_k_norm_g[r]);
                                KCN[((size_t)bg * 256 + n) * 64 + 32 + r] = f2bf(v1 * rn * P.nsa_k_norm_g[32 + r]);
                            } else {
                                VCT[((size_t)bg * 64 + r) * 256 + n] = f2bf(v0);
                                VCT[((size_t)bg * 64 + 32 + r) * 256 + n] = f2bf(v1);
                            }
                        }
                    }
            }
        }
        for (int u = gtid; u < 8 * 64; u += gsz) { KCN[((size_t)(u >> 6) * 256 + 255) * 64 + (u & 63)] = 0; VCT[((size_t)u) * 256 + 255] = 0; }
    };

    auto ph_13 = [&]() __attribute__((always_inline)) {
        const u16* QN = (const u16*)(ws + O_QN);
        const u16* KCN = (const u16*)(ws + O_KCN);
        const u16* VCT = (const u16*)(ws + O_VCT);
        const float* GT1 = (const float*)(ws + O_GT1);
        u16* OCMP = (u16*)(ws + O_OCMP);
        u64* SEL = (u64*)(ws + O_SEL);
        int rnd = 0;
        for (int it = blk; it < 512; it += nblk, ++rnd) {
            const int bg = it >> 6, qp = it & 63, hsel = wave & 1;
            const int qt = (((wave >> 1) ^ rnd) & 1) ? 127 - qp : qp;
            const int b = bg >> 1, g = bg & 1, tq = qt * 32, t = tq + r;
            const size_t row = (size_t)b * 4096 + t;
            const int nkt = (tq >> 9) + 1;
            u16* kl = (u16*)smem;
            u16* vl = kl + 256 * 72;
            __syncthreads();
#pragma unroll
            for (int c8 = 0; c8 < 8; ++c8) {
                const int c = tid + 256 * c8;
                *(u32x4*)(kl + (c >> 3) * 72 + (c & 7) * 8) = *(const u32x4*)(KCN + ((size_t)bg * 256 + (c >> 3)) * 64 + (c & 7) * 8);
                *(u32x4*)(vl + (c >> 5) * 264 + (c & 31) * 8) = *(const u32x4*)(VCT + ((size_t)bg * 64 + (c >> 5)) * 256 + (c & 31) * 8);
            }
            __syncthreads();
            f32x16 imp[2];
            imp[0] = zero16(); imp[1] = zero16();
            for (int hg = hsel * 4; hg < hsel * 4 + 4; ++hg) {
                const int head = g * 8 + hg;
                bf16x8 bq[4];
#pragma unroll
                for (int st = 0; st < 4; ++st) bq[st] = ld16(QN + row * 1024 + head * 64 + 16 * st + 8 * hh);
                float m = -1e30f, l = 0.f;
                for (int kt = 0; kt < nkt; ++kt) {
                    f32x16 s = zero16();
#pragma unroll
                    for (int st = 0; st < 4; ++st) s = MFMA(ld16(kl + (kt * 32 + r) * 72 + 16 * st + 8 * hh), bq[st], s);
                    float mx = -1e30f;
#pragma unroll
                    for (int i = 0; i < 16; ++i) {
                        const int n = kt * 32 + crow(i, hh);
                        if (16 * n + 31 > t) s[i] = -1e30f;
                        mx = fmaxf(mx, s[i]);
                    }
                    mx = fmaxf(mx, __shfl_xor(mx, 32));
                    const float mn = fmaxf(m, mx);
                    float ps = 0.f;
#pragma unroll
                    for (int i = 0; i < 16; ++i) ps += __builtin_amdgcn_exp2f(s[i] - mn);
                    l = l * __builtin_amdgcn_exp2f(m - mn) + ps;
                    m = mn;
                }
                l += __shfl_xor(l, 32);
                const float inv = (t >= 31) ? 1.f / l : 0.f;
                f32x16 ao[2];
                ao[0] = zero16(); ao[1] = zero16();
                for (int kt = 0; kt < nkt; ++kt) {
                    f32x16 s = zero16();
#pragma unroll
                    for (int st = 0; st < 4; ++st) s = MFMA(ld16(kl + (kt * 32 + r) * 72 + 16 * st + 8 * hh), bq[st], s);
#pragma unroll
                    for (int i = 0; i < 16; ++i) {
                        const int n = kt * 32 + crow(i, hh);
                        s[i] = (16 * n + 31 > t) ? 0.f : __builtin_amdgcn_exp2f(s[i] - m) * inv;
                    }
#pragma unroll
                    for (int s2 = 0; s2 < 2; ++s2) {
                        const bf16x8 pb = packp(s, s2);
#pragma unroll
                        for (int dt = 0; dt < 2; ++dt) {
                            const u16* vp = vl + (dt * 32 + r) * 264 + kt * 32 + 16 * s2 + 4 * hh;
                            ao[dt] = MFMA(ld8x2(vp, vp + 8), pb, ao[dt]);
                        }
#pragma unroll
                        for (int bt = 0; bt < 2; ++bt) {
                            const int sb = bt * 32 + r;
                            bf16x8 ov;
#pragma unroll
                            for (int j = 0; j < 8; ++j) {
                                const int n = kt * 32 + 16 * s2 + 8 * (j >> 2) + 4 * hh + (j & 3);
                                ov[j] = (n >= 4 * sb - 1 && n <= 4 * sb + 3) ? (short)0x3F80 : (short)0;
                            }
                            imp[bt] = MFMA(ov, pb, imp[bt]);
                        }
                    }
                }
                const float g0 = GT1[row * 48 + head * 3 + 0];
#pragma unroll
                for (int dt = 0; dt < 2; ++dt)
#pragma unroll
                    for (int i4 = 0; i4 < 4; ++i4) {
                        const int d = dt * 32 + 8 * i4 + 4 * hh;
                        u32x2 ov = {pk2(ao[dt][i4 * 4 + 0] * g0, ao[dt][i4 * 4 + 1] * g0), pk2(ao[dt][i4 * 4 + 2] * g0, ao[dt][i4 * 4 + 3] * g0)};
                        *(u32x2*)(OCMP + row * 1024 + head * 64 + d) = ov;
                    }
            }
            __syncthreads();
            {
                float* mine = (float*)smem + wave * (32 * 65);
#pragma unroll
                for (int bt = 0; bt < 2; ++bt)
#pragma unroll
                    for (int i = 0; i < 16; ++i) mine[r * 65 + bt * 32 + crow(i, hh)] = imp[bt][i];
            }
            __syncthreads();
            {
                const float* pa0 = (const float*)smem + (wave & 2) * (32 * 65);
                const float* pa1 = pa0 + 32 * 65;
                for (int q = hsel * 16; q < hsel * 16 + 16; ++q) {
                    const int cur = (tq + q) >> 6;
                    const float ip = pa0[q * 65 + lane] + pa1[q * 65 + lane];
                    const bool forced = (lane == 0) || (lane == cur) || (lane == cur - 1);
                    const float v = forced ? 1e30f : (lane <= cur ? ip : -1e30f);
                    int cnt = 0;
                    for (int sp = 0; sp < 64; ++sp) {
                        const float c = __shfl(v, sp);
                        cnt += ((c > v) || (c == v && sp < lane)) ? 1 : 0;
                    }
                    const u64 mask = __ballot(cnt < 16);
                    if (lane == 0) SEL[(size_t)bg * 4096 + tq + q] = mask;
                }
            }
        }
        __syncthreads();
    };

    auto ph_14 = [&]() __attribute__((always_inline)) {
        const u16* QN = (const u16*)(ws + O_QN);
        const u16* KSN = (const u16*)(ws + O_KSN); const u16* KWN = (const u16*)(ws + O_KWN);
        const u16* VST = (const u16*)(ws + O_VST); const u16* VWT = (const u16*)(ws + O_VWT);
        const float* GT1 = (const float*)(ws + O_GT1);
        const u16* OCMP = (const u16*)(ws + O_OCMP);
        const u64* SEL = (const u64*)(ws + O_SEL);
        u16* OBUF = (u16*)(ws + O_OBUF);
        constexpr int KST = 72, VSTR = 40, BUFEL = 32 * KST + 64 * VSTR;
        u16* stage = (u16*)smem;
        int* tl = (int*)(stage + 2 * BUFEL);
        for (int item = blk; item < 1024; item += nblk) {
            const int kk = item / nblk, v = item - kk * nblk;
            const int q0 = v & 127, bg = (nblk == 256) ? ((v >> 7) * 4 + kk) : (item >> 7);
            const int qt = (nblk == 256) ? ((kk & 1) ? 127 - q0 : q0) : (item & 127);
            const int b = bg >> 1, g = bg & 1, tq = qt * 32, t = tq + r;
            const size_t rowb = (size_t)b * 4096, row = rowb + t;
            const int h0 = g * 8 + wave * 2;
            bf16x8 bq[2][4];
#pragma unroll
            for (int hd = 0; hd < 2; ++hd)
#pragma unroll
                for (int st = 0; st < 4; ++st) bq[hd][st] = ld16(QN + row * 1024 + (h0 + hd) * 64 + 16 * st + 8 * hh);
            const u64 selm = SEL[(size_t)bg * 4096 + t];
            unsigned ulo = (unsigned)selm, uhi = (unsigned)(selm >> 32);
#pragma unroll
            for (int off = 1; off < 32; off <<= 1) { ulo |= __shfl_xor(ulo, off); uhi |= __shfl_xor(uhi, off); }
            const u64 uni = ((u64)uhi << 32) | ulo;
            __syncthreads();
            if (tid == 0) {
                int n = 0;
                for (int kt = (qt > 16 ? qt - 16 : 0); kt <= qt; ++kt) tl[n++] = kt | (1 << 16);
                const int jmax = (tq + 31) >> 6;
                for (int j = 0; j <= jmax; ++j)
                    if ((uni >> j) & 1ull) { tl[n++] = 2 * j; if ((2 * j + 1) * 32 <= tq + 31) tl[n++] = 2 * j + 1; }
                tl[159] = n;
            }
            __syncthreads();
            const int ntile = tl[159];
            u32x4 kr[3], vr[3];
            auto ldt = [&](u32x4& kreg, u32x4& vreg, int e) __attribute__((always_inline)) {
                const int kt = e & 0xffff, br = e >> 16;
                const u16* Kp = br ? KWN : KSN;
                const u16* Vp = br ? VWT : VST;
                kreg = *(const u32x4*)(Kp + (rowb + kt * 32 + (tid >> 3)) * 128 + g * 64 + (tid & 7) * 8);
                vreg = *(const u32x4*)(Vp + ((size_t)(b * 128 + g * 64 + (tid >> 2))) * 4096 + kt * 32 + (tid & 3) * 8);
            };
            auto stt = [&](const u32x4& kreg, const u32x4& vreg, int p) __attribute__((always_inline)) {
                u16* kb = stage + p * BUFEL;
                *(u32x4*)(kb + (tid >> 3) * KST + (tid & 7) * 8) = kreg;
                *(u32x4*)(kb + 32 * KST + (tid >> 2) * VSTR + (tid & 3) * 8) = vreg;
            };
            f32x16 res[2][2], ao[2][2];
#pragma unroll
            for (int hd = 0; hd < 2; ++hd)
#pragma unroll
                for (int dt = 0; dt < 2; ++dt) { res[hd][dt] = zero16(); ao[hd][dt] = zero16(); }
            float m[2] = {-1e30f, -1e30f}, l[2] = {0.f, 0.f};
            int curbr = 1;
            auto finalize = [&](int br) __attribute__((always_inline)) {
#pragma unroll
                for (int hd = 0; hd < 2; ++hd) {
                    const float lt = l[hd] + __shfl_xor(l[hd], 32);
                    const float gsc = GT1[row * 48 + (h0 + hd) * 3 + 1 + br] / lt;
#pragma unroll
                    for (int dt = 0; dt < 2; ++dt)
#pragma unroll
                        for (int i = 0; i < 16; ++i) { res[hd][dt][i] += ao[hd][dt][i] * gsc; ao[hd][dt][i] = 0.f; }
                    m[hd] = -1e30f; l[hd] = 0.f;
                }
            };
            ldt(kr[0], vr[0], tl[0]);
            if (1 < ntile) ldt(kr[1], vr[1], tl[1]);
            if (2 < ntile) ldt(kr[2], vr[2], tl[2]);
            stt(kr[0], vr[0], 0);
            if (3 < ntile) ldt(kr[0], vr[0], tl[3]);
            __syncthreads();
            for (int it0 = 0; it0 < ntile; it0 += 6) {
#pragma unroll
            for (int uu = 0; uu < 6; ++uu) {
                const int it = it0 + uu;
                if (it < ntile) {
                const int e = tl[it], kt = e & 0xffff, br = e >> 16, p = uu & 1;
                if (br != curbr) { finalize(curbr); curbr = br; }
                const u16* kb = stage + p * BUFEL;
                const u16* vb = kb + 32 * KST;
                f32x16 s[2];
                s[0] = zero16(); s[1] = zero16();
#pragma unroll
                for (int st = 0; st < 4; ++st) {
                    const bf16x8 a = *(const bf16x8*)(kb + r * KST + 16 * st + 8 * hh);
                    s[0] = MFMA(a, bq[0][st], s[0]);
                    s[1] = MFMA(a, bq[1][st], s[1]);
                }
                const bool bsel = br ? true : (((selm >> (kt >> 1)) & 1ull) != 0);
                const bool interior = (kt * 32 + 31 <= tq) && (!br || kt * 32 >= tq - 480);
                const bool needmask = !interior || (__ballot(!bsel) != 0ull);
                if (needmask) {
#pragma unroll
                    for (int i = 0; i < 16; ++i) {
                        const int pk = kt * 32 + crow(i, hh);
                        bool ok = bsel && (pk <= t);
                        if (br) ok = ok && (pk > t - 512);
                        if (!ok) { s[0][i] = -1e30f; s[1][i] = -1e30f; }
                    }
                }
#pragma unroll
                for (int hd = 0; hd < 2; ++hd) {
                    float mx = s[hd][0];
#pragma unroll
                    for (int i = 1; i < 16; ++i) mx = fmaxf(mx, s[hd][i]);
                    mx = fmaxf(mx, __shfl_xor(mx, 32));
                    const float mn = fmaxf(m[hd], mx);
                    const float alpha = __builtin_amdgcn_exp2f(m[hd] - mn);
                    m[hd] = mn;
                    float ps = 0.f;
#pragma unroll
                    for (int i = 0; i < 16; ++i) { s[hd][i] = __builtin_amdgcn_exp2f(s[hd][i] - mn); ps += s[hd][i]; }
                    l[hd] = l[hd] * alpha + ps;
#pragma unroll
                    for (int i = 0; i < 16; ++i) { ao[hd][0][i] *= alpha; ao[hd][1][i] *= alpha; }
                }
#pragma unroll
                for (int s2 = 0; s2 < 2; ++s2) {
                    const bf16x8 pb0 = packp(s[0], s2), pb1 = packp(s[1], s2);
#pragma unroll
                    for (int dt = 0; dt < 2; ++dt) {
                        const u16* vp = vb + (dt * 32 + r) * VSTR + 16 * s2 + 4 * hh;
                        const bf16x8 av = ld8x2(vp, vp + 8);
                        ao[0][dt] = MFMA(av, pb0, ao[0][dt]);
                        ao[1][dt] = MFMA(av, pb1, ao[1][dt]);
                    }
                }
                if (it + 1 < ntile) {
                    stt(kr[(uu + 1) % 3], vr[(uu + 1) % 3], p ^ 1);
                    if (it + 4 < ntile) ldt(kr[(uu + 1) % 3], vr[(uu + 1) % 3], tl[it + 4]);
                }
                __syncthreads();
                }
            }
            }
            finalize(curbr);
#pragma unroll
            for (int hd = 0; hd < 2; ++hd)
#pragma unroll
                for (int dt = 0; dt < 2; ++dt)
#pragma unroll
                    for (int i4 = 0; i4 < 4; ++i4) {
                        const int d = dt * 32 + 8 * i4 + 4 * hh;
                        const u32x2 oc = *(const u32x2*)(OCMP + row * 1024 + (h0 + hd) * 64 + d);
                        u32x2 ov = {pk2(res[hd][dt][i4 * 4 + 0] + bflo(oc.x), res[hd][dt][i4 * 4 + 1] + bfhi(oc.x)),
                                    pk2(res[hd][dt][i4 * 4 + 2] + bflo(oc.y), res[hd][dt][i4 * 4 + 3] + bfhi(oc.y))};
                        *(u32x2*)(OBUF + row * 1024 + (h0 + hd) * 64 + d) = ov;
                    }
        }
        __syncthreads();
    };

    auto ph_15 = [&](bool dry) __attribute__((always_inline)) { if (!dry) resid_gemm((const u16*)(ws + O_OBUF), 1024, (const u16*)(ws + O_WNSAOUT), 1024, P.out, HB0, SS + 4 * MT, 1.f); else resid_gemm((const u16*)(ws + O_OBUF), 1024, (const u16*)(ws + O_WNSAOUT), 1024, P.out, (u16*)nullptr, (u64*)nullptr, 0.f); };
    auto ph_16 = [&](bool dry) __attribute__((always_inline)) { ffn_up_phase(1, HB0, SS + 4 * MT, SS + 7 * MT, !dry); };
    auto ph_17 = [&](bool dry) __attribute__((always_inline)) { if (!dry) resid_gemm((const u16*)(ws + O_ACT), 2816, (const u16*)(ws + O_WDOWN + SZ_WDOWN), 2816, P.out, HB1, SS + 5 * MT, 1.f); else resid_gemm((const u16*)(ws + O_ACT), 2816, (const u16*)(ws + O_WDOWN + SZ_WDOWN), 2816, P.out, (u16*)nullptr, (u64*)nullptr, 0.f); };
    auto ph_18 = [&](bool dry) __attribute__((always_inline)) { gate_phase(1, HB1, SS + 5 * MT, SS + 7 * MT, (u16*)nullptr, (u64*)nullptr, dry ? 0.f : 1.f); };
#define RUNA(k) do { if (PH(k)) ph_##k(); GSYNC(); if ((DUPMASK >> (k)) & 1) { ph_##k(); GSYNC(); } } while (0)
#define RUNB(k) do { if (PH(k)) ph_##k(false); GSYNC(); if ((DUPMASK >> (k)) & 1) { ph_##k(true); GSYNC(); } } while (0)
    RUNA(0); RUNA(1); RUNA(2); RUNA(3); RUNA(4); RUNA(5);
    RUNB(6); RUNB(7); RUNB(8); RUNB(9);
    RUNA(10); RUNA(11); RUNA(12); RUNA(13); RUNA(14);
    RUNB(15); RUNB(16); RUNB(17);
    if (PH(18)) ph_18(false);
    if ((DUPMASK >> 18) & 1) { GSYNC(); ph_18(true); }
}

extern "C" void kernel_launch(void* const* d_in, const int* in_sizes, int n_in, void* d_out, int out_size, void* d_ws, size_t ws_size, hipStream_t stream) {
    static int grid_blocks = 0;
    if (grid_blocks == 0) {
        if (n_in != 32 || out_size != MT * DM || ws_size < WS_NEED) {
            fprintf(stderr, "kernel_launch: unexpected problem (n_in %d, out %d, ws %zu)\n", n_in, out_size, ws_size);
            grid_blocks = -1;
            return;
        }
        int dev = 0, cus = 0, per_cu = 0;
        (void)hipGetDevice(&dev);
        (void)hipDeviceGetAttribute(&cus, hipDeviceAttributeMultiprocessorCount, dev);
        (void)hipOccupancyMaxActiveBlocksPerMultiprocessor(&per_cu, fwd_megakernel, 256, 0);
        if (per_cu < 1) per_cu = 1;
        if (per_cu > 1) per_cu = 1;
        grid_blocks = cus * per_cu;
    }
    if (grid_blocks < 0) return;
    Params p{};
    const float** pp = (const float**)&p;
    for (int i = 0; i < 32; ++i) pp[i] = (const float*)d_in[i];
    p.out = (float*)d_out;
    p.ws = (char*)d_ws;
    (void)hipMemsetAsync((char*)d_ws + O_BAR, 0, 16384, stream);
    void* args[] = {&p};
    hipError_t e = hipLaunchCooperativeKernel((void*)fwd_megakernel, dim3(grid_blocks), dim3(256), args, 0, stream);
    if (e != hipSuccess) fprintf(stderr, "cooperative launch failed: %s (grid %d)\n", hipGetErrorString(e), grid_blocks);
}
```

```cpp
#include <hip/hip_runtime.h>
#include <hip/hip_cooperative_groups.h>
#include <cstdio>
#include <type_traits>
namespace cg = cooperative_groups;

#define DI __device__ __forceinline__
typedef unsigned short u16;
typedef unsigned long long u64;
typedef __attribute__((ext_vector_type(8))) short bf16x8;
typedef __attribute__((ext_vector_type(16))) float f32x16;
typedef __attribute__((ext_vector_type(4))) unsigned u32x4;
typedef __attribute__((ext_vector_type(2))) unsigned u32x2;
#define MFMA(a, b, c) __builtin_amdgcn_mfma_f32_32x32x16_bf16((a), (b), (c), 0, 0, 0)

#ifndef USE_CG
#define USE_CG 0
#endif
#if USE_CG
#define GSYNC() grid.sync()
#else
#define GSYNC() ctr_barrier((unsigned*)(P.ws + O_BAR) + 4096 - 64, bar_gen)
#endif
#ifndef RESTRICT
#define RESTRICT 0
#endif
#define RB(k, id, n) ((((RESTRICT) >> (k)) & 1) && (n) > 256 ? ((id) < 256 ? (id) : 0x3fffffff) : (id))
#define RS(k, n) ((((RESTRICT) >> (k)) & 1) && (n) > 256 ? 256 : (n))
#ifndef P1REP
#define P1REP 1
#endif
#ifndef DUPMASK
#define DUPMASK 0
#endif
#ifndef XCD_CONSEC
#define XCD_CONSEC 1
#endif
#ifndef MINW
#define MINW 1
#endif
#ifndef ONLY
#define PH(k) true
#else
#define PH(k) ((ONLY) == (k))
#endif
constexpr int MT = 16384, DM = 1024, TS = 4096;
constexpr float EPS = 1e-6f;

constexpr size_t O_WABIN = 0;
constexpr size_t O_WABOUT = O_WABIN + 3200ull * 1024 * 2;
constexpr size_t O_WNSAIN = O_WABOUT + 1024ull * 1024 * 2;
constexpr size_t O_WC1K = O_WNSAIN + 1920ull * 1024 * 2;
constexpr size_t O_WC1V = O_WC1K + 256ull * 2048 * 2;
constexpr size_t O_WC2K = O_WC1V + 256ull * 2048 * 2;
constexpr size_t O_WC2V = O_WC2K + 128ull * 256 * 2;
constexpr size_t O_WNSAOUT = O_WC2V + 128ull * 256 * 2;
constexpr size_t O_WUP = O_WNSAOUT + 1024ull * 1024 * 2;
constexpr size_t SZ_WUP = 5632ull * 1024 * 2;
constexpr size_t O_WDOWN = O_WUP + 2 * SZ_WUP;
constexpr size_t SZ_WDOWN = 1024ull * 2816 * 2;
constexpr size_t O_WPLE = O_WDOWN + 2 * SZ_WDOWN;
constexpr size_t SZ_WPLE = 1024ull * 256 * 2;
constexpr size_t O_WGATE = O_WPLE + 2 * SZ_WPLE;
constexpr size_t SZ_WGATE = 1024ull * 1024 * 2;
constexpr size_t O_ROPEC = O_WGATE + 2 * SZ_WGATE;
constexpr size_t O_ROPES = O_ROPEC + 4096ull * 32 * 4;
constexpr size_t O_BIAS1 = O_ROPES + 4096ull * 32 * 4;
constexpr size_t O_BAR = O_BIAS1 + 4096;
constexpr size_t O_SS = O_BAR + 16384;
constexpr size_t O_HB0 = O_SS + 8ull * MT * 8;
constexpr size_t O_HB1 = O_HB0 + (size_t)MT * DM * 2;
constexpr size_t O_BIG = O_HB1 + (size_t)MT * DM * 2;
constexpr size_t O_VT0 = O_BIG;
constexpr size_t O_KT = O_VT0 + 4ull * 1024 * 4096 * 2;
constexpr size_t O_QM = O_KT + 4ull * 256 * 4096 * 2;
constexpr size_t O_KM = O_QM + (size_t)MT * 256 * 2;
constexpr size_t O_KWT = O_KM + (size_t)MT * 256 * 2;
constexpr size_t O_GS = O_KWT + 4ull * 256 * 4096 * 2;
constexpr size_t O_BL = O_GS + 16ull * 4096 * 4;
constexpr size_t O_PM = O_BL + 16ull * 4096 * 4;
constexpr size_t O_BLAST = O_PM + 16ull * 4096 * 4;
constexpr size_t O_GC = O_BLAST + 4096;
constexpr size_t O_MS = O_GC + 4096;
constexpr size_t O_NC = O_MS + 4096;
constexpr size_t O_NS = O_NC + 1024ull * 64 * 4;
constexpr size_t O_GF = O_NS + 1024ull * 64 * 4;
constexpr size_t O_KVT = O_GF + (size_t)MT * 8 * 4;
constexpr size_t O_RT = O_KVT + 512ull * 8192 * 4;
constexpr size_t O_UT = O_RT + 512ull * 8192 * 2;
constexpr size_t O_L0END = O_UT + 1024ull * 8192 * 4;
constexpr size_t O_CT = O_HB1;
constexpr size_t O_ACT = O_BIG;
constexpr size_t O_ERAW = O_ACT + (size_t)MT * 2816 * 2;
constexpr size_t O_FFNEND = O_ERAW + (size_t)MT * DM * 2;
constexpr size_t O_QN = O_BIG;
constexpr size_t O_KCVC = O_QN + (size_t)MT * DM * 2;
constexpr size_t O_KSN = O_KCVC + (size_t)MT * 256 * 2;
constexpr size_t O_KWN = O_KSN + (size_t)MT * 128 * 2;
constexpr size_t O_VST = O_KWN + (size_t)MT * 128 * 2;
constexpr size_t O_VWT = O_VST + (size_t)MT * 128 * 2;
constexpr size_t O_GT1 = O_VWT + (size_t)MT * 128 * 2;
constexpr size_t O_HID = O_GT1 + (size_t)MT * 48 * 4;
constexpr size_t O_KCN = O_HID + 2ull * 2048 * 256 * 2;
constexpr size_t O_VCT = O_KCN + 8ull * 256 * 64 * 2;
constexpr size_t O_SEL = O_VCT + 8ull * 64 * 256 * 2;
constexpr size_t O_OBUF = O_SEL + 8ull * 4096 * 8;
constexpr size_t O_L1END = O_OBUF + (size_t)MT * DM * 2;
constexpr size_t O_OCMP = O_HB1;
constexpr size_t WS_NEED = 256ull << 20;
static_assert(O_L0END <= WS_NEED && O_FFNEND <= WS_NEED && O_L1END <= WS_NEED, "workspace overflow");

struct Params {
    const float *x, *p, *ab_norm_g, *ab_w_in, *ab_conv_w, *ab_conv_b, *ab_ret_norm_g, *ab_ig_b, *ab_fg_b, *ab_m_norm_g, *ab_w_out;
    const float *nsa_norm_g, *nsa_w_in, *nsa_q_norm_g, *nsa_k_norm_g, *nsa_cmp_pos_k, *nsa_cmp_pos_v, *w1k, *w2k, *w1v, *w2v, *nsa_gate_b, *nsa_w_out;
    const float *ffn_norm_g, *ffn_w_up, *ffn_conv_w, *ffn_conv_b, *ffn_w_down, *ple_w, *ple_norm_g, *ple_gate_norm_g, *ple_w_gate;
    float* out;
    char* ws;
};

DI float bf2f(u16 b) { return __uint_as_float(((unsigned)b) << 16); }
typedef float f32x2_t __attribute__((ext_vector_type(2)));
typedef __bf16 bf16x2_t __attribute__((ext_vector_type(2)));
DI unsigned pk2(float a, float b) { f32x2_t v = {a, b}; bf16x2_t o = __builtin_convertvector(v, bf16x2_t); return __builtin_bit_cast(unsigned, o); }
DI u16 f2bf(float x) { return (u16)(pk2(x, 0.f) & 0xffffu); }
DI float bflo(unsigned u) { return __uint_as_float(u << 16); }
DI float bfhi(unsigned u) { return __uint_as_float(u & 0xffff0000u); }
DI int crow(int i, int h) { return (i & 3) + 8 * (i >> 2) + 4 * h; }
DI float sigmoidf_(float x) { return 1.f / (1.f + __expf(-x)); }
DI float gelu_tanh(float x) { float y = 0.7978845608028654f * (x + 0.044715f * x * x * x); float t = 1.f - 2.f / (__expf(2.f * y) + 1.f); return 0.5f * x * (1.f + t); }
DI float red32(float v) { v += __shfl_xor(v, 1); v += __shfl_xor(v, 2); v += __shfl_xor(v, 4); v += __shfl_xor(v, 8); v += __shfl_xor(v, 16); return v; }
DI bf16x8 ld16(const u16* p) { return *(const bf16x8*)p; }
DI bf16x8 ld8x2(const u16* p0, const u16* p1) { u32x2 a = *(const u32x2*)p0, b = *(const u32x2*)p1; u32x4 v = {a.x, a.y, b.x, b.y}; return __builtin_bit_cast(bf16x8, v); }
DI bf16x8 packp(const f32x16& x, int s) {
    u32x4 v = {pk2(x[8 * s + 0], x[8 * s + 1]), pk2(x[8 * s + 2], x[8 * s + 3]), pk2(x[8 * s + 4], x[8 * s + 5]), pk2(x[8 * s + 6], x[8 * s + 7])};
    return __builtin_bit_cast(bf16x8, v);
}
DI f32x16 zero16() { f32x16 z; for (int i = 0; i < 16; ++i) z[i] = 0.f; return z; }
DI u64 ss_fix(float s) { return (u64)(s * 1048576.f + 0.5f); }
DI float ss_rstd(u64 v) { return rsqrtf((float)v * (1.f / (1048576.f * 1024.f)) + EPS); }
DI float gamma_log(int h) { return log1pf(-exp2f(-5.f - (float)h)); }


#define XB_TMO      128
#define XB_XCNT(j)  (256  + 64 * (j))
#define XB_XSUB(j)  (1280 + 64 * (j))
#define XB_XGEN(j)  (2304 + 64 * (j))
#define XB_TOP      3328
#define XB_TOPGEN   3392
#define XCD_BAR_WORDS 3456
#define XB_SPIN_CAP (1u << 22)
#define LAS __attribute__((address_space(3)))
DI unsigned xb_ld(unsigned* p) { return __hip_atomic_load(p, __ATOMIC_RELAXED, __HIP_MEMORY_SCOPE_AGENT); }
DI unsigned xb_add(unsigned* p, unsigned v) { return __hip_atomic_fetch_add(p, v, __ATOMIC_RELAXED, __HIP_MEMORY_SCOPE_AGENT); }
DI unsigned xb_xcc_id() { return (unsigned)__builtin_amdgcn_s_getreg((3 << 11) | 20) & 0xFu; }
#define XB_SPIN(cond, bar) do { unsigned _sp = 0; while (cond) { __builtin_amdgcn_s_sleep(1); \
    if ((++_sp & 255u) == 0u) { if (xb_ld(&(bar)[XB_TMO])) break; if (_sp > XB_SPIN_CAP) { atomicAdd(&(bar)[XB_TMO], 1u); break; } } } } while (0)
struct XcdBarrier { unsigned* bar; unsigned x; volatile LAS unsigned* st; };
DI XcdBarrier xcd_barrier_post(unsigned* bar, volatile LAS unsigned* st) {
    XcdBarrier b; b.bar = bar; b.x = xb_xcc_id(); b.st = st;
    if (threadIdx.x == 0) (void)xb_add(&bar[XB_XCNT(b.x)], 1u);
    return b;
}
DI void xcd_barrier_complete(unsigned* bar, unsigned x, unsigned& nloc, unsigned& nx) {
    const unsigned G = gridDim.x * gridDim.y * gridDim.z;
    unsigned sum, cnt, mine, sp = 0u;
    for (;;) {
        sum = 0u; cnt = 0u; mine = 0u;
#pragma unroll
        for (unsigned j = 0; j < 16; ++j) { const unsigned c = xb_ld(&bar[XB_XCNT(j)]); sum += c; cnt += (c > 0u) ? 1u : 0u; mine = (j == x) ? c : mine; }
        if (sum == G) break;
        __builtin_amdgcn_s_sleep(1);
        if ((++sp & 255u) == 0u) { if (xb_ld(&bar[XB_TMO])) break; if (sp > XB_SPIN_CAP) { atomicAdd(&bar[XB_TMO], 1u); break; } }
    }
    nloc = mine > 0u ? mine : 1u; nx = cnt > 0u ? cnt : 1u;
}
DI void xcd_barrier(const XcdBarrier& b) {
    asm volatile("s_waitcnt vmcnt(0)" ::: "memory");
    __syncthreads();
    if (threadIdx.x == 0) {
        unsigned* bar = b.bar;
        __builtin_amdgcn_s_waitcnt(0);
        unsigned nloc = b.st[0], nx = b.st[1];
        if (nloc == 0u) { xcd_barrier_complete(bar, b.x, nloc, nx); b.st[0] = nloc; b.st[1] = nx; }
        const unsigned old = xb_add(&bar[XB_XSUB(b.x)], 1u);
        const unsigned gen = old / nloc;
        if (old + 1u == (gen + 1u) * nloc) {
            __builtin_amdgcn_fence(__ATOMIC_RELEASE, "agent");
            asm volatile("s_waitcnt vmcnt(0)" ::: "memory");
            const unsigned og = xb_add(&bar[XB_TOP], 1u);
            const unsigned tg = og / nx;
            if (og + 1u == (tg + 1u) * nx) xb_add(&bar[XB_TOPGEN], 1u);
            else XB_SPIN(xb_ld(&bar[XB_TOPGEN]) == tg, bar);
            __builtin_amdgcn_fence(__ATOMIC_ACQUIRE, "agent");
            xb_add(&bar[XB_XGEN(b.x)], 1u);
            asm volatile("s_waitcnt vmcnt(0)" ::: "memory");
        } else {
            XB_SPIN(xb_ld(&bar[XB_XGEN(b.x)]) == gen, bar);
            __builtin_amdgcn_fence(__ATOMIC_ACQUIRE, "agent");
            asm volatile("s_waitcnt vmcnt(0)" ::: "memory");
        }
    }
    __syncthreads();
}

DI void ctr_barrier(unsigned* ctr, unsigned& gen) {
    asm volatile("s_waitcnt vmcnt(0)" ::: "memory");
    __syncthreads();
    gen += 1u;
    if (threadIdx.x == 0) {
        __builtin_amdgcn_fence(__ATOMIC_RELEASE, "agent");
        asm volatile("s_waitcnt vmcnt(0)" ::: "memory");
        (void)__hip_atomic_fetch_add(ctr, 1u, __ATOMIC_RELAXED, __HIP_MEMORY_SCOPE_AGENT);
        const unsigned target = gen * gridDim.x;
        unsigned sp = 0;
        while (__hip_atomic_load(ctr, __ATOMIC_RELAXED, __HIP_MEMORY_SCOPE_AGENT) < target) {
            __builtin_amdgcn_s_sleep(1);
            if (++sp > (1u << 24)) break;
        }
        __builtin_amdgcn_fence(__ATOMIC_ACQUIRE, "agent");
        asm volatile("s_waitcnt vmcnt(0)" ::: "memory");
    }
    __syncthreads();
}

constexpr int LDT = 72;
constexpr int LDS_BYTES = 2 * 2 * 128 * LDT * 2;

template <bool AF32, class RowA>
DI void gemm_main(f32x16 (&acc)[2][2], RowA rowA, const int kmulA, const u16* __restrict__ Bf, int ldb, int n0, int K, u16* As, u16*  ) {
    constexpr int PD = 2;
    constexpr int BUFE = 128 * LDT;
    const int tid = threadIdx.x, lane = tid & 63, wave = tid >> 6;
    const int wm = wave >> 1, wn = wave & 1, r = lane & 31, hh = lane >> 5;
#pragma unroll
    for (int mi = 0; mi < 2; ++mi)
#pragma unroll
        for (int ni = 0; ni < 2; ++ni) acc[mi][ni] = zero16();
    typedef typename std::conditional<AF32, float, u16>::type TA;
    const int row0 = tid >> 3, kc = (tid & 7) * 8;
    const TA* pa[4];
#pragma unroll
    for (int i = 0; i < 4; ++i) pa[i] = (const TA*)rowA(row0 + 32 * i) + kc;
    const int kbn = ldb >> 4;
    const u16* pb = Bf + ((size_t)((n0 + wn * 64) >> 5) * kbn * 64 + lane) * 8;
    u32x4 ra[PD][4];
    bf16x8 rb[PD][8];
    auto loadA = [&](u32x4 (&xa)[4], int k0) __attribute__((always_inline)) {
#pragma unroll
        for (int i = 0; i < 4; ++i) {
            if constexpr (AF32) {
                const float* q = (const float*)pa[i] + k0 * kmulA;
                const float4 v0 = *(const float4*)q, v1 = *(const float4*)(q + 4);
                u32x4 t = {pk2(v0.x, v0.y), pk2(v0.z, v0.w), pk2(v1.x, v1.y), pk2(v1.z, v1.w)};
                xa[i] = t;
            } else {
                xa[i] = *(const u32x4*)((const u16*)pa[i] + k0 * kmulA);
            }
        }
    };
    auto loadB = [&](bf16x8 (&xb)[8], int k0) __attribute__((always_inline)) {
#pragma unroll
        for (int ni = 0; ni < 2; ++ni)
#pragma unroll
            for (int ks = 0; ks < 4; ++ks) xb[ni * 4 + ks] = *(const bf16x8*)(pb + ((size_t)ni * kbn + (k0 >> 4) + ks) * 512);
    };
    auto stores = [&](const u32x4 (&xa)[4], int p) __attribute__((always_inline)) {
        u16* sa = As + p * BUFE + row0 * LDT + kc;
#pragma unroll
        for (int i = 0; i < 4; ++i) *(u32x4*)(sa + 32 * i * LDT) = xa[i];
    };
    const int nk = K >> 6;
#pragma unroll
    for (int d = 0; d < PD; ++d) { loadA(ra[d], d * 64); loadB(rb[d], d * 64); }
    __syncthreads();
    stores(ra[0], 0);
    if (PD < nk) loadA(ra[0], PD * 64);
    __syncthreads();
    const u16* fa = As + (wm * 64 + r) * LDT + hh * 8;
    for (int kb = 0; kb < nk; kb += PD) {
#pragma unroll
        for (int u = 0; u < PD; ++u) {
            const int k = kb + u, p = u & 1;
#pragma unroll
            for (int ks = 0; ks < 4; ++ks) {
                bf16x8 a[2];
#pragma unroll
                for (int mi = 0; mi < 2; ++mi) a[mi] = *(const bf16x8*)(fa + p * BUFE + mi * 32 * LDT + ks * 16);
#pragma unroll
                for (int mi = 0; mi < 2; ++mi)
#pragma unroll
                    for (int ni = 0; ni < 2; ++ni) acc[mi][ni] = MFMA(a[mi], rb[u][ni * 4 + ks], acc[mi][ni]);
            }
            if (k + PD < nk) loadB(rb[u], (k + PD) * 64);
            if (k + 1 < nk) {
                stores(ra[(u + 1) % PD], p ^ 1);
                if (k + 1 + PD < nk) loadA(ra[(u + 1) % PD], (k + 1 + PD) * 64);
            }
            __syncthreads();
        }
    }
}

DI bool tile_decode(int v, int MTl, int NTl, int& mt, int& nt) {
    mt = v / NTl; nt = v - mt * NTl;
    return v < MTl * NTl;
}
DI int tile_bound(int MTl, int NTl) { return MTl * NTl; }

template <class RowMap>
DI void tconv(const float* __restrict__ W, int K, int N, int Npad, const float* __restrict__ g, u16* __restrict__ out, RowMap rm, int gtid, int gsz) {
    const int total = (K / 32) * Npad, kb_per_n = K >> 4;
    for (int u = gtid; u < total; u += gsz) {
        const int n = u % Npad, k32 = u / Npad;
        float v[32];
        if (n < N) {
            const float* wp = W + (size_t)(k32 * 32) * N + n;
#pragma unroll
            for (int j = 0; j < 32; ++j) v[j] = wp[(size_t)j * N];
            if (g) {
#pragma unroll
                for (int j = 0; j < 32; ++j) v[j] *= g[k32 * 32 + j];
            }
        } else {
#pragma unroll
            for (int j = 0; j < 32; ++j) v[j] = 0.f;
        }
        const int np = rm(n), nb = np >> 5, rr = np & 31;
#pragma unroll
        for (int q = 0; q < 4; ++q) {
            u32x4 o = {pk2(v[8 * q + 0], v[8 * q + 1]), pk2(v[8 * q + 2], v[8 * q + 3]), pk2(v[8 * q + 4], v[8 * q + 5]), pk2(v[8 * q + 6], v[8 * q + 7])};
            const size_t blkid = (size_t)nb * kb_per_n + k32 * 2 + (q >> 1);
            *(u32x4*)(out + (blkid * 64 + (q & 1) * 32 + rr) * 8) = o;
        }
    }
}
DI void zfill16(u16* p, size_t n_elems, int gtid, int gsz) {
    u32x4 z = {0u, 0u, 0u, 0u};
    for (size_t u = gtid; u < n_elems / 8; u += gsz) *(u32x4*)(p + u * 8) = z;
}

__global__ void __launch_bounds__(256, MINW) fwd_megakernel(Params P) {
    cg::grid_group grid = cg::this_grid();
    __shared__ __attribute__((aligned(16))) char smem[LDS_BYTES];
    __shared__ uint4 xb_words;
    if (threadIdx.x == 0) xb_words = make_uint4(0u, 0u, 0u, 0u);
    __syncthreads();
    unsigned bar_gen = 0u;
    const XcdBarrier xbar = xcd_barrier_post((unsigned*)(P.ws + O_BAR), (volatile LAS unsigned*)&xb_words);
    u16* As = (u16*)smem;
    u16* Bs = As + 128 * LDT;
    const int tid = threadIdx.x, lane = tid & 63, wave = tid >> 6;
    const int wm = wave >> 1, wn = wave & 1, r = lane & 31, hh = lane >> 5;
    const int nblk = gridDim.x, blk = blockIdx.x;
    const int gtid = blk * 256 + tid, gsz = nblk * 256;
    const int gw = blk * 4 + wave, ngw = nblk * 4;
    char* ws = P.ws;
    u64* SS = (u64*)(ws + O_SS);
    u16* HB0 = (u16*)(ws + O_HB0);
    u16* HB1 = (u16*)(ws + O_HB1);
    const float* ROPEC = (const float*)(ws + O_ROPEC);
    const float* ROPES = (const float*)(ws + O_ROPES);

    auto ph_0 = [&]() __attribute__((always_inline)) {
        auto idm = [](int n) { return n; };
        auto upm = [](int n) { return n < 2816 ? (n >> 6) * 128 + (n & 63) : ((n - 2816) >> 6) * 128 + 64 + ((n - 2816) & 63); };
        tconv(P.ab_w_in, 1024, 3080, 3200, P.ab_norm_g, (u16*)(ws + O_WABIN), idm, gtid, gsz);
        tconv(P.ab_w_out, 1024, 1024, 1024, (const float*)nullptr, (u16*)(ws + O_WABOUT), idm, gtid, gsz);
        tconv(P.nsa_w_in, 1024, 1840, 1920, P.nsa_norm_g, (u16*)(ws + O_WNSAIN), idm, gtid, gsz);
        tconv(P.w1k, 2048, 256, 256, (const float*)nullptr, (u16*)(ws + O_WC1K), idm, gtid, gsz);
        tconv(P.w1v, 2048, 256, 256, (const float*)nullptr, (u16*)(ws + O_WC1V), idm, gtid, gsz);
        tconv(P.w2k, 256, 64, 128, (const float*)nullptr, (u16*)(ws + O_WC2K), idm, gtid, gsz);
        tconv(P.w2v, 256, 64, 128, (const float*)nullptr, (u16*)(ws + O_WC2V), idm, gtid, gsz);
        tconv(P.nsa_w_out, 1024, 1024, 1024, (const float*)nullptr, (u16*)(ws + O_WNSAOUT), idm, gtid, gsz);
        for (int i = 0; i < 2; ++i) {
            tconv(P.ffn_w_up + (size_t)i * 1024 * 5632, 1024, 5632, 5632, P.ffn_norm_g + i * 1024, (u16*)(ws + O_WUP + i * SZ_WUP), upm, gtid, gsz);
            tconv(P.ffn_w_down + (size_t)i * 2816 * 1024, 2816, 1024, 1024, (const float*)nullptr, (u16*)(ws + O_WDOWN + i * SZ_WDOWN), idm, gtid, gsz);
            tconv(P.ple_w + (size_t)i * 256 * 1024, 256, 1024, 1024, (const float*)nullptr, (u16*)(ws + O_WPLE + i * SZ_WPLE), idm, gtid, gsz);
            tconv(P.ple_w_gate + (size_t)i * 1024 * 1024, 1024, 1024, 1024, P.ple_gate_norm_g + i * 1024, (u16*)(ws + O_WGATE + i * SZ_WGATE), idm, gtid, gsz);
        }
        {
            float* rc = (float*)(ws + O_ROPEC);
            float* rs = (float*)(ws + O_ROPES);
            for (int u = gtid; u < 4096 * 32; u += gsz) {
                const int pos = u >> 5, d = u & 31;
                const float inv = powf(10000.f, -(float)d / 32.f);
                const float ang = (float)pos * inv;
                const double a = (double)ang;
                const double n = rint(a * 0.15915494309189535);
                const float rr = (float)(a - n * 6.283185307179586);
                rc[u] = cosf(rr);
                rs[u] = sinf(rr);
            }
        }
        for (int u = gw; u < 512; u += ngw) {
            const int kv = u >> 8, j = u & 255;
            const float* pos = kv ? P.nsa_cmp_pos_v : P.nsa_cmp_pos_k;
            const float* W1 = kv ? P.w1v : P.w1k;
            float s = 0.f;
            for (int k = lane; k < 2048; k += 64) s += pos[k] * W1[(size_t)k * 256 + j];
            s = red32(s); s += __shfl_xor(s, 32);
            if (lane == 0) ((float*)(ws + O_BIAS1))[u] = s;
        }
        for (int u = gtid; u < 7 * MT; u += gsz) SS[MT + u] = 0ull;
        for (int row = gw; row < MT; row += ngw) {
            const float4* xr = (const float4*)(P.x + (size_t)row * DM);
            float s = 0.f;
#pragma unroll
            for (int j = 0; j < 4; ++j) {
                const float4 v = xr[lane + 64 * j];
                s += v.x * v.x + v.y * v.y + v.z * v.z + v.w * v.w;
                u32x2 o = {pk2(v.x, v.y), pk2(v.z, v.w)};
                *(u32x2*)(HB0 + (size_t)row * DM + (lane + 64 * j) * 4) = o;
            }
            s = red32(s); s += __shfl_xor(s, 32);
            if (lane == 0) SS[row] = ss_fix(s);
        }
    };

    auto ph_1 = [&]() __attribute__((always_inline)) {
        u16* Z0 = (u16*)P.out;
        u16* VT0 = (u16*)(ws + O_VT0);
        u16* KT = (u16*)(ws + O_KT);
        float* GF = (float*)(ws + O_GF);
        const u16* Wt = (const u16*)(ws + O_WABIN);
        for (int tile = blk; tile < tile_bound(128, 25); tile += nblk) {
            int mt, nt; if (!tile_decode(tile, 128, 25, mt, nt)) continue;
            const int m0 = mt * 128, n0 = nt * 128;
            f32x16 acc[2][2];
            const u16* Ab = HB0 + (size_t)m0 * DM;
            gemm_main<false>(acc, [&](int row) { return Ab + (size_t)row * DM; }, 1, Wt, 1024, n0, 1024, As, Bs);
            const int colw = n0 + wn * 64;
            float rsv[2][16], cv[2][16], sv[2][16];
#pragma unroll
            for (int mi = 0; mi < 2; ++mi)
#pragma unroll
                for (int i = 0; i < 16; ++i) {
                    const int row = m0 + wm * 64 + mi * 32 + crow(i, hh);
                    rsv[mi][i] = ss_rstd(SS[row]);
                    cv[mi][i] = (nt < 4) ? ROPEC[(row & 4095) * 32 + r] : 0.f;
                    sv[mi][i] = (nt < 4) ? ROPES[(row & 4095) * 32 + r] : 0.f;
                }
#pragma unroll
            for (int mi = 0; mi < 2; ++mi) {
#pragma unroll
                for (int i4 = 0; i4 < 4; ++i4) {
                    float v0[4], v1[4];
                    const int rowb = m0 + wm * 64 + mi * 32 + 8 * i4 + 4 * hh;
#pragma unroll
                    for (int j = 0; j < 4; ++j) {
                        const float rs = rsv[mi][i4 * 4 + j];
                        v0[j] = acc[mi][0][i4 * 4 + j] * rs;
                        v1[j] = acc[mi][1][i4 * 4 + j] * rs;
                    }
                    const int bb = rowb >> 12, t = rowb & 4095;
                    if (nt < 4) {
                        const int head = (colw & 255) >> 6;
                        const float lg = gamma_log(head);
#pragma unroll
                        for (int j = 0; j < 4; ++j) {
                            const float c = cv[mi][i4 * 4 + j], s = sv[mi][i4 * 4 + j];
                            float y0 = v0[j] * c - v1[j] * s, y1 = v0[j] * s + v1[j] * c;
                            if (nt >= 2) { const float sc = 0.125f * __expf(-(float)(((t + j) & 127) + 1) * lg); y0 *= sc; y1 *= sc; }
                            v0[j] = y0; v1[j] = y1;
                            Z0[(size_t)(rowb + j) * 2048 + colw + r] = f2bf(y0);
                            Z0[(size_t)(rowb + j) * 2048 + colw + 32 + r] = f2bf(y1);
                        }
                        if (nt >= 2) {
                            const int kc = colw - 256;
                            u32x2 o0 = {pk2(v0[0], v0[1]), pk2(v0[2], v0[3])}, o1 = {pk2(v1[0], v1[1]), pk2(v1[2], v1[3])};
                            *(u32x2*)(KT + ((size_t)(bb * 256 + kc + r)) * 4096 + t) = o0;
                            *(u32x2*)(KT + ((size_t)(bb * 256 + kc + 32 + r)) * 4096 + t) = o1;
                        }
                    } else if ((nt >= 4 && nt < 8) || (nt >= 16 && nt < 20)) {
                        const int vc = (nt < 8) ? (colw - 512) : (512 + colw - 2048);
                        u32x2 o0 = {pk2(v0[0], v0[1]), pk2(v0[2], v0[3])}, o1 = {pk2(v1[0], v1[1]), pk2(v1[2], v1[3])};
                        *(u32x2*)(VT0 + ((size_t)(bb * 1024 + vc + r)) * 4096 + t) = o0;
                        *(u32x2*)(VT0 + ((size_t)(bb * 1024 + vc + 32 + r)) * 4096 + t) = o1;
                    } else if (nt < 24) {
                        const int zc = (nt < 12) ? (512 + colw - 1024) : (nt < 16) ? (1024 + colw - 1536) : (1536 + colw - 2560);
#pragma unroll
                        for (int j = 0; j < 4; ++j) {
                            Z0[(size_t)(rowb + j) * 2048 + zc + r] = f2bf(v0[j]);
                            Z0[(size_t)(rowb + j) * 2048 + zc + 32 + r] = f2bf(v1[j]);
                        }
                    } else {
                        if (wn == 0 && r < 8) {
#pragma unroll
                            for (int j = 0; j < 4; ++j) GF[(size_t)(rowb + j) * 8 + r] = v0[j];
                        }
                    }
                }
            }
        }
    };

    auto ph_2 = [&]() __attribute__((always_inline)) {
        const u16* Z0 = (const u16*)P.out;
        const float* GF = (const float*)(ws + O_GF);
        float* GS = (float*)(ws + O_GS); float* BL = (float*)(ws + O_BL); float* PM = (float*)(ws + O_PM);
        float* BLAST = (float*)(ws + O_BLAST); float* GC = (float*)(ws + O_GC); float* NC = (float*)(ws + O_NC);
        u16* QM = (u16*)(ws + O_QM); u16* KM = (u16*)(ws + O_KM); u16* KWT = (u16*)(ws + O_KWT);
        for (int u = gw; u < 1024; u += ngw) {
            const int bh = u >> 6, c = u & 63, b = bh >> 2, h = bh & 3, t0 = c * 64;
            const size_t rowb = (size_t)b * 4096;
            const size_t row = rowb + t0 + lane;
            const float f = GF[row * 8 + 4 + h] + P.ab_fg_b[h];
            const float fc = fminf(f, 0.f) - log1pf(__expf(-fabsf(f)));
            const float ic = GF[row * 8 + h] + P.ab_ig_b[h];
            float bcs = fc;
#pragma unroll
            for (int off = 1; off < 64; off <<= 1) { const float o = __shfl_up(bcs, off); if (lane >= off) bcs += o; }
            const float g = ic - bcs;
            float pm = g;
#pragma unroll
            for (int off = 1; off < 64; off <<= 1) { const float o = __shfl_up(pm, off); if (lane >= off) pm = fmaxf(pm, o); }
            const float G = __shfl(pm, 63), bl = __shfl(bcs, 63);
            const float w = __expf(g - G);
            GS[bh * 4096 + t0 + lane] = g; BL[bh * 4096 + t0 + lane] = bcs; PM[bh * 4096 + t0 + lane] = pm;
            if (lane == 0) { BLAST[bh * 64 + c] = bl; GC[bh * 64 + c] = G; }
            {
                const int ch = 256 + h * 64 + lane;
                const float w0 = P.ab_conv_w[ch], w1 = P.ab_conv_w[512 + ch], w2 = P.ab_conv_w[1024 + ch], w3 = P.ab_conv_w[1536 + ch], cb = P.ab_conv_b[ch];
                const u16* zp = Z0 + 1024 + ch;
                float x0 = 0.f, x1 = 0.f, x2 = 0.f;
                if (t0 > 0) { x0 = bf2f(zp[(rowb + t0 - 3) * 2048]); x1 = bf2f(zp[(rowb + t0 - 2) * 2048]); x2 = bf2f(zp[(rowb + t0 - 1) * 2048]); }
                float nsum = 0.f;
                float xr[64];
#pragma unroll
                for (int s = 0; s < 64; ++s) xr[s] = bf2f(zp[(rowb + t0 + s) * 2048]);
#pragma unroll
                for (int s8 = 0; s8 < 8; ++s8) {
                    float vw[8];
#pragma unroll
                    for (int j = 0; j < 8; ++j) {
                        const int s = s8 * 8 + j;
                        const float x3 = xr[s];
                        float v = cb + w0 * x0 + w1 * x1 + w2 * x2 + w3 * x3;
                        v = v / (1.f + __expf(-v));
                        x0 = x1; x1 = x2; x2 = x3;
                        KM[(rowb + t0 + s) * 256 + h * 64 + lane] = f2bf(v);
                        const float wsv = __shfl(w, s);
                        vw[j] = v * wsv; nsum += vw[j];
                    }
                    u32x4 o = {pk2(vw[0], vw[1]), pk2(vw[2], vw[3]), pk2(vw[4], vw[5]), pk2(vw[6], vw[7])};
                    *(u32x4*)(KWT + ((size_t)(b * 256 + h * 64 + lane)) * 4096 + t0 + s8 * 8) = o;
                }
                NC[(size_t)u * 64 + lane] = nsum;
            }
            {
                const int ch = h * 64 + lane;
                const float w0 = P.ab_conv_w[ch], w1 = P.ab_conv_w[512 + ch], w2 = P.ab_conv_w[1024 + ch], w3 = P.ab_conv_w[1536 + ch], cb = P.ab_conv_b[ch];
                const u16* zp = Z0 + 1024 + ch;
                float x0 = 0.f, x1 = 0.f, x2 = 0.f;
                if (t0 > 0) { x0 = bf2f(zp[(rowb + t0 - 3) * 2048]); x1 = bf2f(zp[(rowb + t0 - 2) * 2048]); x2 = bf2f(zp[(rowb + t0 - 1) * 2048]); }
                float xr[64];
#pragma unroll
                for (int s = 0; s < 64; ++s) xr[s] = bf2f(zp[(rowb + t0 + s) * 2048]);
#pragma unroll
                for (int s = 0; s < 64; ++s) {
                    const float x3 = xr[s];
                    float v = cb + w0 * x0 + w1 * x1 + w2 * x2 + w3 * x3;
                    v = v / (1.f + __expf(-v));
                    x0 = x1; x1 = x2; x2 = x3;
                    QM[(rowb + t0 + s) * 256 + h * 64 + lane] = f2bf(v * 0.125f);
                }
            }
        }
    };

    auto ph_3 = [&]() __attribute__((always_inline)) {
        const u16* VT0 = (const u16*)(ws + O_VT0);
        const u16* KT = (const u16*)(ws + O_KT);
        const u16* KWT = (const u16*)(ws + O_KWT);
        float* KVT = (float*)(ws + O_KVT);
        float* UT = (float*)(ws + O_UT);
        for (int u = gw; u < 2048 + 4096; u += ngw) {
            f32x16 a0 = zero16(), a1 = zero16();
            if (u < 2048) {
                const int dt = u & 3, c = (u >> 2) & 31, bh = u >> 7, b = bh >> 2, h = bh & 3, t0 = c * 128;
                const u16* va = VT0 + ((size_t)(b * 1024 + h * 128 + dt * 32 + r)) * 4096 + t0 + 8 * hh;
                const u16* kb = KT + ((size_t)(b * 256 + h * 64 + r)) * 4096 + t0 + 8 * hh;
#pragma unroll
                for (int st = 0; st < 8; ++st) {
                    const bf16x8 a = ld16(va + 16 * st);
                    a0 = MFMA(a, ld16(kb + 16 * st), a0);
                    a1 = MFMA(a, ld16(kb + 32 * 4096 + 16 * st), a1);
                }
                const float cdec = __expf(128.f * gamma_log(h));
                float* o = KVT + (size_t)(bh * 32 + c) * 8192;
#pragma unroll
                for (int i = 0; i < 16; ++i) {
                    o[(dt * 32 + crow(i, hh)) * 64 + r] = cdec * a0[i];
                    o[(dt * 32 + crow(i, hh)) * 64 + 32 + r] = cdec * a1[i];
                }
            } else {
                const int v = u - 2048;
                const int dt = v & 3, c = (v >> 2) & 63, bh = v >> 8, b = bh >> 2, h = bh & 3, t0 = c * 64;
                const u16* va = VT0 + ((size_t)(b * 1024 + 512 + h * 128 + dt * 32 + r)) * 4096 + t0 + 8 * hh;
                const u16* kb = KWT + ((size_t)(b * 256 + h * 64 + r)) * 4096 + t0 + 8 * hh;
#pragma unroll
                for (int st = 0; st < 4; ++st) {
                    const bf16x8 a = ld16(va + 16 * st);
                    a0 = MFMA(a, ld16(kb + 16 * st), a0);
                    a1 = MFMA(a, ld16(kb + 32 * 4096 + 16 * st), a1);
                }
                float* o = UT + (size_t)(bh * 64 + c) * 8192;
#pragma unroll
                for (int i = 0; i < 16; ++i) {
                    o[(dt * 32 + crow(i, hh)) * 64 + r] = a0[i];
                    o[(dt * 32 + crow(i, hh)) * 64 + 32 + r] = a1[i];
                }
            }
        }
    };

    auto ph_4 = [&]() __attribute__((always_inline)) {
        const float* KVT = (const float*)(ws + O_KVT);
        const float* UT = (const float*)(ws + O_UT);
        const float* NC = (const float*)(ws + O_NC);
        const float* BLAST = (const float*)(ws + O_BLAST);
        const float* GC = (const float*)(ws + O_GC);
        u16* RT = (u16*)(ws + O_RT);
        u16* CT = (u16*)(ws + O_CT);
        float* MS = (float*)(ws + O_MS);
        float* NS = (float*)(ws + O_NS);
        for (int e = gtid; e < 131072 * 2 + 1024; e += gsz) {
            if (e < 131072) {
                const int bh = e >> 13, idx = e & 8191;
                const float cdec = __expf(128.f * gamma_log(bh & 3));
                float R = 0.f;
                float kvv[32];
#pragma unroll
                for (int c = 0; c < 32; ++c) kvv[c] = KVT[(size_t)(bh * 32 + c) * 8192 + idx];
#pragma unroll
                for (int c = 0; c < 32; ++c) {
                    RT[(size_t)(bh * 32 + c) * 8192 + idx] = f2bf(R);
                    R = cdec * R + kvv[c];
                }
            } else if (e < 262144) {
                const int e2 = e - 131072, bh = e2 >> 13, idx = e2 & 8191;
                float C = 0.f, m = 0.f;
                float utv[64];
#pragma unroll
                for (int c = 0; c < 64; ++c) utv[c] = UT[(size_t)(bh * 64 + c) * 8192 + idx];
#pragma unroll
                for (int c = 0; c < 64; ++c) {
                    const float G = GC[bh * 64 + c];
                    const float M = fmaxf(m, G);
                    const float dC = __expf(m - M), dU = __expf(G - M);
                    CT[(size_t)(bh * 64 + c) * 8192 + idx] = f2bf(C);
                    if (idx == 0) MS[bh * 64 + c] = m;
                    C = dC * C + dU * utv[c];
                    m = BLAST[bh * 64 + c] + M;
                }
            } else {
                const int e2 = e - 262144, bh = e2 >> 6, dk = e2 & 63;
                float n = 0.f, m = 0.f;
                for (int c = 0; c < 64; ++c) {
                    const float G = GC[bh * 64 + c];
                    const float M = fmaxf(m, G);
                    const float dC = __expf(m - M), dU = __expf(G - M);
                    NS[(size_t)(bh * 64 + c) * 64 + dk] = n;
                    n = dC * n + dU * NC[(size_t)(bh * 64 + c) * 64 + dk];
                    m = BLAST[bh * 64 + c] + M;
                }
            }
        }
    };

    auto ph_5 = [&]() __attribute__((always_inline)) {
        const u16* Z0 = (const u16*)P.out;
        const u16* VT0 = (const u16*)(ws + O_VT0);
        const u16* RT = (const u16*)(ws + O_RT);
        const u16* CT = (const u16*)(ws + O_CT);
        const u16* QM = (const u16*)(ws + O_QM);
        const u16* KM = (const u16*)(ws + O_KM);
        const float* GS = (const float*)(ws + O_GS); const float* BL = (const float*)(ws + O_BL); const float* PM = (const float*)(ws + O_PM);
        const float* MS = (const float*)(ws + O_MS); const float* NS = (const float*)(ws + O_NS);
        u16* MIX = HB0;
        for (int u = gw; u < 4096; u += ngw) {
            f32x16 o[4];
            if (u < 2048) {
                const int qt = u & 3, c = (u >> 2) & 31, bh = u >> 7, b = bh >> 2, h = bh & 3, t0 = c * 128, tq = t0 + qt * 32;
                const size_t rowb = (size_t)b * 4096;
                bf16x8 bq[4];
#pragma unroll
                for (int st = 0; st < 4; ++st) bq[st] = ld16(Z0 + (rowb + tq + r) * 2048 + h * 64 + 16 * st + 8 * hh);
                const u16* rt = RT + (size_t)(bh * 32 + c) * 8192;
#pragma unroll
                for (int dt = 0; dt < 4; ++dt) {
                    o[dt] = zero16();
#pragma unroll
                    for (int st = 0; st < 4; ++st) o[dt] = MFMA(ld16(rt + (dt * 32 + r) * 64 + 16 * st + 8 * hh), bq[st], o[dt]);
                }
                for (int kt = 0; kt <= qt; ++kt) {
                    f32x16 s = zero16();
#pragma unroll
                    for (int st = 0; st < 4; ++st) s = MFMA(ld16(Z0 + (rowb + t0 + kt * 32 + r) * 2048 + 256 + h * 64 + 16 * st + 8 * hh), bq[st], s);
                    if (kt == qt) {
#pragma unroll
                        for (int i = 0; i < 16; ++i) if (crow(i, hh) > r) s[i] = 0.f;
                    }
#pragma unroll
                    for (int s2 = 0; s2 < 2; ++s2) {
                        const bf16x8 pb = packp(s, s2);
#pragma unroll
                        for (int dt = 0; dt < 4; ++dt) {
                            const u16* vp = VT0 + ((size_t)(b * 1024 + h * 128 + dt * 32 + r)) * 4096 + t0 + kt * 32 + 16 * s2 + 4 * hh;
                            o[dt] = MFMA(ld8x2(vp, vp + 8), pb, o[dt]);
                        }
                    }
                }
                const float qdec = __expf((float)(qt * 32 + r + 1) * gamma_log(h));
                float ss = 0.f;
#pragma unroll
                for (int dt = 0; dt < 4; ++dt)
#pragma unroll
                    for (int i = 0; i < 16; ++i) { o[dt][i] *= qdec; ss += o[dt][i] * o[dt][i]; }
                ss += __shfl_xor(ss, 32);
                const float rs = rsqrtf(ss * (1.f / 128.f) + EPS);
                const size_t row = rowb + tq + r;
#pragma unroll
                for (int dt = 0; dt < 4; ++dt)
#pragma unroll
                    for (int i4 = 0; i4 < 4; ++i4) {
                        const int dv = dt * 32 + 8 * i4 + 4 * hh;
                        const u32x2 gv = *(const u32x2*)(Z0 + row * 2048 + 512 + h * 128 + dv);
                        const float g0 = bflo(gv.x), g1 = bfhi(gv.x), g2 = bflo(gv.y), g3 = bfhi(gv.y);
                        const float4 ng = *(const float4*)(P.ab_ret_norm_g + h * 128 + dv);
                        const float y0 = o[dt][i4 * 4 + 0] * rs * ng.x * (g0 * sigmoidf_(g0));
                        const float y1 = o[dt][i4 * 4 + 1] * rs * ng.y * (g1 * sigmoidf_(g1));
                        const float y2 = o[dt][i4 * 4 + 2] * rs * ng.z * (g2 * sigmoidf_(g2));
                        const float y3 = o[dt][i4 * 4 + 3] * rs * ng.w * (g3 * sigmoidf_(g3));
                        u32x2 ov = {pk2(y0, y1), pk2(y2, y3)};
                        *(u32x2*)(MIX + row * 1024 + h * 128 + dv) = ov;
                    }
            } else {
                const int v = u - 2048;
                const int qt = v & 1, c = (v >> 1) & 63, bh = v >> 7, b = bh >> 2, h = bh & 3, t0 = c * 64, tq = t0 + qt * 32;
                const size_t rowb = (size_t)b * 4096;
                const size_t row = rowb + tq + r;
                const float mc = MS[bh * 64 + c];
                const float Ml = fmaxf(mc, PM[bh * 4096 + tq + r]);
                const float bl = BL[bh * 4096 + tq + r];
                const float wint = __expf(mc - Ml);
                bf16x8 bq[4];
#pragma unroll
                for (int st = 0; st < 4; ++st) bq[st] = ld16(QM + row * 256 + h * 64 + 16 * st + 8 * hh);
                const u16* ct = CT + (size_t)(bh * 64 + c) * 8192;
#pragma unroll
                for (int dt = 0; dt < 4; ++dt) {
                    o[dt] = zero16();
#pragma unroll
                    for (int st = 0; st < 4; ++st) o[dt] = MFMA(ld16(ct + (dt * 32 + r) * 64 + 16 * st + 8 * hh), bq[st], o[dt]);
#pragma unroll
                    for (int i = 0; i < 16; ++i) o[dt][i] *= wint;
                }
                float qn = 0.f;
                {
                    const u16* qp = QM + row * 256 + h * 64 + 32 * hh;
                    const float* np = NS + (size_t)(bh * 64 + c) * 64 + 32 * hh;
#pragma unroll
                    for (int j = 0; j < 32; ++j) qn += bf2f(qp[j]) * np[j];
                    qn += __shfl_xor(qn, 32);
                }
                float den = 0.f;
                for (int kt = 0; kt <= qt; ++kt) {
                    f32x16 s = zero16();
#pragma unroll
                    for (int st = 0; st < 4; ++st) s = MFMA(ld16(KM + (rowb + t0 + kt * 32 + r) * 256 + h * 64 + 16 * st + 8 * hh), bq[st], s);
#pragma unroll
                    for (int i4 = 0; i4 < 4; ++i4) {
                        const float4 gg = *(const float4*)(GS + bh * 4096 + t0 + kt * 32 + 8 * i4 + 4 * hh);
                        const float ga[4] = {gg.x, gg.y, gg.z, gg.w};
#pragma unroll
                        for (int j = 0; j < 4; ++j) {
                            const int i = i4 * 4 + j;
                            float d = __expf(ga[j] - Ml);
                            if (kt == qt && crow(i, hh) > r) d = 0.f;
                            s[i] *= d; den += s[i];
                        }
                    }
#pragma unroll
                    for (int s2 = 0; s2 < 2; ++s2) {
                        const bf16x8 pb = packp(s, s2);
#pragma unroll
                        for (int dt = 0; dt < 4; ++dt) {
                            const u16* vp = VT0 + ((size_t)(b * 1024 + 512 + h * 128 + dt * 32 + r)) * 4096 + t0 + kt * 32 + 16 * s2 + 4 * hh;
                            o[dt] = MFMA(ld8x2(vp, vp + 8), pb, o[dt]);
                        }
                    }
                }
                den += __shfl_xor(den, 32);
                den += wint * qn;
                const float dinv = 1.f / fmaxf(fabsf(den), __expf(-(bl + Ml)));
                float ss = 0.f;
#pragma unroll
                for (int dt = 0; dt < 4; ++dt)
#pragma unroll
                    for (int i = 0; i < 16; ++i) { o[dt][i] *= dinv; ss += o[dt][i] * o[dt][i]; }
                ss += __shfl_xor(ss, 32);
                const float rs = rsqrtf(ss * (1.f / 128.f) + EPS);
#pragma unroll
                for (int dt = 0; dt < 4; ++dt)
#pragma unroll
                    for (int i4 = 0; i4 < 4; ++i4) {
                        const int dv = dt * 32 + 8 * i4 + 4 * hh;
                        const u32x2 gv = *(const u32x2*)(Z0 + row * 2048 + 1536 + h * 128 + dv);
                        const float4 ng = *(const float4*)(P.ab_m_norm_g + h * 128 + dv);
                        const float y0 = o[dt][i4 * 4 + 0] * rs * ng.x * sigmoidf_(bflo(gv.x));
                        const float y1 = o[dt][i4 * 4 + 1] * rs * ng.y * sigmoidf_(bfhi(gv.x));
                        const float y2 = o[dt][i4 * 4 + 2] * rs * ng.z * sigmoidf_(bflo(gv.y));
                        const float y3 = o[dt][i4 * 4 + 3] * rs * ng.w * sigmoidf_(bfhi(gv.y));
                        u32x2 ov = {pk2(y0, y1), pk2(y2, y3)};
                        *(u32x2*)(MIX + row * 1024 + 512 + h * 128 + dv) = ov;
                    }
            }
        }
    };

    auto resid_gemm = [&](const u16* A, int lda, const u16* Wt, int K, const float* resid, u16* hb_out, u64* ss_out, float scale) __attribute__((always_inline)) {
        for (int tile = blk; tile < tile_bound(128, 8); tile += nblk) {
            int mt, nt; if (!tile_decode(tile, 128, 8, mt, nt)) continue;
            const int m0 = mt * 128, n0 = nt * 128;
            f32x16 acc[2][2];
            const u16* Ab = A + (size_t)m0 * lda;
            gemm_main<false>(acc, [&](int row) { return Ab + (size_t)row * lda; }, 1, Wt, K, n0, K, As, Bs);
            const size_t rbase = (size_t)(m0 + wm * 64 + 4 * hh) * 1024 + n0 + wn * 64 + r;
            float rv[2][2][16];
#pragma unroll
            for (int mi = 0; mi < 2; ++mi)
#pragma unroll
                for (int ni = 0; ni < 2; ++ni)
#pragma unroll
                    for (int i = 0; i < 16; ++i) rv[mi][ni][i] = resid[rbase + (size_t)(mi * 32 + (i & 3) + 8 * (i >> 2)) * 1024 + ni * 32];
            float sqv[2][16];
#pragma unroll
            for (int mi = 0; mi < 2; ++mi)
#pragma unroll
                for (int i = 0; i < 16; ++i) {
                    float sq = 0.f;
#pragma unroll
                    for (int ni = 0; ni < 2; ++ni) {
                        const size_t o = rbase + (size_t)(mi * 32 + (i & 3) + 8 * (i >> 2)) * 1024 + ni * 32;
                        const float hv = rv[mi][ni][i] + scale * acc[mi][ni][i];
                        P.out[o] = hv;
                        if (hb_out) hb_out[o] = f2bf(hv);
                        sq += hv * hv;
                    }
                    sqv[mi][i] = sq;
                }
            if (ss_out) {
#pragma unroll
                for (int mi = 0; mi < 2; ++mi)
#pragma unroll
                    for (int i = 0; i < 16; ++i) {
                        const float s = red32(sqv[mi][i]);
                        if (r == 0) atomicAdd(ss_out + (m0 + wm * 64 + mi * 32 + crow(i, hh)), ss_fix(s));
                    }
            }
        }
    };
    auto ffn_up_phase = [&](int li, const u16* hb, const u64* ss_in, u64* sse, bool do_ss) __attribute__((always_inline)) {
        const u16* Wt = (const u16*)(ws + O_WUP + li * SZ_WUP);
        const u16* Wp = (const u16*)(ws + O_WPLE + li * SZ_WPLE);
        u16* ACT = (u16*)(ws + O_ACT);
        u16* ERAW = (u16*)(ws + O_ERAW);
        const float* cw = P.ffn_conv_w + li * 3 * 2816;
        const float* cb = P.ffn_conv_b + li * 2816;
        const float* pin = P.p + (size_t)li * MT * 256;
        u16* SA = (u16*)smem;
        u16* SB = SA + 128 * 66;
        for (int pass = 0; pass < 2; ++pass)
        for (int tile = blk; tile < (pass ? tile_bound(128, 8) : tile_bound(132, 44)); tile += nblk) {
            f32x16 acc[2][2];
            int mt, nt; if (!tile_decode(tile, pass ? 128 : 132, pass ? 8 : 44, mt, nt)) continue;
            if (pass == 0) {
                const int b = mt / 33, jt = mt % 33, tok0 = jt * 126 - 2, n0 = nt * 128;
                const u16* Ab = hb + (size_t)b * 4096 * DM;
                gemm_main<false>(acc, [&](int row) { int tk = tok0 + row; tk = tk < 0 ? 0 : (tk > 4095 ? 4095 : tk); return Ab + (size_t)tk * DM; }, 1, Wt, 1024, n0, 1024, As, Bs);
                __syncthreads();
#pragma unroll
                for (int mi = 0; mi < 2; ++mi)
#pragma unroll
                    for (int i = 0; i < 16; ++i) {
                        const int rl = wm * 64 + mi * 32 + crow(i, hh);
                        const int tok = tok0 + rl;
                        const int tkc = tok < 0 ? 0 : (tok > 4095 ? 4095 : tok);
                        const float rs = ss_rstd(ss_in[b * 4096 + tkc]);
#pragma unroll
                        for (int ni = 0; ni < 2; ++ni) {
                            float v = acc[mi][ni][i] * rs;
                            if (tok < 0) v = 0.f;
                            (wn == 0 ? SA : SB)[rl * 66 + ni * 32 + r] = f2bf(v);
                        }
                    }
                __syncthreads();
                for (int e = tid; e < 126 * 64; e += 256) {
                    const int rl = 2 + (e >> 6), cl = e & 63, tok = tok0 + rl;
                    if (tok < 4096) {
                        const int f = nt * 64 + cl;
                        const float a = cb[f] + cw[f] * bf2f(SA[(rl - 2) * 66 + cl]) + cw[2816 + f] * bf2f(SA[(rl - 1) * 66 + cl]) + cw[5632 + f] * bf2f(SA[rl * 66 + cl]);
                        ACT[((size_t)b * 4096 + tok) * 2816 + f] = f2bf(gelu_tanh(a) * bf2f(SB[rl * 66 + cl]));
                    }
                }
            } else {
                const int m0 = mt * 128, n0 = nt * 128;
                const float* Ab = pin + (size_t)m0 * 256;
                gemm_main<true>(acc, [&](int row) { return Ab + (size_t)row * 256; }, 1, Wp, 256, n0, 256, As, Bs);
#pragma unroll
                for (int mi = 0; mi < 2; ++mi)
#pragma unroll
                    for (int i = 0; i < 16; ++i) {
                        const size_t row = m0 + wm * 64 + mi * 32 + crow(i, hh);
                        float sq = 0.f;
#pragma unroll
                        for (int ni = 0; ni < 2; ++ni) {
                            const int col = n0 + wn * 64 + ni * 32 + r;
                            const float v = acc[mi][ni][i];
                            ERAW[row * 1024 + col] = f2bf(v);
                            sq += v * v;
                        }
                        sq = red32(sq); if (do_ss && r == 0) atomicAdd(sse + row, ss_fix(sq));
                    }
            }
        }
    };
    auto gate_phase = [&](int li, const u16* hb, const u64* ss_in, const u64* sse, u16* hb_out, u64* ss_out, float scale) __attribute__((always_inline)) {
        const u16* Wt = (const u16*)(ws + O_WGATE + li * SZ_WGATE);
        const u16* ERAW = (const u16*)(ws + O_ERAW);
        const float* eg = P.ple_norm_g + li * 1024;
        for (int tile = blk; tile < tile_bound(128, 8); tile += nblk) {
            int mt, nt; if (!tile_decode(tile, 128, 8, mt, nt)) continue;
            const int m0 = mt * 128, n0 = nt * 128;
            f32x16 acc[2][2];
            const u16* Ab = hb + (size_t)m0 * DM;
            gemm_main<false>(acc, [&](int row) { return Ab + (size_t)row * DM; }, 1, Wt, 1024, n0, 1024, As, Bs);
            const size_t rbase = (size_t)(m0 + wm * 64 + 4 * hh) * 1024 + n0 + wn * 64 + r;
            float ov[2][2][16], ev[2][2][16], rsv[2][16], rev[2][16];
#pragma unroll
            for (int mi = 0; mi < 2; ++mi)
#pragma unroll
                for (int i = 0; i < 16; ++i) {
                    const int row = m0 + wm * 64 + mi * 32 + crow(i, hh);
                    rsv[mi][i] = ss_rstd(ss_in[row]);
                    rev[mi][i] = ss_rstd(sse[row]);
#pragma unroll
                    for (int ni = 0; ni < 2; ++ni) {
                        const size_t o = rbase + (size_t)(mi * 32 + (i & 3) + 8 * (i >> 2)) * 1024 + ni * 32;
                        ov[mi][ni][i] = P.out[o];
                        ev[mi][ni][i] = bf2f(ERAW[o]);
                    }
                }
            const float eg0 = eg[n0 + wn * 64 + r], eg1 = eg[n0 + wn * 64 + 32 + r];
            float sqv[2][16];
#pragma unroll
            for (int mi = 0; mi < 2; ++mi)
#pragma unroll
                for (int i = 0; i < 16; ++i) {
                    float sq = 0.f;
#pragma unroll
                    for (int ni = 0; ni < 2; ++ni) {
                        const size_t o = rbase + (size_t)(mi * 32 + (i & 3) + 8 * (i >> 2)) * 1024 + ni * 32;
                        const float gt = sigmoidf_(acc[mi][ni][i] * rsv[mi][i]);
                        const float e = ev[mi][ni][i] * rev[mi][i] * (ni ? eg1 : eg0);
                        const float hv = ov[mi][ni][i] + scale * gt * e;
                        P.out[o] = hv;
                        if (hb_out) hb_out[o] = f2bf(hv);
                        sq += hv * hv;
                    }
                    sqv[mi][i] = sq;
                }
            if (ss_out) {
#pragma unroll
                for (int mi = 0; mi < 2; ++mi)
#pragma unroll
                    for (int i = 0; i < 16; ++i) {
                        const float s = red32(sqv[mi][i]);
                        if (r == 0) atomicAdd(ss_out + (m0 + wm * 64 + mi * 32 + crow(i, hh)), ss_fix(s));
                    }
            }
        }
    };

    auto ph_6 = [&](bool dry) __attribute__((always_inline)) { if (!dry) resid_gemm(HB0, 1024, (const u16*)(ws + O_WABOUT), 1024, P.x, HB1, SS + 1 * MT, 1.f); else resid_gemm(HB0, 1024, (const u16*)(ws + O_WABOUT), 1024, P.out, (u16*)nullptr, (u64*)nullptr, 0.f); };
    auto ph_7 = [&](bool dry) __attribute__((always_inline)) { ffn_up_phase(0, HB1, SS + 1 * MT, SS + 6 * MT, !dry); };
    auto ph_8 = [&](bool dry) __attribute__((always_inline)) { if (!dry) resid_gemm((const u16*)(ws + O_ACT), 2816, (const u16*)(ws + O_WDOWN), 2816, P.out, HB0, SS + 2 * MT, 1.f); else resid_gemm((const u16*)(ws + O_ACT), 2816, (const u16*)(ws + O_WDOWN), 2816, P.out, (u16*)nullptr, (u64*)nullptr, 0.f); };
    auto ph_9 = [&](bool dry) __attribute__((always_inline)) { if (!dry) gate_phase(0, HB0, SS + 2 * MT, SS + 6 * MT, HB1, SS + 3 * MT, 1.f); else gate_phase(0, HB0, SS + 2 * MT, SS + 6 * MT, (u16*)nullptr, (u64*)nullptr, 0.f); };

    auto ph_10 = [&]() __attribute__((always_inline)) {
        const u16* Wt = (const u16*)(ws + O_WNSAIN);
        u16* QN = (u16*)(ws + O_QN); u16* KCVC = (u16*)(ws + O_KCVC); u16* KSN = (u16*)(ws + O_KSN); u16* KWN = (u16*)(ws + O_KWN);
        u16* VST = (u16*)(ws + O_VST); u16* VWT = (u16*)(ws + O_VWT); float* GT1 = (float*)(ws + O_GT1);
        const u64* ssin = SS + 3 * MT;
        for (int tile = blk; tile < tile_bound(128, 15); tile += nblk) {
            int mt, nt; if (!tile_decode(tile, 128, 15, mt, nt)) continue;
            const int m0 = mt * 128, n0 = nt * 128;
            f32x16 acc[2][2];
            const u16* Ab = HB1 + (size_t)m0 * DM;
            gemm_main<false>(acc, [&](int row) { return Ab + (size_t)row * DM; }, 1, Wt, 1024, n0, 1024, As, Bs);
            const int colw = n0 + wn * 64;
            float rsv[2][16];
#pragma unroll
            for (int mi = 0; mi < 2; ++mi)
#pragma unroll
                for (int i = 0; i < 16; ++i) rsv[mi][i] = ss_rstd(ssin[m0 + wm * 64 + mi * 32 + crow(i, hh)]);
#pragma unroll
            for (int mi = 0; mi < 2; ++mi) {
#pragma unroll
                for (int i4 = 0; i4 < 4; ++i4) {
                    float v0[4], v1[4];
                    const int rowb = m0 + wm * 64 + mi * 32 + 8 * i4 + 4 * hh;
#pragma unroll
                    for (int j = 0; j < 4; ++j) {
                        const float rs = rsv[mi][i4 * 4 + j];
                        v0[j] = acc[mi][0][i4 * 4 + j] * rs;
                        v1[j] = acc[mi][1][i4 * 4 + j] * rs;
                    }
                    const int bb = rowb >> 12, t = rowb & 4095;
                    if (nt < 8 || nt == 10 || nt == 12) {
                        const float* gn = (nt < 8) ? P.nsa_q_norm_g : (nt == 10 ? P.nsa_k_norm_g + 64 : P.nsa_k_norm_g + 128);
                        const float g0 = gn[r], g1 = gn[32 + r];
                        const float sc = (nt < 8) ? 0.125f * 1.4426950408889634f : 1.f;
#pragma unroll
                        for (int j = 0; j < 4; ++j) {
                            const float ss = red32(v0[j] * v0[j] + v1[j] * v1[j]);
                            const float rn = rsqrtf(ss * (1.f / 64.f) + EPS) * sc;
                            const u16 y0 = f2bf(v0[j] * rn * g0), y1 = f2bf(v1[j] * rn * g1);
                            if (nt < 8) { QN[(size_t)(rowb + j) * 1024 + colw + r] = y0; QN[(size_t)(rowb + j) * 1024 + colw + 32 + r] = y1; }
                            else {
                                u16* dst = (nt == 10) ? KSN : KWN;
                                dst[(size_t)(rowb + j) * 128 + wn * 64 + r] = y0; dst[(size_t)(rowb + j) * 128 + wn * 64 + 32 + r] = y1;
                            }
                        }
                    } else if (nt == 8 || nt == 9) {
                        const int cc = (nt - 8) * 128 + wn * 64;
#pragma unroll
                        for (int j = 0; j < 4; ++j) {
                            KCVC[(size_t)(rowb + j) * 256 + cc + r] = f2bf(v0[j]);
                            KCVC[(size_t)(rowb + j) * 256 + cc + 32 + r] = f2bf(v1[j]);
                        }
                    } else if (nt == 11 || nt == 13) {
                        u16* dst = (nt == 11) ? VST : VWT;
                        u32x2 o0 = {pk2(v0[0], v0[1]), pk2(v0[2], v0[3])}, o1 = {pk2(v1[0], v1[1]), pk2(v1[2], v1[3])};
                        *(u32x2*)(dst + ((size_t)(bb * 128 + wn * 64 + r)) * 4096 + t) = o0;
                        *(u32x2*)(dst + ((size_t)(bb * 128 + wn * 64 + 32 + r)) * 4096 + t) = o1;
                    } else {
                        if (wn == 0) {
#pragma unroll
                            for (int j = 0; j < 4; ++j) {
                                GT1[(size_t)(rowb + j) * 48 + r] = sigmoidf_(v0[j] + P.nsa_gate_b[r]);
                                if (r < 16) GT1[(size_t)(rowb + j) * 48 + 32 + r] = sigmoidf_(v1[j] + P.nsa_gate_b[32 + r]);
                            }
                        }
                    }
                }
            }
        }
    };

    auto ph_11 = [&]() __attribute__((always_inline)) {
        const u16* KCVC = (const u16*)(ws + O_KCVC);
        u16* HID = (u16*)(ws + O_HID);
        const float* B1 = (const float*)(ws + O_BIAS1);
        for (int tile = RB(5, blk, nblk); tile < 64; tile += RS(5, nblk)) {
            const int kv = tile >> 5, mt = (tile >> 1) & 15, nt = tile & 1, m0 = mt * 128, n0 = nt * 128;
            const u16* Wt = (const u16*)(ws + (kv ? O_WC1V : O_WC1K));
            f32x16 acc[2][2];
            gemm_main<false>(acc, [&](int row) {
                int R = m0 + row; R = R > 2039 ? 2039 : R;
                const int bg = R / 255, n = R - bg * 255, b = bg >> 1, g = bg & 1;
                return KCVC + ((size_t)b * 4096 + 16 * n) * 256 + kv * 128 + g * 64;
            }, 4, Wt, 2048, n0, 2048, As, Bs);
#pragma unroll
            for (int mi = 0; mi < 2; ++mi)
#pragma unroll
                for (int i = 0; i < 16; ++i) {
                    const int R = m0 + wm * 64 + mi * 32 + crow(i, hh);
#pragma unroll
                    for (int ni = 0; ni < 2; ++ni) {
                        const int col = n0 + wn * 64 + ni * 32 + r;
                        if (R < 2040) HID[((size_t)kv * 2048 + R) * 256 + col] = f2bf(gelu_tanh(acc[mi][ni][i] + B1[kv * 256 + col]));
                    }
                }
        }
    };

    auto ph_12 = [&]() __attribute__((always_inline)) {
        const u16* HID = (const u16*)(ws + O_HID);
        u16* KCN = (u16*)(ws + O_KCN);
        u16* VCT = (u16*)(ws + O_VCT);
        for (int tile = RB(6, blk, nblk); tile < 32; tile += RS(6, nblk)) {
            const int kv = tile >> 4, mt = tile & 15, m0 = mt * 128;
            const u16* Wt = (const u16*)(ws + (kv ? O_WC2V : O_WC2K));
            const u16* Ab = HID + ((size_t)kv * 2048 + m0) * 256;
            f32x16 acc[2][2];
            gemm_main<false>(acc, [&](int row) { return Ab + (size_t)row * 256; }, 1, Wt, 256, 0, 256, As, Bs);
            if (wn == 0) {
#pragma unroll
                for (int mi = 0; mi < 2; ++mi)
#pragma unroll
                    for (int i = 0; i < 16; ++i) {
                        const int R = m0 + wm * 64 + mi * 32 + crow(i, hh);
                        const float v0 = acc[mi][0][i], v1 = acc[mi][1][i];
                        const float ss = red32(v0 * v0 + v1 * v1);
                        if (R < 2040) {
                            const int bg = R / 255, n = R - bg * 255;
                            if (kv == 0) {
                                const float rn = rsqrtf(ss * (1.f / 64.f) + EPS);
                                KCN[((size_t)bg * 256 + n) * 64 + r] = f2bf(v0 * rn * P.nsa_k_norm_g[r]);
                                KCN[((size_t)bg * 256 + n) * 64 + 32 + r] = f2bf(v1 * rn * P.nsa_k_norm_g[32 + r]);
                            } else {
                                VCT[((size_t)bg * 64 + r) * 256 + n] = f2bf(v0);
                                VCT[((size_t)bg * 64 + 32 + r) * 256 + n] = f2bf(v1);
                            }
                        }
                    }
            }
        }
        for (int u = gtid; u < 8 * 64; u += gsz) { KCN[((size_t)(u >> 6) * 256 + 255) * 64 + (u & 63)] = 0; VCT[((size_t)u) * 256 + 255] = 0; }
    };

    auto ph_13 = [&]() __attribute__((always_inline)) {
        const u16* QN = (const u16*)(ws + O_QN);
        const u16* KCN = (const u16*)(ws + O_KCN);
        const u16* VCT = (const u16*)(ws + O_VCT);
        const float* GT1 = (const float*)(ws + O_GT1);
        u16* OCMP = (u16*)(ws + O_OCMP);
        u64* SEL = (u64*)(ws + O_SEL);
        float* sc_lds = (float*)smem + wave * (32 * 65);
        for (int u0 = blk * 4; u0 < 1024; u0 += nblk * 4) {
            const int u = u0 + wave;
            const int qt = u & 127, bg = u >> 7, b = bg >> 1, g = bg & 1, tq = qt * 32, t = tq + r;
            const size_t row = (size_t)b * 4096 + t;
            const int nkt = (tq >> 9) + 1;
            u16* kl = (u16*)smem;
            u16* vl = kl + 256 * 72;
            __syncthreads();
#pragma unroll
            for (int c8 = 0; c8 < 8; ++c8) {
                const int c = tid + 256 * c8;
                *(u32x4*)(kl + (c >> 3) * 72 + (c & 7) * 8) = *(const u32x4*)(KCN + ((size_t)bg * 256 + (c >> 3)) * 64 + (c & 7) * 8);
                *(u32x4*)(vl + (c >> 5) * 264 + (c & 31) * 8) = *(const u32x4*)(VCT + ((size_t)bg * 64 + (c >> 5)) * 256 + (c & 31) * 8);
            }
            __syncthreads();
            f32x16 imp[2];
            imp[0] = zero16(); imp[1] = zero16();
            for (int hg = 0; hg < 8; ++hg) {
                const int head = g * 8 + hg;
                bf16x8 bq[4];
#pragma unroll
                for (int st = 0; st < 4; ++st) bq[st] = ld16(QN + row * 1024 + head * 64 + 16 * st + 8 * hh);
                float m = -1e30f, l = 0.f;
                for (int kt = 0; kt < nkt; ++kt) {
                    f32x16 s = zero16();
#pragma unroll
                    for (int st = 0; st < 4; ++st) s = MFMA(ld16(kl + (kt * 32 + r) * 72 + 16 * st + 8 * hh), bq[st], s);
                    float mx = -1e30f;
#pragma unroll
                    for (int i = 0; i < 16; ++i) {
                        const int n = kt * 32 + crow(i, hh);
                        if (16 * n + 31 > t) s[i] = -1e30f;
                        mx = fmaxf(mx, s[i]);
                    }
                    mx = fmaxf(mx, __shfl_xor(mx, 32));
                    const float mn = fmaxf(m, mx);
                    float ps = 0.f;
#pragma unroll
                    for (int i = 0; i < 16; ++i) ps += __builtin_amdgcn_exp2f(s[i] - mn);
                    l = l * __builtin_amdgcn_exp2f(m - mn) + ps;
                    m = mn;
                }
                l += __shfl_xor(l, 32);
                const float inv = (t >= 31) ? 1.f / l : 0.f;
                f32x16 ao[2];
                ao[0] = zero16(); ao[1] = zero16();
                for (int kt = 0; kt < nkt; ++kt) {
                    f32x16 s = zero16();
#pragma unroll
                    for (int st = 0; st < 4; ++st) s = MFMA(ld16(kl + (kt * 32 + r) * 72 + 16 * st + 8 * hh), bq[st], s);
#pragma unroll
                    for (int i = 0; i < 16; ++i) {
                        const int n = kt * 32 + crow(i, hh);
                        s[i] = (16 * n + 31 > t) ? 0.f : __builtin_amdgcn_exp2f(s[i] - m) * inv;
                    }
#pragma unroll
                    for (int s2 = 0; s2 < 2; ++s2) {
                        const bf16x8 pb = packp(s, s2);
#pragma unroll
                        for (int dt = 0; dt < 2; ++dt) {
                            const u16* vp = vl + (dt * 32 + r) * 264 + kt * 32 + 16 * s2 + 4 * hh;
                            ao[dt] = MFMA(ld8x2(vp, vp + 8), pb, ao[dt]);
                        }
#pragma unroll
                        for (int bt = 0; bt < 2; ++bt) {
                            const int sb = bt * 32 + r;
                            bf16x8 ov;
#pragma unroll
                            for (int j = 0; j < 8; ++j) {
                                const int n = kt * 32 + 16 * s2 + 8 * (j >> 2) + 4 * hh + (j & 3);
                                ov[j] = (n >= 4 * sb - 1 && n <= 4 * sb + 3) ? (short)0x3F80 : (short)0;
                            }
                            imp[bt] = MFMA(ov, pb, imp[bt]);
                        }
                    }
                }
                const float g0 = GT1[row * 48 + head * 3 + 0];
#pragma unroll
                for (int dt = 0; dt < 2; ++dt)
#pragma unroll
                    for (int i4 = 0; i4 < 4; ++i4) {
                        const int d = dt * 32 + 8 * i4 + 4 * hh;
                        u32x2 ov = {pk2(ao[dt][i4 * 4 + 0] * g0, ao[dt][i4 * 4 + 1] * g0), pk2(ao[dt][i4 * 4 + 2] * g0, ao[dt][i4 * 4 + 3] * g0)};
                        *(u32x2*)(OCMP + row * 1024 + head * 64 + d) = ov;
                    }
            }
            const int cur = t >> 6;
            __syncthreads();
#pragma unroll
            for (int bt = 0; bt < 2; ++bt)
#pragma unroll
                for (int i = 0; i < 16; ++i) {
                    const int sb = bt * 32 + crow(i, hh);
                    const bool forced = (sb == 0) || (sb == cur) || (sb == cur - 1);
                    const float sc = forced ? 1e30f : (sb <= cur ? imp[bt][i] : -1e30f);
                    sc_lds[r * 65 + sb] = sc;
                }
            __syncthreads();
            for (int q = 0; q < 32; ++q) {
                const float v = sc_lds[q * 65 + lane];
                int cnt = 0;
                for (int sp = 0; sp < 64; ++sp) {
                    const float c = __shfl(v, sp);
                    cnt += ((c > v) || (c == v && sp < lane)) ? 1 : 0;
                }
                const u64 mask = __ballot(cnt < 16);
                if (lane == 0) SEL[(size_t)bg * 4096 + tq + q] = mask;
            }
        }
        __syncthreads();
    };

    auto ph_14 = [&]() __attribute__((always_inline)) {
        const u16* QN = (const u16*)(ws + O_QN);
        const u16* KSN = (const u16*)(ws + O_KSN); const u16* KWN = (const u16*)(ws + O_KWN);
        const u16* VST = (const u16*)(ws + O_VST); const u16* VWT = (const u16*)(ws + O_VWT);
        const float* GT1 = (const float*)(ws + O_GT1);
        const u16* OCMP = (const u16*)(ws + O_OCMP);
        const u64* SEL = (const u64*)(ws + O_SEL);
        u16* OBUF = (u16*)(ws + O_OBUF);
        constexpr int KST = 72, VSTR = 40, BUFEL = 32 * KST + 64 * VSTR;
        float mbound;
        {
            float gq = fabsf(P.nsa_q_norm_g[lane]);
            float gk = fmaxf(fabsf(P.nsa_k_norm_g[64 + lane]), fabsf(P.nsa_k_norm_g[128 + lane]));
#pragma unroll
            for (int off = 1; off < 64; off <<= 1) { gq = fmaxf(gq, __shfl_xor(gq, off)); gk = fmaxf(gk, __shfl_xor(gk, off)); }
            mbound = 8.f * 1.4426950408889634f * gq * gk * 1.02f;
        }
        u16* stage = (u16*)smem;
        int* tl = (int*)(stage + 2 * BUFEL);
        for (int item = blk; item < 1024; item += nblk) {
            const int kk = item / nblk, v = item - kk * nblk;
            const int q0 = v & 127, bg = (nblk == 256) ? ((v >> 7) * 4 + kk) : (item >> 7);
            const int qt = (nblk == 256) ? ((kk & 1) ? 127 - q0 : q0) : (item & 127);
            const int b = bg >> 1, g = bg & 1, tq = qt * 32, t = tq + r;
            const size_t rowb = (size_t)b * 4096, row = rowb + t;
            const int h0 = g * 8 + wave * 2;
            bf16x8 bq[2][4];
#pragma unroll
            for (int hd = 0; hd < 2; ++hd)
#pragma unroll
                for (int st = 0; st < 4; ++st) bq[hd][st] = ld16(QN + row * 1024 + (h0 + hd) * 64 + 16 * st + 8 * hh);
            const u64 selm = SEL[(size_t)bg * 4096 + t];
            unsigned ulo = (unsigned)selm, uhi = (unsigned)(selm >> 32);
#pragma unroll
            for (int off = 1; off < 32; off <<= 1) { ulo |= __shfl_xor(ulo, off); uhi |= __shfl_xor(uhi, off); }
            const u64 uni = ((u64)uhi << 32) | ulo;
            __syncthreads();
            if (tid == 0) {
                int n = 0;
                for (int kt = (qt > 16 ? qt - 16 : 0); kt <= qt; ++kt) tl[n++] = kt | (1 << 16);
                const int jmax = (tq + 31) >> 6;
                for (int j = 0; j <= jmax; ++j)
                    if ((uni >> j) & 1ull) { tl[n++] = 2 * j; if ((2 * j + 1) * 32 <= tq + 31) tl[n++] = 2 * j + 1; }
                tl[159] = n;
            }
            __syncthreads();
            const int ntile = tl[159];
            u32x4 kr[3], vr[3];
            auto ldt = [&](u32x4& kreg, u32x4& vreg, int e) __attribute__((always_inline)) {
                const int kt = e & 0xffff, br = e >> 16;
                const u16* Kp = br ? KWN : KSN;
                const u16* Vp = br ? VWT : VST;
                kreg = *(const u32x4*)(Kp + (rowb + kt * 32 + (tid >> 3)) * 128 + g * 64 + (tid & 7) * 8);
                vreg = *(const u32x4*)(Vp + ((size_t)(b * 128 + g * 64 + (tid >> 2))) * 4096 + kt * 32 + (tid & 3) * 8);
            };
            auto stt = [&](const u32x4& kreg, const u32x4& vreg, int p) __attribute__((always_inline)) {
                u16* kb = stage + p * BUFEL;
                *(u32x4*)(kb + (tid >> 3) * KST + (tid & 7) * 8) = kreg;
                *(u32x4*)(kb + 32 * KST + (tid >> 2) * VSTR + (tid & 3) * 8) = vreg;
            };
            f32x16 res[2][2], ao[2][2];
#pragma unroll
            for (int hd = 0; hd < 2; ++hd)
#pragma unroll
                for (int dt = 0; dt < 2; ++dt) { res[hd][dt] = zero16(); ao[hd][dt] = zero16(); }
            float l[2] = {0.f, 0.f};
            int curbr = 1;
            auto finalize = [&](int br) __attribute__((always_inline)) {
#pragma unroll
                for (int hd = 0; hd < 2; ++hd) {
                    const float lt = l[hd] + __shfl_xor(l[hd], 32);
                    const float gsc = GT1[row * 48 + (h0 + hd) * 3 + 1 + br] / lt;
#pragma unroll
                    for (int dt = 0; dt < 2; ++dt)
#pragma unroll
                        for (int i = 0; i < 16; ++i) { res[hd][dt][i] += ao[hd][dt][i] * gsc; ao[hd][dt][i] = 0.f; }
                    l[hd] = 0.f;
                }
            };
            ldt(kr[0], vr[0], tl[0]);
            if (1 < ntile) ldt(kr[1], vr[1], tl[1]);
            if (2 < ntile) ldt(kr[2], vr[2], tl[2]);
            stt(kr[0], vr[0], 0);
            if (3 < ntile) ldt(kr[0], vr[0], tl[3]);
            __syncthreads();
            for (int it0 = 0; it0 < ntile; it0 += 6) {
#pragma unroll
            for (int uu = 0; uu < 6; ++uu) {
                const int it = it0 + uu;
                if (it < ntile) {
                const int e = tl[it], kt = e & 0xffff, br = e >> 16, p = uu & 1;
                if (br != curbr) { finalize(curbr); curbr = br; }
                const u16* kb = stage + p * BUFEL;
                const u16* vb = kb + 32 * KST;
                f32x16 s[2];
                s[0] = zero16(); s[1] = zero16();
#pragma unroll
                for (int st = 0; st < 4; ++st) {
                    const bf16x8 a = *(const bf16x8*)(kb + r * KST + 16 * st + 8 * hh);
                    s[0] = MFMA(a, bq[0][st], s[0]);
                    s[1] = MFMA(a, bq[1][st], s[1]);
                }
                const bool bsel = br ? true : (((selm >> (kt >> 1)) & 1ull) != 0);
                const bool interior = (kt * 32 + 31 <= tq) && (!br || kt * 32 >= tq - 480);
                const bool needmask = !interior || (__ballot(!bsel) != 0ull);
                if (needmask) {
#pragma unroll
                    for (int i = 0; i < 16; ++i) {
                        const int pk = kt * 32 + crow(i, hh);
                        bool ok = bsel && (pk <= t);
                        if (br) ok = ok && (pk > t - 512);
                        if (!ok) { s[0][i] = -1e30f; s[1][i] = -1e30f; }
                    }
                }
#pragma unroll
                for (int hd = 0; hd < 2; ++hd) {
                    float ps = 0.f;
#pragma unroll
                    for (int i = 0; i < 16; ++i) { s[hd][i] = __builtin_amdgcn_exp2f(s[hd][i] - mbound); ps += s[hd][i]; }
                    l[hd] += ps;
                }
#pragma unroll
                for (int s2 = 0; s2 < 2; ++s2) {
                    const bf16x8 pb0 = packp(s[0], s2), pb1 = packp(s[1], s2);
#pragma unroll
                    for (int dt = 0; dt < 2; ++dt) {
                        const u16* vp = vb + (dt * 32 + r) * VSTR + 16 * s2 + 4 * hh;
                        const bf16x8 av = ld8x2(vp, vp + 8);
                        ao[0][dt] = MFMA(av, pb0, ao[0][dt]);
                        ao[1][dt] = MFMA(av, pb1, ao[1][dt]);
                    }
                }
                if (it + 1 < ntile) {
                    stt(kr[(uu + 1) % 3], vr[(uu + 1) % 3], p ^ 1);
                    if (it + 4 < ntile) ldt(kr[(uu + 1) % 3], vr[(uu + 1) % 3], tl[it + 4]);
                }
                __syncthreads();
                }
            }
            }
            finalize(curbr);
#pragma unroll
            for (int hd = 0; hd < 2; ++hd)
#pragma unroll
                for (int dt = 0; dt < 2; ++dt)
#pragma unroll
                    for (int i4 = 0; i4 < 4; ++i4) {
                        const int d = dt * 32 + 8 * i4 + 4 * hh;
                        const u32x2 oc = *(const u32x2*)(OCMP + row * 1024 + (h0 + hd) * 64 + d);
                        u32x2 ov = {pk2(res[hd][dt][i4 * 4 + 0] + bflo(oc.x), res[hd][dt][i4 * 4 + 1] + bfhi(oc.x)),
                                    pk2(res[hd][dt][i4 * 4 + 2] + bflo(oc.y), res[hd][dt][i4 * 4 + 3] + bfhi(oc.y))};
                        *(u32x2*)(OBUF + row * 1024 + (h0 + hd) * 64 + d) = ov;
                    }
        }
        __syncthreads();
    };

    auto ph_15 = [&](bool dry) __attribute__((always_inline)) { if (!dry) resid_gemm((const u16*)(ws + O_OBUF), 1024, (const u16*)(ws + O_WNSAOUT), 1024, P.out, HB0, SS + 4 * MT, 1.f); else resid_gemm((const u16*)(ws + O_OBUF), 1024, (const u16*)(ws + O_WNSAOUT), 1024, P.out, (u16*)nullptr, (u64*)nullptr, 0.f); };
    auto ph_16 = [&](bool dry) __attribute__((always_inline)) { ffn_up_phase(1, HB0, SS + 4 * MT, SS + 7 * MT, !dry); };
    auto ph_17 = [&](bool dry) __attribute__((always_inline)) { if (!dry) resid_gemm((const u16*)(ws + O_ACT), 2816, (const u16*)(ws + O_WDOWN + SZ_WDOWN), 2816, P.out, HB1, SS + 5 * MT, 1.f); else resid_gemm((const u16*)(ws + O_ACT), 2816, (const u16*)(ws + O_WDOWN + SZ_WDOWN), 2816, P.out, (u16*)nullptr, (u64*)nullptr, 0.f); };
    auto ph_18 = [&](bool dry) __attribute__((always_inline)) { gate_phase(1, HB1, SS + 5 * MT, SS + 7 * MT, (u16*)nullptr, (u64*)nullptr, dry ? 0.f : 1.f); };
#define RUNA(k) do { if (PH(k)) ph_##k(); GSYNC(); if ((DUPMASK >> (k)) & 1) { ph_##k(); GSYNC(); } } while (0)
#define RUNB(k) do { if (PH(k)) ph_##k(false); GSYNC(); if ((DUPMASK >> (k)) & 1) { ph_##k(true); GSYNC(); } } while (0)
    RUNA(0); RUNA(1); RUNA(2); RUNA(3); RUNA(4); RUNA(5);
    RUNB(6); RUNB(7); RUNB(8); RUNB(9);
    RUNA(10); RUNA(11); RUNA(12); RUNA(13); RUNA(14);
    RUNB(15); RUNB(16); RUNB(17);
    if (PH(18)) ph_18(false);
    if ((DUPMASK >> 18) & 1) { GSYNC(); ph_18(true); }
}

extern "C" void kernel_launch(void* const* d_in, const int* in_sizes, int n_in, void* d_out, int out_size, void* d_ws, size_t ws_size, hipStream_t stream) {
    static int grid_blocks = 0;
    if (grid_blocks == 0) {
        if (n_in != 32 || out_size != MT * DM || ws_size < WS_NEED) {
            fprintf(stderr, "kernel_launch: unexpected problem (n_in %d, out %d, ws %zu)\n", n_in, out_size, ws_size);
            grid_blocks = -1;
            return;
        }
        int dev = 0, cus = 0, per_cu = 0;
        (void)hipGetDevice(&dev);
        (void)hipDeviceGetAttribute(&cus, hipDeviceAttributeMultiprocessorCount, dev);
        (void)hipOccupancyMaxActiveBlocksPerMultiprocessor(&per_cu, fwd_megakernel, 256, 0);
        if (per_cu < 1) per_cu = 1;
        if (per_cu > 1) per_cu = 1;
        grid_blocks = cus * per_cu;
    }
    if (grid_blocks < 0) return;
    Params p{};
    const float** pp = (const float**)&p;
    for (int i = 0; i < 32; ++i) pp[i] = (const float*)d_in[i];
    p.out = (float*)d_out;
    p.ws = (char*)d_ws;
    (void)hipMemsetAsync((char*)d_ws + O_BAR, 0, 16384, stream);
    void* args[] = {&p};
    hipError_t e = hipLaunchCooperativeKernel((void*)fwd_megakernel, dim3(grid_blocks), dim3(256), args, 0, stream);
    if (e != hipSuccess) fprintf(stderr, "cooperative launch failed: %s (grid %d)\n", hipGetErrorString(e), grid_blocks);
}
```

```cpp
#include <hip/hip_runtime.h>
#include <hip/hip_cooperative_groups.h>
#include <cstdio>
#include <type_traits>
namespace cg = cooperative_groups;

#define DI __device__ __forceinline__
typedef unsigned short u16;
typedef unsigned long long u64;
typedef __attribute__((ext_vector_type(8))) short bf16x8;
typedef __attribute__((ext_vector_type(16))) float f32x16;
typedef __attribute__((ext_vector_type(4))) unsigned u32x4;
typedef __attribute__((ext_vector_type(2))) unsigned u32x2;
#define MFMA(a, b, c) __builtin_amdgcn_mfma_f32_32x32x16_bf16((a), (b), (c), 0, 0, 0)

#ifndef USE_CG
#define USE_CG 0
#endif
#if USE_CG
#define GSYNC() grid.sync()
#else
#define GSYNC() ctr_barrier((unsigned*)(P.ws + O_BAR) + 4096 - 64, bar_gen)
#endif
#ifndef RESTRICT
#define RESTRICT 0
#endif
#define RB(k, id, n) ((((RESTRICT) >> (k)) & 1) && (n) > 256 ? ((id) < 256 ? (id) : 0x3fffffff) : (id))
#define RS(k, n) ((((RESTRICT) >> (k)) & 1) && (n) > 256 ? 256 : (n))
#ifndef P1REP
#define P1REP 1
#endif
#ifndef DUPMASK
#define DUPMASK 0
#endif
#ifndef XCD_CONSEC
#define XCD_CONSEC 1
#endif
#ifndef MINW
#define MINW 1
#endif
#ifndef ONLY
#define PH(k) true
#else
#define PH(k) ((ONLY) == (k))
#endif
constexpr int MT = 16384, DM = 1024, TS = 4096;
constexpr float EPS = 1e-6f;

constexpr size_t O_WABIN = 0;
constexpr size_t O_WABOUT = O_WABIN + 3200ull * 1024 * 2;
constexpr size_t O_WNSAIN = O_WABOUT + 1024ull * 1024 * 2;
constexpr size_t O_WC1K = O_WNSAIN + 1920ull * 1024 * 2;
constexpr size_t O_WC1V = O_WC1K + 256ull * 2048 * 2;
constexpr size_t O_WC2K = O_WC1V + 256ull * 2048 * 2;
constexpr size_t O_WC2V = O_WC2K + 128ull * 256 * 2;
constexpr size_t O_WNSAOUT = O_WC2V + 128ull * 256 * 2;
constexpr size_t O_WUP = O_WNSAOUT + 1024ull * 1024 * 2;
constexpr size_t SZ_WUP = 5632ull * 1024 * 2;
constexpr size_t O_WDOWN = O_WUP + 2 * SZ_WUP;
constexpr size_t SZ_WDOWN = 1024ull * 2816 * 2;
constexpr size_t O_WPLE = O_WDOWN + 2 * SZ_WDOWN;
constexpr size_t SZ_WPLE = 1024ull * 256 * 2;
constexpr size_t O_WGATE = O_WPLE + 2 * SZ_WPLE;
constexpr size_t SZ_WGATE = 1024ull * 1024 * 2;
constexpr size_t O_ROPEC = O_WGATE + 2 * SZ_WGATE;
constexpr size_t O_ROPES = O_ROPEC + 4096ull * 32 * 4;
constexpr size_t O_BIAS1 = O_ROPES + 4096ull * 32 * 4;
constexpr size_t O_BAR = O_BIAS1 + 4096;
constexpr size_t O_SS = O_BAR + 16384;
constexpr size_t O_HB0 = O_SS + 8ull * MT * 8;
constexpr size_t O_HB1 = O_HB0 + (size_t)MT * DM * 2;
constexpr size_t O_BIG = O_HB1 + (size_t)MT * DM * 2;
constexpr size_t O_VT0 = O_BIG;
constexpr size_t O_KT = O_VT0 + 4ull * 1024 * 4096 * 2;
constexpr size_t O_QM = O_KT + 4ull * 256 * 4096 * 2;
constexpr size_t O_KM = O_QM + (size_t)MT * 256 * 2;
constexpr size_t O_KWT = O_KM + (size_t)MT * 256 * 2;
constexpr size_t O_GS = O_KWT + 4ull * 256 * 4096 * 2;
constexpr size_t O_BL = O_GS + 16ull * 4096 * 4;
constexpr size_t O_PM = O_BL + 16ull * 4096 * 4;
constexpr size_t O_BLAST = O_PM + 16ull * 4096 * 4;
constexpr size_t O_GC = O_BLAST + 4096;
constexpr size_t O_MS = O_GC + 4096;
constexpr size_t O_NC = O_MS + 4096;
constexpr size_t O_NS = O_NC + 1024ull * 64 * 4;
constexpr size_t O_GF = O_NS + 1024ull * 64 * 4;
constexpr size_t O_KVT = O_GF + (size_t)MT * 8 * 4;
constexpr size_t O_RT = O_KVT + 512ull * 8192 * 4;
constexpr size_t O_UT = O_RT + 512ull * 8192 * 2;
constexpr size_t O_L0END = O_UT + 1024ull * 8192 * 4;
constexpr size_t O_CT = O_HB1;
constexpr size_t O_ACT = O_BIG;
constexpr size_t O_ERAW = O_ACT + (size_t)MT * 2816 * 2;
constexpr size_t O_FFNEND = O_ERAW + (size_t)MT * DM * 2;
constexpr size_t O_QN = O_BIG;
constexpr size_t O_KCVC = O_QN + (size_t)MT * DM * 2;
constexpr size_t O_KSN = O_KCVC + (size_t)MT * 256 * 2;
constexpr size_t O_KWN = O_KSN + (size_t)MT * 128 * 2;
constexpr size_t O_VST = O_KWN + (size_t)MT * 128 * 2;
constexpr size_t O_VWT = O_VST + (size_t)MT * 128 * 2;
constexpr size_t O_GT1 = O_VWT + (size_t)MT * 128 * 2;
constexpr size_t O_HID = O_GT1 + (size_t)MT * 48 * 4;
constexpr size_t O_KCN = O_HID + 2ull * 2048 * 256 * 2;
constexpr size_t O_VCT = O_KCN + 8ull * 256 * 64 * 2;
constexpr size_t O_SEL = O_VCT + 8ull * 64 * 256 * 2;
constexpr size_t O_OBUF = O_SEL + 8ull * 4096 * 8;
constexpr size_t O_L1END = O_OBUF + (size_t)MT * DM * 2;
constexpr size_t O_OCMP = O_HB1;
constexpr size_t WS_NEED = 256ull << 20;
static_assert(O_L0END <= WS_NEED && O_FFNEND <= WS_NEED && O_L1END <= WS_NEED, "workspace overflow");

struct Params {
    const float *x, *p, *ab_norm_g, *ab_w_in, *ab_conv_w, *ab_conv_b, *ab_ret_norm_g, *ab_ig_b, *ab_fg_b, *ab_m_norm_g, *ab_w_out;
    const float *nsa_norm_g, *nsa_w_in, *nsa_q_norm_g, *nsa_k_norm_g, *nsa_cmp_pos_k, *nsa_cmp_pos_v, *w1k, *w2k, *w1v, *w2v, *nsa_gate_b, *nsa_w_out;
    const float *ffn_norm_g, *ffn_w_up, *ffn_conv_w, *ffn_conv_b, *ffn_w_down, *ple_w, *ple_norm_g, *ple_gate_norm_g, *ple_w_gate;
    float* out;
    char* ws;
};

DI float bf2f(u16 b) { return __uint_as_float(((unsigned)b) << 16); }
typedef float f32x2_t __attribute__((ext_vector_type(2)));
typedef __bf16 bf16x2_t __attribute__((ext_vector_type(2)));
DI unsigned pk2(float a, float b) { f32x2_t v = {a, b}; bf16x2_t o = __builtin_convertvector(v, bf16x2_t); return __builtin_bit_cast(unsigned, o); }
DI u16 f2bf(float x) { return (u16)(pk2(x, 0.f) & 0xffffu); }
DI float bflo(unsigned u) { return __uint_as_float(u << 16); }
DI float bfhi(unsigned u) { return __uint_as_float(u & 0xffff0000u); }
DI int crow(int i, int h) { return (i & 3) + 8 * (i >> 2) + 4 * h; }
DI float sigmoidf_(float x) { return 1.f / (1.f + __expf(-x)); }
DI float gelu_tanh(float x) { float y = 0.7978845608028654f * (x + 0.044715f * x * x * x); float t = 1.f - 2.f / (__expf(2.f * y) + 1.f); return 0.5f * x * (1.f + t); }
DI float red32(float v) { v += __shfl_xor(v, 1); v += __shfl_xor(v, 2); v += __shfl_xor(v, 4); v += __shfl_xor(v, 8); v += __shfl_xor(v, 16); return v; }
DI bf16x8 ld16(const u16* p) { return *(const bf16x8*)p; }
DI bf16x8 ld8x2(const u16* p0, const u16* p1) { u32x2 a = *(const u32x2*)p0, b = *(const u32x2*)p1; u32x4 v = {a.x, a.y, b.x, b.y}; return __builtin_bit_cast(bf16x8, v); }
DI bf16x8 packp(const f32x16& x, int s) {
    u32x4 v = {pk2(x[8 * s + 0], x[8 * s + 1]), pk2(x[8 * s + 2], x[8 * s + 3]), pk2(x[8 * s + 4], x[8 * s + 5]), pk2(x[8 * s + 6], x[8 * s + 7])};
    return __builtin_bit_cast(bf16x8, v);
}
DI f32x16 zero16() { f32x16 z; for (int i = 0; i < 16; ++i) z[i] = 0.f; return z; }
DI u64 ss_fix(float s) { return (u64)(s * 1048576.f + 0.5f); }
DI float ss_rstd(u64 v) { return rsqrtf((float)v * (1.f / (1048576.f * 1024.f)) + EPS); }
DI float gamma_log(int h) { return log1pf(-exp2f(-5.f - (float)h)); }


#define XB_TMO      128
#define XB_XCNT(j)  (256  + 64 * (j))
#define XB_XSUB(j)  (1280 + 64 * (j))
#define XB_XGEN(j)  (2304 + 64 * (j))
#define XB_TOP      3328
#define XB_TOPGEN   3392
#define XCD_BAR_WORDS 3456
#define XB_SPIN_CAP (1u << 22)
#define LAS __attribute__((address_space(3)))
DI unsigned xb_ld(unsigned* p) { return __hip_atomic_load(p, __ATOMIC_RELAXED, __HIP_MEMORY_SCOPE_AGENT); }
DI unsigned xb_add(unsigned* p, unsigned v) { return __hip_atomic_fetch_add(p, v, __ATOMIC_RELAXED, __HIP_MEMORY_SCOPE_AGENT); }
DI unsigned xb_xcc_id() { return (unsigned)__builtin_amdgcn_s_getreg((3 << 11) | 20) & 0xFu; }
#define XB_SPIN(cond, bar) do { unsigned _sp = 0; while (cond) { __builtin_amdgcn_s_sleep(1); \
    if ((++_sp & 255u) == 0u) { if (xb_ld(&(bar)[XB_TMO])) break; if (_sp > XB_SPIN_CAP) { atomicAdd(&(bar)[XB_TMO], 1u); break; } } } } while (0)
struct XcdBarrier { unsigned* bar; unsigned x; volatile LAS unsigned* st; };
DI XcdBarrier xcd_barrier_post(unsigned* bar, volatile LAS unsigned* st) {
    XcdBarrier b; b.bar = bar; b.x = xb_xcc_id(); b.st = st;
    if (threadIdx.x == 0) (void)xb_add(&bar[XB_XCNT(b.x)], 1u);
    return b;
}
DI void xcd_barrier_complete(unsigned* bar, unsigned x, unsigned& nloc, unsigned& nx) {
    const unsigned G = gridDim.x * gridDim.y * gridDim.z;
    unsigned sum, cnt, mine, sp = 0u;
    for (;;) {
        sum = 0u; cnt = 0u; mine = 0u;
#pragma unroll
        for (unsigned j = 0; j < 16; ++j) { const unsigned c = xb_ld(&bar[XB_XCNT(j)]); sum += c; cnt += (c > 0u) ? 1u : 0u; mine = (j == x) ? c : mine; }
        if (sum == G) break;
        __builtin_amdgcn_s_sleep(1);
        if ((++sp & 255u) == 0u) { if (xb_ld(&bar[XB_TMO])) break; if (sp > XB_SPIN_CAP) { atomicAdd(&bar[XB_TMO], 1u); break; } }
    }
    nloc = mine > 0u ? mine : 1u; nx = cnt > 0u ? cnt : 1u;
}
DI void xcd_barrier(const XcdBarrier& b) {
    asm volatile("s_waitcnt vmcnt(0)" ::: "memory");
    __syncthreads();
    if (threadIdx.x == 0) {
        unsigned* bar = b.bar;
        __builtin_amdgcn_s_waitcnt(0);
        unsigned nloc = b.st[0], nx = b.st[1];
        if (nloc == 0u) { xcd_barrier_complete(bar, b.x, nloc, nx); b.st[0] = nloc; b.st[1] = nx; }
        const unsigned old = xb_add(&bar[XB_XSUB(b.x)], 1u);
        const unsigned gen = old / nloc;
        if (old + 1u == (gen + 1u) * nloc) {
            __builtin_amdgcn_fence(__ATOMIC_RELEASE, "agent");
            asm volatile("s_waitcnt vmcnt(0)" ::: "memory");
            const unsigned og = xb_add(&bar[XB_TOP], 1u);
            const unsigned tg = og / nx;
            if (og + 1u == (tg + 1u) * nx) xb_add(&bar[XB_TOPGEN], 1u);
            else XB_SPIN(xb_ld(&bar[XB_TOPGEN]) == tg, bar);
            __builtin_amdgcn_fence(__ATOMIC_ACQUIRE, "agent");
            xb_add(&bar[XB_XGEN(b.x)], 1u);
            asm volatile("s_waitcnt vmcnt(0)" ::: "memory");
        } else {
            XB_SPIN(xb_ld(&bar[XB_XGEN(b.x)]) == gen, bar);
            __builtin_amdgcn_fence(__ATOMIC_ACQUIRE, "agent");
            asm volatile("s_waitcnt vmcnt(0)" ::: "memory");
        }
    }
    __syncthreads();
}

DI void ctr_barrier(unsigned* ctr, unsigned& gen) {
    asm volatile("s_waitcnt vmcnt(0)" ::: "memory");
    __syncthreads();
    gen += 1u;
    if (threadIdx.x == 0) {
        __builtin_amdgcn_fence(__ATOMIC_RELEASE, "agent");
        asm volatile("s_waitcnt vmcnt(0)" ::: "memory");
        (void)__hip_atomic_fetch_add(ctr, 1u, __ATOMIC_RELAXED, __HIP_MEMORY_SCOPE_AGENT);
        const unsigned target = gen * gridDim.x;
        unsigned sp = 0;
        while (__hip_atomic_load(ctr, __ATOMIC_RELAXED, __HIP_MEMORY_SCOPE_AGENT) < target) {
            __builtin_amdgcn_s_sleep(1);
            if (++sp > (1u << 24)) break;
        }
        __builtin_amdgcn_fence(__ATOMIC_ACQUIRE, "agent");
        asm volatile("s_waitcnt vmcnt(0)" ::: "memory");
    }
    __syncthreads();
}

constexpr int LDT = 72;
constexpr int LDS_BYTES = 2 * 2 * 128 * LDT * 2;

template <bool AF32, class RowA>
DI void gemm_main(f32x16 (&acc)[2][2], RowA rowA, const int kmulA, const u16* __restrict__ Bf, int ldb, int n0, int K, u16* As, u16*  ) {
    constexpr int PD = 2;
    constexpr int BUFE = 128 * LDT;
    const int tid = threadIdx.x, lane = tid & 63, wave = tid >> 6;
    const int wm = wave >> 1, wn = wave & 1, r = lane & 31, hh = lane >> 5;
#pragma unroll
    for (int mi = 0; mi < 2; ++mi)
#pragma unroll
        for (int ni = 0; ni < 2; ++ni) acc[mi][ni] = zero16();
    typedef typename std::conditional<AF32, float, u16>::type TA;
    const int row0 = tid >> 3, kc = (tid & 7) * 8;
    const TA* pa[4];
#pragma unroll
    for (int i = 0; i < 4; ++i) pa[i] = (const TA*)rowA(row0 + 32 * i) + kc;
    const int kbn = ldb >> 4;
    const u16* pb = Bf + ((size_t)((n0 + wn * 64) >> 5) * kbn * 64 + lane) * 8;
    u32x4 ra[PD][4];
    bf16x8 rb[PD][8];
    auto loadA = [&](u32x4 (&xa)[4], int k0) __attribute__((always_inline)) {
#pragma unroll
        for (int i = 0; i < 4; ++i) {
            if constexpr (AF32) {
                const float* q = (const float*)pa[i] + k0 * kmulA;
                const float4 v0 = *(const float4*)q, v1 = *(const float4*)(q + 4);
                u32x4 t = {pk2(v0.x, v0.y), pk2(v0.z, v0.w), pk2(v1.x, v1.y), pk2(v1.z, v1.w)};
                xa[i] = t;
            } else {
                xa[i] = *(const u32x4*)((const u16*)pa[i] + k0 * kmulA);
            }
        }
    };
    auto loadB = [&](bf16x8 (&xb)[8], int k0) __attribute__((always_inline)) {
#pragma unroll
        for (int ni = 0; ni < 2; ++ni)
#pragma unroll
            for (int ks = 0; ks < 4; ++ks) xb[ni * 4 + ks] = *(const bf16x8*)(pb + ((size_t)ni * kbn + (k0 >> 4) + ks) * 512);
    };
    auto stores = [&](const u32x4 (&xa)[4], int p) __attribute__((always_inline)) {
        u16* sa = As + p * BUFE + row0 * LDT + kc;
#pragma unroll
        for (int i = 0; i < 4; ++i) *(u32x4*)(sa + 32 * i * LDT) = xa[i];
    };
    const int nk = K >> 6;
#pragma unroll
    for (int d = 0; d < PD; ++d) { loadA(ra[d], d * 64); loadB(rb[d], d * 64); }
    __syncthreads();
    stores(ra[0], 0);
    if (PD < nk) loadA(ra[0], PD * 64);
    __syncthreads();
    const u16* fa = As + (wm * 64 + r) * LDT + hh * 8;
    for (int kb = 0; kb < nk; kb += PD) {
#pragma unroll
        for (int u = 0; u < PD; ++u) {
            const int k = kb + u, p = u & 1;
#pragma unroll
            for (int ks = 0; ks < 4; ++ks) {
                bf16x8 a[2];
#pragma unroll
                for (int mi = 0; mi < 2; ++mi) a[mi] = *(const bf16x8*)(fa + p * BUFE + mi * 32 * LDT + ks * 16);
#pragma unroll
                for (int mi = 0; mi < 2; ++mi)
#pragma unroll
                    for (int ni = 0; ni < 2; ++ni) acc[mi][ni] = MFMA(a[mi], rb[u][ni * 4 + ks], acc[mi][ni]);
            }
            if (k + PD < nk) loadB(rb[u], (k + PD) * 64);
            if (k + 1 < nk) {
                stores(ra[(u + 1) % PD], p ^ 1);
                if (k + 1 + PD < nk) loadA(ra[(u + 1) % PD], (k + 1 + PD) * 64);
            }
            __syncthreads();
        }
    }
}

DI bool tile_decode(int v, int MTl, int NTl, int& mt, int& nt) {
    mt = v / NTl; nt = v - mt * NTl;
    return v < MTl * NTl;
}
DI int tile_bound(int MTl, int NTl) { return MTl * NTl; }

template <class RowMap>
DI void tconv(const float* __restrict__ W, int K, int N, int Npad, const float* __restrict__ g, u16* __restrict__ out, RowMap rm, int gtid, int gsz) {
    const int total = (K / 32) * Npad, kb_per_n = K >> 4;
    for (int u = gtid; u < total; u += gsz) {
        const int n = u % Npad, k32 = u / Npad;
        float v[32];
        if (n < N) {
            const float* wp = W + (size_t)(k32 * 32) * N + n;
#pragma unroll
            for (int j = 0; j < 32; ++j) v[j] = wp[(size_t)j * N];
            if (g) {
#pragma unroll
                for (int j = 0; j < 32; ++j) v[j] *= g[k32 * 32 + j];
            }
        } else {
#pragma unroll
            for (int j = 0; j < 32; ++j) v[j] = 0.f;
        }
        const int np = rm(n), nb = np >> 5, rr = np & 31;
#pragma unroll
        for (int q = 0; q < 4; ++q) {
            u32x4 o = {pk2(v[8 * q + 0], v[8 * q + 1]), pk2(v[8 * q + 2], v[8 * q + 3]), pk2(v[8 * q + 4], v[8 * q + 5]), pk2(v[8 * q + 6], v[8 * q + 7])};
            const size_t blkid = (size_t)nb * kb_per_n + k32 * 2 + (q >> 1);
            *(u32x4*)(out + (blkid * 64 + (q & 1) * 32 + rr) * 8) = o;
        }
    }
}
DI void zfill16(u16* p, size_t n_elems, int gtid, int gsz) {
    u32x4 z = {0u, 0u, 0u, 0u};
    for (size_t u = gtid; u < n_elems / 8; u += gsz) *(u32x4*)(p + u * 8) = z;
}

__global__ void __launch_bounds__(256, MINW) fwd_megakernel(Params P) {
    cg::grid_group grid = cg::this_grid();
    __shared__ __attribute__((aligned(16))) char smem[LDS_BYTES];
    __shared__ uint4 xb_words;
    if (threadIdx.x == 0) xb_words = make_uint4(0u, 0u, 0u, 0u);
    __syncthreads();
    unsigned bar_gen = 0u;
    const XcdBarrier xbar = xcd_barrier_post((unsigned*)(P.ws + O_BAR), (volatile LAS unsigned*)&xb_words);
    u16* As = (u16*)smem;
    u16* Bs = As + 128 * LDT;
    const int tid = threadIdx.x, lane = tid & 63, wave = tid >> 6;
    const int wm = wave >> 1, wn = wave & 1, r = lane & 31, hh = lane >> 5;
    const int nblk = gridDim.x, blk = blockIdx.x;
    const int gtid = blk * 256 + tid, gsz = nblk * 256;
    const int gw = blk * 4 + wave, ngw = nblk * 4;
    char* ws = P.ws;
    u64* SS = (u64*)(ws + O_SS);
    u16* HB0 = (u16*)(ws + O_HB0);
    u16* HB1 = (u16*)(ws + O_HB1);
    const float* ROPEC = (const float*)(ws + O_ROPEC);
    const float* ROPES = (const float*)(ws + O_ROPES);

    auto ph_0 = [&]() __attribute__((always_inline)) {
        auto idm = [](int n) { return n; };
        auto upm = [](int n) { return n < 2816 ? (n >> 6) * 128 + (n & 63) : ((n - 2816) >> 6) * 128 + 64 + ((n - 2816) & 63); };
        tconv(P.ab_w_in, 1024, 3080, 3200, P.ab_norm_g, (u16*)(ws + O_WABIN), idm, gtid, gsz);
        tconv(P.ab_w_out, 1024, 1024, 1024, (const float*)nullptr, (u16*)(ws + O_WABOUT), idm, gtid, gsz);
        tconv(P.nsa_w_in, 1024, 1840, 1920, P.nsa_norm_g, (u16*)(ws + O_WNSAIN), idm, gtid, gsz);
        tconv(P.w1k, 2048, 256, 256, (const float*)nullptr, (u16*)(ws + O_WC1K), idm, gtid, gsz);
        tconv(P.w1v, 2048, 256, 256, (const float*)nullptr, (u16*)(ws + O_WC1V), idm, gtid, gsz);
        tconv(P.w2k, 256, 64, 128, (const float*)nullptr, (u16*)(ws + O_WC2K), idm, gtid, gsz);
        tconv(P.w2v, 256, 64, 128, (const float*)nullptr, (u16*)(ws + O_WC2V), idm, gtid, gsz);
        tconv(P.nsa_w_out, 1024, 1024, 1024, (const float*)nullptr, (u16*)(ws + O_WNSAOUT), idm, gtid, gsz);
        for (int i = 0; i < 2; ++i) {
            tconv(P.ffn_w_up + (size_t)i * 1024 * 5632, 1024, 5632, 5632, P.ffn_norm_g + i * 1024, (u16*)(ws + O_WUP + i * SZ_WUP), upm, gtid, gsz);
            tconv(P.ffn_w_down + (size_t)i * 2816 * 1024, 2816, 1024, 1024, (const float*)nullptr, (u16*)(ws + O_WDOWN + i * SZ_WDOWN), idm, gtid, gsz);
            tconv(P.ple_w + (size_t)i * 256 * 1024, 256, 1024, 1024, (const float*)nullptr, (u16*)(ws + O_WPLE + i * SZ_WPLE), idm, gtid, gsz);
            tconv(P.ple_w_gate + (size_t)i * 1024 * 1024, 1024, 1024, 1024, P.ple_gate_norm_g + i * 1024, (u16*)(ws + O_WGATE + i * SZ_WGATE), idm, gtid, gsz);
        }
        {
            float* rc = (float*)(ws + O_ROPEC);
            float* rs = (float*)(ws + O_ROPES);
            for (int u = gtid; u < 4096 * 32; u += gsz) {
                const int pos = u >> 5, d = u & 31;
                const float inv = powf(10000.f, -(float)d / 32.f);
                const float ang = (float)pos * inv;
                const double a = (double)ang;
                const double n = rint(a * 0.15915494309189535);
                const float rr = (float)(a - n * 6.283185307179586);
                rc[u] = cosf(rr);
                rs[u] = sinf(rr);
            }
        }
        for (int u = gw; u < 512; u += ngw) {
            const int kv = u >> 8, j = u & 255;
            const float* pos = kv ? P.nsa_cmp_pos_v : P.nsa_cmp_pos_k;
            const float* W1 = kv ? P.w1v : P.w1k;
            float s = 0.f;
            for (int k = lane; k < 2048; k += 64) s += pos[k] * W1[(size_t)k * 256 + j];
            s = red32(s); s += __shfl_xor(s, 32);
            if (lane == 0) ((float*)(ws + O_BIAS1))[u] = s;
        }
        for (int u = gtid; u < 7 * MT; u += gsz) SS[MT + u] = 0ull;
        for (int row = gw; row < MT; row += ngw) {
            const float4* xr = (const float4*)(P.x + (size_t)row * DM);
            float s = 0.f;
#pragma unroll
            for (int j = 0; j < 4; ++j) {
                const float4 v = xr[lane + 64 * j];
                s += v.x * v.x + v.y * v.y + v.z * v.z + v.w * v.w;
                u32x2 o = {pk2(v.x, v.y), pk2(v.z, v.w)};
                *(u32x2*)(HB0 + (size_t)row * DM + (lane + 64 * j) * 4) = o;
            }
            s = red32(s); s += __shfl_xor(s, 32);
            if (lane == 0) SS[row] = ss_fix(s);
        }
    };

    auto ph_1 = [&]() __attribute__((always_inline)) {
        u16* Z0 = (u16*)P.out;
        u16* VT0 = (u16*)(ws + O_VT0);
        u16* KT = (u16*)(ws + O_KT);
        float* GF = (float*)(ws + O_GF);
        const u16* Wt = (const u16*)(ws + O_WABIN);
        for (int tile = blk; tile < tile_bound(128, 25); tile += nblk) {
            int mt, nt; if (!tile_decode(tile, 128, 25, mt, nt)) continue;
            const int m0 = mt * 128, n0 = nt * 128;
            f32x16 acc[2][2];
            const u16* Ab = HB0 + (size_t)m0 * DM;
            gemm_main<false>(acc, [&](int row) { return Ab + (size_t)row * DM; }, 1, Wt, 1024, n0, 1024, As, Bs);
            const int colw = n0 + wn * 64;
            float rsv[2][16], cv[2][16], sv[2][16];
#pragma unroll
            for (int mi = 0; mi < 2; ++mi)
#pragma unroll
                for (int i = 0; i < 16; ++i) {
                    const int row = m0 + wm * 64 + mi * 32 + crow(i, hh);
                    rsv[mi][i] = ss_rstd(SS[row]);
                    cv[mi][i] = (nt < 4) ? ROPEC[(row & 4095) * 32 + r] : 0.f;
                    sv[mi][i] = (nt < 4) ? ROPES[(row & 4095) * 32 + r] : 0.f;
                }
#pragma unroll
            for (int mi = 0; mi < 2; ++mi) {
#pragma unroll
                for (int i4 = 0; i4 < 4; ++i4) {
                    float v0[4], v1[4];
                    const int rowb = m0 + wm * 64 + mi * 32 + 8 * i4 + 4 * hh;
#pragma unroll
                    for (int j = 0; j < 4; ++j) {
                        const float rs = rsv[mi][i4 * 4 + j];
                        v0[j] = acc[mi][0][i4 * 4 + j] * rs;
                        v1[j] = acc[mi][1][i4 * 4 + j] * rs;
                    }
                    const int bb = rowb >> 12, t = rowb & 4095;
                    if (nt < 4) {
                        const int head = (colw & 255) >> 6;
                        const float lg = gamma_log(head);
#pragma unroll
                        for (int j = 0; j < 4; ++j) {
                            const float c = cv[mi][i4 * 4 + j], s = sv[mi][i4 * 4 + j];
                            float y0 = v0[j] * c - v1[j] * s, y1 = v0[j] * s + v1[j] * c;
                            if (nt >= 2) { const float sc = 0.125f * __expf(-(float)(((t + j) & 127) + 1) * lg); y0 *= sc; y1 *= sc; }
                            v0[j] = y0; v1[j] = y1;
                            Z0[(size_t)(rowb + j) * 2048 + colw + r] = f2bf(y0);
                            Z0[(size_t)(rowb + j) * 2048 + colw + 32 + r] = f2bf(y1);
                        }
                        if (nt >= 2) {
                            const int kc = colw - 256;
                            u32x2 o0 = {pk2(v0[0], v0[1]), pk2(v0[2], v0[3])}, o1 = {pk2(v1[0], v1[1]), pk2(v1[2], v1[3])};
                            *(u32x2*)(KT + ((size_t)(bb * 256 + kc + r)) * 4096 + t) = o0;
                            *(u32x2*)(KT + ((size_t)(bb * 256 + kc + 32 + r)) * 4096 + t) = o1;
                        }
                    } else if ((nt >= 4 && nt < 8) || (nt >= 16 && nt < 20)) {
                        const int vc = (nt < 8) ? (colw - 512) : (512 + colw - 2048);
                        u32x2 o0 = {pk2(v0[0], v0[1]), pk2(v0[2], v0[3])}, o1 = {pk2(v1[0], v1[1]), pk2(v1[2], v1[3])};
                        *(u32x2*)(VT0 + ((size_t)(bb * 1024 + vc + r)) * 4096 + t) = o0;
                        *(u32x2*)(VT0 + ((size_t)(bb * 1024 + vc + 32 + r)) * 4096 + t) = o1;
                    } else if (nt < 24) {
                        const int zc = (nt < 12) ? (512 + colw - 1024) : (nt < 16) ? (1024 + colw - 1536) : (1536 + colw - 2560);
#pragma unroll
                        for (int j = 0; j < 4; ++j) {
                            Z0[(size_t)(rowb + j) * 2048 + zc + r] = f2bf(v0[j]);
                            Z0[(size_t)(rowb + j) * 2048 + zc + 32 + r] = f2bf(v1[j]);
                        }
                    } else {
                        if (wn == 0 && r < 8) {
#pragma unroll
                            for (int j = 0; j < 4; ++j) GF[(size_t)(rowb + j) * 8 + r] = v0[j];
                        }
                    }
                }
            }
        }
    };

    auto ph_2 = [&]() __attribute__((always_inline)) {
        const u16* Z0 = (const u16*)P.out;
        const float* GF = (const float*)(ws + O_GF);
        float* GS = (float*)(ws + O_GS); float* BL = (float*)(ws + O_BL); float* PM = (float*)(ws + O_PM);
        float* BLAST = (float*)(ws + O_BLAST); float* GC = (float*)(ws + O_GC); float* NC = (float*)(ws + O_NC);
        u16* QM = (u16*)(ws + O_QM); u16* KM = (u16*)(ws + O_KM); u16* KWT = (u16*)(ws + O_KWT);
        for (int u = gw; u < 1024; u += ngw) {
            const int bh = u >> 6, c = u & 63, b = bh >> 2, h = bh & 3, t0 = c * 64;
            const size_t rowb = (size_t)b * 4096;
            const size_t row = rowb + t0 + lane;
            const float f = GF[row * 8 + 4 + h] + P.ab_fg_b[h];
            const float fc = fminf(f, 0.f) - log1pf(__expf(-fabsf(f)));
            const float ic = GF[row * 8 + h] + P.ab_ig_b[h];
            float bcs = fc;
#pragma unroll
            for (int off = 1; off < 64; off <<= 1) { const float o = __shfl_up(bcs, off); if (lane >= off) bcs += o; }
            const float g = ic - bcs;
            float pm = g;
#pragma unroll
            for (int off = 1; off < 64; off <<= 1) { const float o = __shfl_up(pm, off); if (lane >= off) pm = fmaxf(pm, o); }
            const float G = __shfl(pm, 63), bl = __shfl(bcs, 63);
            const float w = __expf(g - G);
            GS[bh * 4096 + t0 + lane] = g; BL[bh * 4096 + t0 + lane] = bcs; PM[bh * 4096 + t0 + lane] = pm;
            if (lane == 0) { BLAST[bh * 64 + c] = bl; GC[bh * 64 + c] = G; }
            {
                const int ch = 256 + h * 64 + lane;
                const float w0 = P.ab_conv_w[ch], w1 = P.ab_conv_w[512 + ch], w2 = P.ab_conv_w[1024 + ch], w3 = P.ab_conv_w[1536 + ch], cb = P.ab_conv_b[ch];
                const u16* zp = Z0 + 1024 + ch;
                float x0 = 0.f, x1 = 0.f, x2 = 0.f;
                if (t0 > 0) { x0 = bf2f(zp[(rowb + t0 - 3) * 2048]); x1 = bf2f(zp[(rowb + t0 - 2) * 2048]); x2 = bf2f(zp[(rowb + t0 - 1) * 2048]); }
                float nsum = 0.f;
                float xr[64];
#pragma unroll
                for (int s = 0; s < 64; ++s) xr[s] = bf2f(zp[(rowb + t0 + s) * 2048]);
#pragma unroll
                for (int s8 = 0; s8 < 8; ++s8) {
                    float vw[8];
#pragma unroll
                    for (int j = 0; j < 8; ++j) {
                        const int s = s8 * 8 + j;
                        const float x3 = xr[s];
                        float v = cb + w0 * x0 + w1 * x1 + w2 * x2 + w3 * x3;
                        v = v / (1.f + __expf(-v));
                        x0 = x1; x1 = x2; x2 = x3;
                        KM[(rowb + t0 + s) * 256 + h * 64 + lane] = f2bf(v);
                        const float wsv = __shfl(w, s);
                        vw[j] = v * wsv; nsum += vw[j];
                    }
                    u32x4 o = {pk2(vw[0], vw[1]), pk2(vw[2], vw[3]), pk2(vw[4], vw[5]), pk2(vw[6], vw[7])};
                    *(u32x4*)(KWT + ((size_t)(b * 256 + h * 64 + lane)) * 4096 + t0 + s8 * 8) = o;
                }
                NC[(size_t)u * 64 + lane] = nsum;
            }
            {
                const int ch = h * 64 + lane;
                const float w0 = P.ab_conv_w[ch], w1 = P.ab_conv_w[512 + ch], w2 = P.ab_conv_w[1024 + ch], w3 = P.ab_conv_w[1536 + ch], cb = P.ab_conv_b[ch];
                const u16* zp = Z0 + 1024 + ch;
                float x0 = 0.f, x1 = 0.f, x2 = 0.f;
                if (t0 > 0) { x0 = bf2f(zp[(rowb + t0 - 3) * 2048]); x1 = bf2f(zp[(rowb + t0 - 2) * 2048]); x2 = bf2f(zp[(rowb + t0 - 1) * 2048]); }
                float xr[64];
#pragma unroll
                for (int s = 0; s < 64; ++s) xr[s] = bf2f(zp[(rowb + t0 + s) * 2048]);
#pragma unroll
                for (int s = 0; s < 64; ++s) {
                    const float x3 = xr[s];
                    float v = cb + w0 * x0 + w1 * x1 + w2 * x2 + w3 * x3;
                    v = v / (1.f + __expf(-v));
                    x0 = x1; x1 = x2; x2 = x3;
                    QM[(rowb + t0 + s) * 256 + h * 64 + lane] = f2bf(v * 0.125f);
                }
            }
        }
    };

    auto ph_3 = [&]() __attribute__((always_inline)) {
        const u16* VT0 = (const u16*)(ws + O_VT0);
        const u16* KT = (const u16*)(ws + O_KT);
        const u16* KWT = (const u16*)(ws + O_KWT);
        float* KVT = (float*)(ws + O_KVT);
        float* UT = (float*)(ws + O_UT);
        for (int u = gw; u < 2048 + 4096; u += ngw) {
            f32x16 a0 = zero16(), a1 = zero16();
            if (u < 2048) {
                const int dt = u & 3, c = (u >> 2) & 31, bh = u >> 7, b = bh >> 2, h = bh & 3, t0 = c * 128;
                const u16* va = VT0 + ((size_t)(b * 1024 + h * 128 + dt * 32 + r)) * 4096 + t0 + 8 * hh;
                const u16* kb = KT + ((size_t)(b * 256 + h * 64 + r)) * 4096 + t0 + 8 * hh;
#pragma unroll
                for (int st = 0; st < 8; ++st) {
                    const bf16x8 a = ld16(va + 16 * st);
                    a0 = MFMA(a, ld16(kb + 16 * st), a0);
                    a1 = MFMA(a, ld16(kb + 32 * 4096 + 16 * st), a1);
                }
                const float cdec = __expf(128.f * gamma_log(h));
                float* o = KVT + (size_t)(bh * 32 + c) * 8192;
#pragma unroll
                for (int i = 0; i < 16; ++i) {
                    o[(dt * 32 + crow(i, hh)) * 64 + r] = cdec * a0[i];
                    o[(dt * 32 + crow(i, hh)) * 64 + 32 + r] = cdec * a1[i];
                }
            } else {
                const int v = u - 2048;
                const int dt = v & 3, c = (v >> 2) & 63, bh = v >> 8, b = bh >> 2, h = bh & 3, t0 = c * 64;
                const u16* va = VT0 + ((size_t)(b * 1024 + 512 + h * 128 + dt * 32 + r)) * 4096 + t0 + 8 * hh;
                const u16* kb = KWT + ((size_t)(b * 256 + h * 64 + r)) * 4096 + t0 + 8 * hh;
#pragma unroll
                for (int st = 0; st < 4; ++st) {
                    const bf16x8 a = ld16(va + 16 * st);
                    a0 = MFMA(a, ld16(kb + 16 * st), a0);
                    a1 = MFMA(a, ld16(kb + 32 * 4096 + 16 * st), a1);
                }
                float* o = UT + (size_t)(bh * 64 + c) * 8192;
#pragma unroll
                for (int i = 0; i < 16; ++i) {
                    o[(dt * 32 + crow(i, hh)) * 64 + r] = a0[i];
                    o[(dt * 32 + crow(i, hh)) * 64 + 32 + r] = a1[i];
                }
            }
        }
    };

    auto ph_4 = [&]() __attribute__((always_inline)) {
        const float* KVT = (const float*)(ws + O_KVT);
        const float* UT = (const float*)(ws + O_UT);
        const float* NC = (const float*)(ws + O_NC);
        const float* BLAST = (const float*)(ws + O_BLAST);
        const float* GC = (const float*)(ws + O_GC);
        u16* RT = (u16*)(ws + O_RT);
        u16* CT = (u16*)(ws + O_CT);
        float* MS = (float*)(ws + O_MS);
        float* NS = (float*)(ws + O_NS);
        for (int e = gtid; e < 131072 * 2 + 1024; e += gsz) {
            if (e < 131072) {
                const int bh = e >> 13, idx = e & 8191;
                const float cdec = __expf(128.f * gamma_log(bh & 3));
                float R = 0.f;
                float kvv[32];
#pragma unroll
                for (int c = 0; c < 32; ++c) kvv[c] = KVT[(size_t)(bh * 32 + c) * 8192 + idx];
#pragma unroll
                for (int c = 0; c < 32; ++c) {
                    RT[(size_t)(bh * 32 + c) * 8192 + idx] = f2bf(R);
                    R = cdec * R + kvv[c];
                }
            } else if (e < 262144) {
                const int e2 = e - 131072, bh = e2 >> 13, idx = e2 & 8191;
                float C = 0.f, m = 0.f;
                float utv[64];
#pragma unroll
                for (int c = 0; c < 64; ++c) utv[c] = UT[(size_t)(bh * 64 + c) * 8192 + idx];
#pragma unroll
                for (int c = 0; c < 64; ++c) {
                    const float G = GC[bh * 64 + c];
                    const float M = fmaxf(m, G);
                    const float dC = __expf(m - M), dU = __expf(G - M);
                    CT[(size_t)(bh * 64 + c) * 8192 + idx] = f2bf(C);
                    if (idx == 0) MS[bh * 64 + c] = m;
                    C = dC * C + dU * utv[c];
                    m = BLAST[bh * 64 + c] + M;
                }
            } else {
                const int e2 = e - 262144, bh = e2 >> 6, dk = e2 & 63;
                float n = 0.f, m = 0.f;
                for (int c = 0; c < 64; ++c) {
                    const float G = GC[bh * 64 + c];
                    const float M = fmaxf(m, G);
                    const float dC = __expf(m - M), dU = __expf(G - M);
                    NS[(size_t)(bh * 64 + c) * 64 + dk] = n;
                    n = dC * n + dU * NC[(size_t)(bh * 64 + c) * 64 + dk];
                    m = BLAST[bh * 64 + c] + M;
                }
            }
        }
    };

    auto ph_5 = [&]() __attribute__((always_inline)) {
        const u16* Z0 = (const u16*)P.out;
        const u16* VT0 = (const u16*)(ws + O_VT0);
        const u16* RT = (const u16*)(ws + O_RT);
        const u16* CT = (const u16*)(ws + O_CT);
        const u16* QM = (const u16*)(ws + O_QM);
        const u16* KM = (const u16*)(ws + O_KM);
        const float* GS = (const float*)(ws + O_GS); const float* BL = (const float*)(ws + O_BL); const float* PM = (const float*)(ws + O_PM);
        const float* MS = (const float*)(ws + O_MS); const float* NS = (const float*)(ws + O_NS);
        u16* MIX = HB0;
        for (int u = gw; u < 4096; u += ngw) {
            f32x16 o[4];
            if (u < 2048) {
                const int qt = u & 3, c = (u >> 2) & 31, bh = u >> 7, b = bh >> 2, h = bh & 3, t0 = c * 128, tq = t0 + qt * 32;
                const size_t rowb = (size_t)b * 4096;
                bf16x8 bq[4];
#pragma unroll
                for (int st = 0; st < 4; ++st) bq[st] = ld16(Z0 + (rowb + tq + r) * 2048 + h * 64 + 16 * st + 8 * hh);
                const u16* rt = RT + (size_t)(bh * 32 + c) * 8192;
#pragma unroll
                for (int dt = 0; dt < 4; ++dt) {
                    o[dt] = zero16();
#pragma unroll
                    for (int st = 0; st < 4; ++st) o[dt] = MFMA(ld16(rt + (dt * 32 + r) * 64 + 16 * st + 8 * hh), bq[st], o[dt]);
                }
                for (int kt = 0; kt <= qt; ++kt) {
                    f32x16 s = zero16();
#pragma unroll
                    for (int st = 0; st < 4; ++st) s = MFMA(ld16(Z0 + (rowb + t0 + kt * 32 + r) * 2048 + 256 + h * 64 + 16 * st + 8 * hh), bq[st], s);
                    if (kt == qt) {
#pragma unroll
                        for (int i = 0; i < 16; ++i) if (crow(i, hh) > r) s[i] = 0.f;
                    }
#pragma unroll
                    for (int s2 = 0; s2 < 2; ++s2) {
                        const bf16x8 pb = packp(s, s2);
#pragma unroll
                        for (int dt = 0; dt < 4; ++dt) {
                            const u16* vp = VT0 + ((size_t)(b * 1024 + h * 128 + dt * 32 + r)) * 4096 + t0 + kt * 32 + 16 * s2 + 4 * hh;
                            o[dt] = MFMA(ld8x2(vp, vp + 8), pb, o[dt]);
                        }
                    }
                }
                const float qdec = __expf((float)(qt * 32 + r + 1) * gamma_log(h));
                float ss = 0.f;
#pragma unroll
                for (int dt = 0; dt < 4; ++dt)
#pragma unroll
                    for (int i = 0; i < 16; ++i) { o[dt][i] *= qdec; ss += o[dt][i] * o[dt][i]; }
                ss += __shfl_xor(ss, 32);
                const float rs = rsqrtf(ss * (1.f / 128.f) + EPS);
                const size_t row = rowb + tq + r;
#pragma unroll
                for (int dt = 0; dt < 4; ++dt)
#pragma unroll
                    for (int i4 = 0; i4 < 4; ++i4) {
                        const int dv = dt * 32 + 8 * i4 + 4 * hh;
                        const u32x2 gv = *(const u32x2*)(Z0 + row * 2048 + 512 + h * 128 + dv);
                        const float g0 = bflo(gv.x), g1 = bfhi(gv.x), g2 = bflo(gv.y), g3 = bfhi(gv.y);
                        const float4 ng = *(const float4*)(P.ab_ret_norm_g + h * 128 + dv);
                        const float y0 = o[dt][i4 * 4 + 0] * rs * ng.x * (g0 * sigmoidf_(g0));
                        const float y1 = o[dt][i4 * 4 + 1] * rs * ng.y * (g1 * sigmoidf_(g1));
                        const float y2 = o[dt][i4 * 4 + 2] * rs * ng.z * (g2 * sigmoidf_(g2));
                        const float y3 = o[dt][i4 * 4 + 3] * rs * ng.w * (g3 * sigmoidf_(g3));
                        u32x2 ov = {pk2(y0, y1), pk2(y2, y3)};
                        *(u32x2*)(MIX + row * 1024 + h * 128 + dv) = ov;
                    }
            } else {
                const int v = u - 2048;
                const int qt = v & 1, c = (v >> 1) & 63, bh = v >> 7, b = bh >> 2, h = bh & 3, t0 = c * 64, tq = t0 + qt * 32;
                const size_t rowb = (size_t)b * 4096;
                const size_t row = rowb + tq + r;
                const float mc = MS[bh * 64 + c];
                const float Ml = fmaxf(mc, PM[bh * 4096 + tq + r]);
                const float bl = BL[bh * 4096 + tq + r];
                const float wint = __expf(mc - Ml);
                bf16x8 bq[4];
#pragma unroll
                for (int st = 0; st < 4; ++st) bq[st] = ld16(QM + row * 256 + h * 64 + 16 * st + 8 * hh);
                const u16* ct = CT + (size_t)(bh * 64 + c) * 8192;
#pragma unroll
                for (int dt = 0; dt < 4; ++dt) {
                    o[dt] = zero16();
#pragma unroll
                    for (int st = 0; st < 4; ++st) o[dt] = MFMA(ld16(ct + (dt * 32 + r) * 64 + 16 * st + 8 * hh), bq[st], o[dt]);
#pragma unroll
                    for (int i = 0; i < 16; ++i) o[dt][i] *= wint;
                }
                float qn = 0.f;
                {
                    const u16* qp = QM + row * 256 + h * 64 + 32 * hh;
                    const float* np = NS + (size_t)(bh * 64 + c) * 64 + 32 * hh;
#pragma unroll
                    for (int j = 0; j < 32; ++j) qn += bf2f(qp[j]) * np[j];
                    qn += __shfl_xor(qn, 32);
                }
                float den = 0.f;
                for (int kt = 0; kt <= qt; ++kt) {
                    f32x16 s = zero16();
#pragma unroll
                    for (int st = 0; st < 4; ++st) s = MFMA(ld16(KM + (rowb + t0 + kt * 32 + r) * 256 + h * 64 + 16 * st + 8 * hh), bq[st], s);
#pragma unroll
                    for (int i4 = 0; i4 < 4; ++i4) {
                        const float4 gg = *(const float4*)(GS + bh * 4096 + t0 + kt * 32 + 8 * i4 + 4 * hh);
                        const float ga[4] = {gg.x, gg.y, gg.z, gg.w};
#pragma unroll
                        for (int j = 0; j < 4; ++j) {
                            const int i = i4 * 4 + j;
                            float d = __expf(ga[j] - Ml);
                            if (kt == qt && crow(i, hh) > r) d = 0.f;
                            s[i] *= d; den += s[i];
                        }
                    }
#pragma unroll
                    for (int s2 = 0; s2 < 2; ++s2) {
                        const bf16x8 pb = packp(s, s2);
#pragma unroll
                        for (int dt = 0; dt < 4; ++dt) {
                            const u16* vp = VT0 + ((size_t)(b * 1024 + 512 + h * 128 + dt * 32 + r)) * 4096 + t0 + kt * 32 + 16 * s2 + 4 * hh;
                            o[dt] = MFMA(ld8x2(vp, vp + 8), pb, o[dt]);
                        }
                    }
                }
                den += __shfl_xor(den, 32);
                den += wint * qn;
                const float dinv = 1.f / fmaxf(fabsf(den), __expf(-(bl + Ml)));
                float ss = 0.f;
#pragma unroll
                for (int dt = 0; dt < 4; ++dt)
#pragma unroll
                    for (int i = 0; i < 16; ++i) { o[dt][i] *= dinv; ss += o[dt][i] * o[dt][i]; }
                ss += __shfl_xor(ss, 32);
                const float rs = rsqrtf(ss * (1.f / 128.f) + EPS);
#pragma unroll
                for (int dt = 0; dt < 4; ++dt)
#pragma unroll
                    for (int i4 = 0; i4 < 4; ++i4) {
                        const int dv = dt * 32 + 8 * i4 + 4 * hh;
                        const u32x2 gv = *(const u32x2*)(Z0 + row * 2048 + 1536 + h * 128 + dv);
                        const float4 ng = *(const float4*)(P.ab_m_norm_g + h * 128 + dv);
                        const float y0 = o[dt][i4 * 4 + 0] * rs * ng.x * sigmoidf_(bflo(gv.x));
                        const float y1 = o[dt][i4 * 4 + 1] * rs * ng.y * sigmoidf_(bfhi(gv.x));
                        const float y2 = o[dt][i4 * 4 + 2] * rs * ng.z * sigmoidf_(bflo(gv.y));
                        const float y3 = o[dt][i4 * 4 + 3] * rs * ng.w * sigmoidf_(bfhi(gv.y));
                        u32x2 ov = {pk2(y0, y1), pk2(y2, y3)};
                        *(u32x2*)(MIX + row * 1024 + 512 + h * 128 + dv) = ov;
                    }
            }
        }
    };

    auto resid_gemm = [&](const u16* A, int lda, const u16* Wt, int K, const float* resid, u16* hb_out, u64* ss_out, float scale) __attribute__((always_inline)) {
        for (int tile = blk; tile < tile_bound(128, 8); tile += nblk) {
            int mt, nt; if (!tile_decode(tile, 128, 8, mt, nt)) continue;
            const int m0 = mt * 128, n0 = nt * 128;
            f32x16 acc[2][2];
            const u16* Ab = A + (size_t)m0 * lda;
            gemm_main<false>(acc, [&](int row) { return Ab + (size_t)row * lda; }, 1, Wt, K, n0, K, As, Bs);
            const size_t rbase = (size_t)(m0 + wm * 64 + 4 * hh) * 1024 + n0 + wn * 64 + r;
            float rv[2][2][16];
#pragma unroll
            for (int mi = 0; mi < 2; ++mi)
#pragma unroll
                for (int ni = 0; ni < 2; ++ni)
#pragma unroll
                    for (int i = 0; i < 16; ++i) rv[mi][ni][i] = resid[rbase + (size_t)(mi * 32 + (i & 3) + 8 * (i >> 2)) * 1024 + ni * 32];
            float sqv[2][16];
#pragma unroll
            for (int mi = 0; mi < 2; ++mi)
#pragma unroll
                for (int i = 0; i < 16; ++i) {
                    float sq = 0.f;
#pragma unroll
                    for (int ni = 0; ni < 2; ++ni) {
                        const size_t o = rbase + (size_t)(mi * 32 + (i & 3) + 8 * (i >> 2)) * 1024 + ni * 32;
                        const float hv = rv[mi][ni][i] + scale * acc[mi][ni][i];
                        P.out[o] = hv;
                        if (hb_out) hb_out[o] = f2bf(hv);
                        sq += hv * hv;
                    }
                    sqv[mi][i] = sq;
                }
            if (ss_out) {
#pragma unroll
                for (int mi = 0; mi < 2; ++mi)
#pragma unroll
                    for (int i = 0; i < 16; ++i) {
                        const float s = red32(sqv[mi][i]);
                        if (r == 0) atomicAdd(ss_out + (m0 + wm * 64 + mi * 32 + crow(i, hh)), ss_fix(s));
                    }
            }
        }
    };
    auto ffn_up_phase = [&](int li, const u16* hb, const u64* ss_in, u64* sse, bool do_ss) __attribute__((always_inline)) {
        const u16* Wt = (const u16*)(ws + O_WUP + li * SZ_WUP);
        const u16* Wp = (const u16*)(ws + O_WPLE + li * SZ_WPLE);
        u16* ACT = (u16*)(ws + O_ACT);
        u16* ERAW = (u16*)(ws + O_ERAW);
        const float* cw = P.ffn_conv_w + li * 3 * 2816;
        const float* cb = P.ffn_conv_b + li * 2816;
        const float* pin = P.p + (size_t)li * MT * 256;
        u16* SA = (u16*)smem;
        u16* SB = SA + 128 * 66;
        for (int pass = 0; pass < 2; ++pass)
        for (int tile = blk; tile < (pass ? tile_bound(128, 8) : tile_bound(132, 44)); tile += nblk) {
            f32x16 acc[2][2];
            int mt, nt; if (!tile_decode(tile, pass ? 128 : 132, pass ? 8 : 44, mt, nt)) continue;
            if (pass == 0) {
                const int b = mt / 33, jt = mt % 33, tok0 = jt * 126 - 2, n0 = nt * 128;
                const u16* Ab = hb + (size_t)b * 4096 * DM;
                gemm_main<false>(acc, [&](int row) { int tk = tok0 + row; tk = tk < 0 ? 0 : (tk > 4095 ? 4095 : tk); return Ab + (size_t)tk * DM; }, 1, Wt, 1024, n0, 1024, As, Bs);
                __syncthreads();
#pragma unroll
                for (int mi = 0; mi < 2; ++mi)
#pragma unroll
                    for (int i = 0; i < 16; ++i) {
                        const int rl = wm * 64 + mi * 32 + crow(i, hh);
                        const int tok = tok0 + rl;
                        const int tkc = tok < 0 ? 0 : (tok > 4095 ? 4095 : tok);
                        const float rs = ss_rstd(ss_in[b * 4096 + tkc]);
#pragma unroll
                        for (int ni = 0; ni < 2; ++ni) {
                            float v = acc[mi][ni][i] * rs;
                            if (tok < 0) v = 0.f;
                            (wn == 0 ? SA : SB)[rl * 66 + ni * 32 + r] = f2bf(v);
                        }
                    }
                __syncthreads();
                for (int e = tid; e < 126 * 64; e += 256) {
                    const int rl = 2 + (e >> 6), cl = e & 63, tok = tok0 + rl;
                    if (tok < 4096) {
                        const int f = nt * 64 + cl;
                        const float a = cb[f] + cw[f] * bf2f(SA[(rl - 2) * 66 + cl]) + cw[2816 + f] * bf2f(SA[(rl - 1) * 66 + cl]) + cw[5632 + f] * bf2f(SA[rl * 66 + cl]);
                        ACT[((size_t)b * 4096 + tok) * 2816 + f] = f2bf(gelu_tanh(a) * bf2f(SB[rl * 66 + cl]));
                    }
                }
            } else {
                const int m0 = mt * 128, n0 = nt * 128;
                const float* Ab = pin + (size_t)m0 * 256;
                gemm_main<true>(acc, [&](int row) { return Ab + (size_t)row * 256; }, 1, Wp, 256, n0, 256, As, Bs);
#pragma unroll
                for (int mi = 0; mi < 2; ++mi)
#pragma unroll
                    for (int i = 0; i < 16; ++i) {
                        const size_t row = m0 + wm * 64 + mi * 32 + crow(i, hh);
                        float sq = 0.f;
#pragma unroll
                        for (int ni = 0; ni < 2; ++ni) {
                            const int col = n0 + wn * 64 + ni * 32 + r;
                            const float v = acc[mi][ni][i];
                            ERAW[row * 1024 + col] = f2bf(v);
                            sq += v * v;
                        }
                        sq = red32(sq); if (do_ss && r == 0) atomicAdd(sse + row, ss_fix(sq));
                    }
            }
        }
    };
    auto gate_phase = [&](int li, const u16* hb, const u64* ss_in, const u64* sse, u16* hb_out, u64* ss_out, float scale) __attribute__((always_inline)) {
        const u16* Wt = (const u16*)(ws + O_WGATE + li * SZ_WGATE);
        const u16* ERAW = (const u16*)(ws + O_ERAW);
        const float* eg = P.ple_norm_g + li * 1024;
        for (int tile = blk; tile < tile_bound(128, 8); tile += nblk) {
            int mt, nt; if (!tile_decode(tile, 128, 8, mt, nt)) continue;
            const int m0 = mt * 128, n0 = nt * 128;
            f32x16 acc[2][2];
            const u16* Ab = hb + (size_t)m0 * DM;
            gemm_main<false>(acc, [&](int row) { return Ab + (size_t)row * DM; }, 1, Wt, 1024, n0, 1024, As, Bs);
            const size_t rbase = (size_t)(m0 + wm * 64 + 4 * hh) * 1024 + n0 + wn * 64 + r;
            float ov[2][2][16], ev[2][2][16], rsv[2][16], rev[2][16];
#pragma unroll
            for (int mi = 0; mi < 2; ++mi)
#pragma unroll
                for (int i = 0; i < 16; ++i) {
                    const int row = m0 + wm * 64 + mi * 32 + crow(i, hh);
                    rsv[mi][i] = ss_rstd(ss_in[row]);
                    rev[mi][i] = ss_rstd(sse[row]);
#pragma unroll
                    for (int ni = 0; ni < 2; ++ni) {
                        const size_t o = rbase + (size_t)(mi * 32 + (i & 3) + 8 * (i >> 2)) * 1024 + ni * 32;
                        ov[mi][ni][i] = P.out[o];
                        ev[mi][ni][i] = bf2f(ERAW[o]);
                    }
                }
            const float eg0 = eg[n0 + wn * 64 + r], eg1 = eg[n0 + wn * 64 + 32 + r];
            float sqv[2][16];
#pragma unroll
            for (int mi = 0; mi < 2; ++mi)
#pragma unroll
                for (int i = 0; i < 16; ++i) {
                    float sq = 0.f;
#pragma unroll
                    for (int ni = 0; ni < 2; ++ni) {
                        const size_t o = rbase + (size_t)(mi * 32 + (i & 3) + 8 * (i >> 2)) * 1024 + ni * 32;
                        const float gt = sigmoidf_(acc[mi][ni][i] * rsv[mi][i]);
                        const float e = ev[mi][ni][i] * rev[mi][i] * (ni ? eg1 : eg0);
                        const float hv = ov[mi][ni][i] + scale * gt * e;
                        P.out[o] = hv;
                        if (hb_out) hb_out[o] = f2bf(hv);
                        sq += hv * hv;
                    }
                    sqv[mi][i] = sq;
                }
            if (ss_out) {
#pragma unroll
                for (int mi = 0; mi < 2; ++mi)
#pragma unroll
                    for (int i = 0; i < 16; ++i) {
                        const float s = red32(sqv[mi][i]);
                        if (r == 0) atomicAdd(ss_out + (m0 + wm * 64 + mi * 32 + crow(i, hh)), ss_fix(s));
                    }
            }
        }
    };

    auto ph_6 = [&](bool dry) __attribute__((always_inline)) { if (!dry) resid_gemm(HB0, 1024, (const u16*)(ws + O_WABOUT), 1024, P.x, HB1, SS + 1 * MT, 1.f); else resid_gemm(HB0, 1024, (const u16*)(ws + O_WABOUT), 1024, P.out, (u16*)nullptr, (u64*)nullptr, 0.f); };
    auto ph_7 = [&](bool dry) __attribute__((always_inline)) { ffn_up_phase(0, HB1, SS + 1 * MT, SS + 6 * MT, !dry); };
    auto ph_8 = [&](bool dry) __attribute__((always_inline)) { if (!dry) resid_gemm((const u16*)(ws + O_ACT), 2816, (const u16*)(ws + O_WDOWN), 2816, P.out, HB0, SS + 2 * MT, 1.f); else resid_gemm((const u16*)(ws + O_ACT), 2816, (const u16*)(ws + O_WDOWN), 2816, P.out, (u16*)nullptr, (u64*)nullptr, 0.f); };
    auto ph_9 = [&](bool dry) __attribute__((always_inline)) { if (!dry) gate_phase(0, HB0, SS + 2 * MT, SS + 6 * MT, HB1, SS + 3 * MT, 1.f); else gate_phase(0, HB0, SS + 2 * MT, SS + 6 * MT, (u16*)nullptr, (u64*)nullptr, 0.f); };

    auto ph_10 = [&]() __attribute__((always_inline)) {
        const u16* Wt = (const u16*)(ws + O_WNSAIN);
        u16* QN = (u16*)(ws + O_QN); u16* KCVC = (u16*)(ws + O_KCVC); u16* KSN = (u16*)(ws + O_KSN); u16* KWN = (u16*)(ws + O_KWN);
        u16* VST = (u16*)(ws + O_VST); u16* VWT = (u16*)(ws + O_VWT); float* GT1 = (float*)(ws + O_GT1);
        const u64* ssin = SS + 3 * MT;
        for (int tile = blk; tile < tile_bound(128, 15); tile += nblk) {
            int mt, nt; if (!tile_decode(tile, 128, 15, mt, nt)) continue;
            const int m0 = mt * 128, n0 = nt * 128;
            f32x16 acc[2][2];
            const u16* Ab = HB1 + (size_t)m0 * DM;
            gemm_main<false>(acc, [&](int row) { return Ab + (size_t)row * DM; }, 1, Wt, 1024, n0, 1024, As, Bs);
            const int colw = n0 + wn * 64;
            float rsv[2][16];
#pragma unroll
            for (int mi = 0; mi < 2; ++mi)
#pragma unroll
                for (int i = 0; i < 16; ++i) rsv[mi][i] = ss_rstd(ssin[m0 + wm * 64 + mi * 32 + crow(i, hh)]);
#pragma unroll
            for (int mi = 0; mi < 2; ++mi) {
#pragma unroll
                for (int i4 = 0; i4 < 4; ++i4) {
                    float v0[4], v1[4];
                    const int rowb = m0 + wm * 64 + mi * 32 + 8 * i4 + 4 * hh;
#pragma unroll
                    for (int j = 0; j < 4; ++j) {
                        const float rs = rsv[mi][i4 * 4 + j];
                        v0[j] = acc[mi][0][i4 * 4 + j] * rs;
                        v1[j] = acc[mi][1][i4 * 4 + j] * rs;
                    }
                    const int bb = rowb >> 12, t = rowb & 4095;
                    if (nt < 8 || nt == 10 || nt == 12) {
                        const float* gn = (nt < 8) ? P.nsa_q_norm_g : (nt == 10 ? P.nsa_k_norm_g + 64 : P.nsa_k_norm_g + 128);
                        const float g0 = gn[r], g1 = gn[32 + r];
                        const float sc = (nt < 8) ? 0.125f * 1.4426950408889634f : 1.f;
#pragma unroll
                        for (int j = 0; j < 4; ++j) {
                            const float ss = red32(v0[j] * v0[j] + v1[j] * v1[j]);
                            const float rn = rsqrtf(ss * (1.f / 64.f) + EPS) * sc;
                            const u16 y0 = f2bf(v0[j] * rn * g0), y1 = f2bf(v1[j] * rn * g1);
                            if (nt < 8) { QN[(size_t)(rowb + j) * 1024 + colw + r] = y0; QN[(size_t)(rowb + j) * 1024 + colw + 32 + r] = y1; }
                            else {
                                u16* dst = (nt == 10) ? KSN : KWN;
                                dst[(size_t)(rowb + j) * 128 + wn * 64 + r] = y0; dst[(size_t)(rowb + j) * 128 + wn * 64 + 32 + r] = y1;
                            }
                        }
                    } else if (nt == 8 || nt == 9) {
                        const int cc = (nt - 8) * 128 + wn * 64;
#pragma unroll
                        for (int j = 0; j < 4; ++j) {
                            KCVC[(size_t)(rowb + j) * 256 + cc + r] = f2bf(v0[j]);
                            KCVC[(size_t)(rowb + j) * 256 + cc + 32 + r] = f2bf(v1[j]);
                        }
                    } else if (nt == 11 || nt == 13) {
                        u16* dst = (nt == 11) ? VST : VWT;
                        u32x2 o0 = {pk2(v0[0], v0[1]), pk2(v0[2], v0[3])}, o1 = {pk2(v1[0], v1[1]), pk2(v1[2], v1[3])};
                        *(u32x2*)(dst + ((size_t)(bb * 128 + wn * 64 + r)) * 4096 + t) = o0;
                        *(u32x2*)(dst + ((size_t)(bb * 128 + wn * 64 + 32 + r)) * 4096 + t) = o1;
                    } else {
                        if (wn == 0) {
#pragma unroll
                            for (int j = 0; j < 4; ++j) {
                                GT1[(size_t)(rowb + j) * 48 + r] = sigmoidf_(v0[j] + P.nsa_gate_b[r]);
                                if (r < 16) GT1[(size_t)(rowb + j) * 48 + 32 + r] = sigmoidf_(v1[j] + P.nsa_gate_b[32 + r]);
                            }
                        }
                    }
                }
            }
        }
    };

    auto ph_11 = [&]() __attribute__((always_inline)) {
        const u16* KCVC = (const u16*)(ws + O_KCVC);
        u16* HID = (u16*)(ws + O_HID);
        const float* B1 = (const float*)(ws + O_BIAS1);
        for (int tile = RB(5, blk, nblk); tile < 64; tile += RS(5, nblk)) {
            const int kv = tile >> 5, mt = (tile >> 1) & 15, nt = tile & 1, m0 = mt * 128, n0 = nt * 128;
            const u16* Wt = (const u16*)(ws + (kv ? O_WC1V : O_WC1K));
            f32x16 acc[2][2];
            gemm_main<false>(acc, [&](int row) {
                int R = m0 + row; R = R > 2039 ? 2039 : R;
                const int bg = R / 255, n = R - bg * 255, b = bg >> 1, g = bg & 1;
                return KCVC + ((size_t)b * 4096 + 16 * n) * 256 + kv * 128 + g * 64;
            }, 4, Wt, 2048, n0, 2048, As, Bs);
#pragma unroll
            for (int mi = 0; mi < 2; ++mi)
#pragma unroll
                for (int i = 0; i < 16; ++i) {
                    const int R = m0 + wm * 64 + mi * 32 + crow(i, hh);
#pragma unroll
                    for (int ni = 0; ni < 2; ++ni) {
                        const int col = n0 + wn * 64 + ni * 32 + r;
                        if (R < 2040) HID[((size_t)kv * 2048 + R) * 256 + col] = f2bf(gelu_tanh(acc[mi][ni][i] + B1[kv * 256 + col]));
                    }
                }
        }
    };

    auto ph_12 = [&]() __attribute__((always_inline)) {
        const u16* HID = (const u16*)(ws + O_HID);
        u16* KCN = (u16*)(ws + O_KCN);
        u16* VCT = (u16*)(ws + O_VCT);
        for (int tile = RB(6, blk, nblk); tile < 32; tile += RS(6, nblk)) {
            const int kv = tile >> 4, mt = tile & 15, m0 = mt * 128;
            const u16* Wt = (const u16*)(ws + (kv ? O_WC2V : O_WC2K));
            const u16* Ab = HID + ((size_t)kv * 2048 + m0) * 256;
            f32x16 acc[2][2];
            gemm_main<false>(acc, [&](int row) { return Ab + (size_t)row * 256; }, 1, Wt, 256, 0, 256, As, Bs);
            if (wn == 0) {
#pragma unroll
                for (int mi = 0; mi < 2; ++mi)
#pragma unroll
                    for (int i = 0; i < 16; ++i) {
                        const int R = m0 + wm * 64 + mi * 32 + crow(i, hh);
                        const float v0 = acc[mi][0][i], v1 = acc[mi][1][i];
                        const float ss = red32(v0 * v0 + v1 * v1);
                        if (R < 2040) {
                            const int bg = R / 255, n = R - bg * 255;
                            if (kv == 0) {
                                const float rn = rsqrtf(ss * (1.f / 64.f) + EPS);
                                KCN[((size_t)bg * 256 + n) * 64 + r] = f2bf(v0 * rn * P.nsa_k_norm_g[r]);
                                KCN[((size_t)bg * 256 + n) * 64 + 32 + r] = f2bf(v1 * rn * P.nsa_k_norm_g[32 + r]);
                            } else {
                                VCT[((size_t)bg * 64 + r) * 256 + n] = f2bf(v0);
                                VCT[((size_t)bg * 64 + 32 + r) * 256 + n] = f2bf(v1);
                            }
                        }
                    }
            }
        }
        for (int u = gtid; u < 8 * 64; u += gsz) { KCN[((size_t)(u >> 6) * 256 + 255) * 64 + (u & 63)] = 0; VCT[((size_t)u) * 256 + 255] = 0; }
    };

    auto ph_13 = [&]() __attribute__((always_inline)) {
        const u16* QN = (const u16*)(ws + O_QN);
        const u16* KCN = (const u16*)(ws + O_KCN);
        const u16* VCT = (const u16*)(ws + O_VCT);
        const float* GT1 = (const float*)(ws + O_GT1);
        u16* OCMP = (u16*)(ws + O_OCMP);
        u64* SEL = (u64*)(ws + O_SEL);
        float* sc_lds = (float*)smem + wave * (32 * 65);
        float mbound4;
        {
            float gq = fabsf(P.nsa_q_norm_g[lane]), gk = fabsf(P.nsa_k_norm_g[lane]);
#pragma unroll
            for (int off = 1; off < 64; off <<= 1) { gq = fmaxf(gq, __shfl_xor(gq, off)); gk = fmaxf(gk, __shfl_xor(gk, off)); }
            mbound4 = 8.f * 1.4426950408889634f * gq * gk * 1.02f;
        }
        for (int u0 = blk * 4; u0 < 1024; u0 += nblk * 4) {
            const int u = u0 + wave;
            const int qt = u & 127, bg = u >> 7, b = bg >> 1, g = bg & 1, tq = qt * 32, t = tq + r;
            const size_t row = (size_t)b * 4096 + t;
            const int nkt = (tq >> 9) + 1;
            u16* kl = (u16*)smem;
            u16* vl = kl + 256 * 72;
            __syncthreads();
#pragma unroll
            for (int c8 = 0; c8 < 8; ++c8) {
                const int c = tid + 256 * c8;
                *(u32x4*)(kl + (c >> 3) * 72 + (c & 7) * 8) = *(const u32x4*)(KCN + ((size_t)bg * 256 + (c >> 3)) * 64 + (c & 7) * 8);
                *(u32x4*)(vl + (c >> 5) * 264 + (c & 31) * 8) = *(const u32x4*)(VCT + ((size_t)bg * 64 + (c >> 5)) * 256 + (c & 31) * 8);
            }
            __syncthreads();
            f32x16 imp[2];
            imp[0] = zero16(); imp[1] = zero16();
            for (int hg = 0; hg < 8; ++hg) {
                const int head = g * 8 + hg;
                bf16x8 bq[4];
#pragma unroll
                for (int st = 0; st < 4; ++st) bq[st] = ld16(QN + row * 1024 + head * 64 + 16 * st + 8 * hh);
                f32x16 ao[2], ih[2];
                ao[0] = zero16(); ao[1] = zero16(); ih[0] = zero16(); ih[1] = zero16();
                float l = 0.f;
                for (int kt = 0; kt < nkt; ++kt) {
                    f32x16 s = zero16();
#pragma unroll
                    for (int st = 0; st < 4; ++st) s = MFMA(ld16(kl + (kt * 32 + r) * 72 + 16 * st + 8 * hh), bq[st], s);
#pragma unroll
                    for (int i = 0; i < 16; ++i) {
                        const int n = kt * 32 + crow(i, hh);
                        s[i] = (16 * n + 31 > t) ? 0.f : __builtin_amdgcn_exp2f(s[i] - mbound4);
                        l += s[i];
                    }
#pragma unroll
                    for (int s2 = 0; s2 < 2; ++s2) {
                        const bf16x8 pb = packp(s, s2);
#pragma unroll
                        for (int dt = 0; dt < 2; ++dt) {
                            const u16* vp = vl + (dt * 32 + r) * 264 + kt * 32 + 16 * s2 + 4 * hh;
                            ao[dt] = MFMA(ld8x2(vp, vp + 8), pb, ao[dt]);
                        }
#pragma unroll
                        for (int bt = 0; bt < 2; ++bt) {
                            const int sb = bt * 32 + r;
                            bf16x8 ov;
#pragma unroll
                            for (int j = 0; j < 8; ++j) {
                                const int n = kt * 32 + 16 * s2 + 8 * (j >> 2) + 4 * hh + (j & 3);
                                ov[j] = (n >= 4 * sb - 1 && n <= 4 * sb + 3) ? (short)0x3F80 : (short)0;
                            }
                            ih[bt] = MFMA(ov, pb, ih[bt]);
                        }
                    }
                }
                l += __shfl_xor(l, 32);
                const float inv = (t >= 31) ? 1.f / l : 0.f;
#pragma unroll
                for (int bt = 0; bt < 2; ++bt)
#pragma unroll
                    for (int i = 0; i < 16; ++i) imp[bt][i] += ih[bt][i] * inv;
                const float g0 = GT1[row * 48 + head * 3 + 0] * inv;
#pragma unroll
                for (int dt = 0; dt < 2; ++dt)
#pragma unroll
                    for (int i4 = 0; i4 < 4; ++i4) {
                        const int d = dt * 32 + 8 * i4 + 4 * hh;
                        u32x2 ov = {pk2(ao[dt][i4 * 4 + 0] * g0, ao[dt][i4 * 4 + 1] * g0), pk2(ao[dt][i4 * 4 + 2] * g0, ao[dt][i4 * 4 + 3] * g0)};
                        *(u32x2*)(OCMP + row * 1024 + head * 64 + d) = ov;
                    }
            }
            const int cur = t >> 6;
            __syncthreads();
#pragma unroll
            for (int bt = 0; bt < 2; ++bt)
#pragma unroll
                for (int i = 0; i < 16; ++i) {
                    const int sb = bt * 32 + crow(i, hh);
                    const bool forced = (sb == 0) || (sb == cur) || (sb == cur - 1);
                    const float sc = forced ? 1e30f : (sb <= cur ? imp[bt][i] : -1e30f);
                    sc_lds[r * 65 + sb] = sc;
                }
            __syncthreads();
            for (int q = 0; q < 32; ++q) {
                const float v = sc_lds[q * 65 + lane];
                int cnt = 0;
                for (int sp = 0; sp < 64; ++sp) {
                    const float c = __shfl(v, sp);
                    cnt += ((c > v) || (c == v && sp < lane)) ? 1 : 0;
                }
                const u64 mask = __ballot(cnt < 16);
                if (lane == 0) SEL[(size_t)bg * 4096 + tq + q] = mask;
            }
        }
        __syncthreads();
    };

    auto ph_14 = [&]() __attribute__((always_inline)) {
        const u16* QN = (const u16*)(ws + O_QN);
        const u16* KSN = (const u16*)(ws + O_KSN); const u16* KWN = (const u16*)(ws + O_KWN);
        const u16* VST = (const u16*)(ws + O_VST); const u16* VWT = (const u16*)(ws + O_VWT);
        const float* GT1 = (const float*)(ws + O_GT1);
        const u16* OCMP = (const u16*)(ws + O_OCMP);
        const u64* SEL = (const u64*)(ws + O_SEL);
        u16* OBUF = (u16*)(ws + O_OBUF);
        constexpr int KST = 72, VSTR = 40, BUFEL = 32 * KST + 64 * VSTR;
        float mbound;
        {
            float gq = fabsf(P.nsa_q_norm_g[lane]);
            float gk = fmaxf(fabsf(P.nsa_k_norm_g[64 + lane]), fabsf(P.nsa_k_norm_g[128 + lane]));
#pragma unroll
            for (int off = 1; off < 64; off <<= 1) { gq = fmaxf(gq, __shfl_xor(gq, off)); gk = fmaxf(gk, __shfl_xor(gk, off)); }
            mbound = 8.f * 1.4426950408889634f * gq * gk * 1.02f;
        }
        u16* stage = (u16*)smem;
        int* tl = (int*)(stage + 2 * BUFEL);
        for (int item = blk; item < 1024; item += nblk) {
            const int kk = item / nblk, v = item - kk * nblk;
            const int q0 = v & 127, bg = (nblk == 256) ? ((v >> 7) * 4 + kk) : (item >> 7);
            const int qt = (nblk == 256) ? ((kk & 1) ? 127 - q0 : q0) : (item & 127);
            const int b = bg >> 1, g = bg & 1, tq = qt * 32, t = tq + r;
            const size_t rowb = (size_t)b * 4096, row = rowb + t;
            const int h0 = g * 8 + wave * 2;
            bf16x8 bq[2][4];
#pragma unroll
            for (int hd = 0; hd < 2; ++hd)
#pragma unroll
                for (int st = 0; st < 4; ++st) bq[hd][st] = ld16(QN + row * 1024 + (h0 + hd) * 64 + 16 * st + 8 * hh);
            const u64 selm = SEL[(size_t)bg * 4096 + t];
            unsigned ulo = (unsigned)selm, uhi = (unsigned)(selm >> 32);
#pragma unroll
            for (int off = 1; off < 32; off <<= 1) { ulo |= __shfl_xor(ulo, off); uhi |= __shfl_xor(uhi, off); }
            const u64 uni = ((u64)uhi << 32) | ulo;
            __syncthreads();
            if (tid == 0) {
                int n = 0;
                for (int kt = (qt > 16 ? qt - 16 : 0); kt <= qt; ++kt) tl[n++] = kt | (1 << 16);
                const int jmax = (tq + 31) >> 6;
                for (int j = 0; j <= jmax; ++j)
                    if ((uni >> j) & 1ull) { tl[n++] = 2 * j; if ((2 * j + 1) * 32 <= tq + 31) tl[n++] = 2 * j + 1; }
                tl[159] = n;
            }
            __syncthreads();
            const int ntile = tl[159];
            u32x4 kr[3], vr[3];
            auto ldt = [&](u32x4& kreg, u32x4& vreg, int e) __attribute__((always_inline)) {
                const int kt = e & 0xffff, br = e >> 16;
                const u16* Kp = br ? KWN : KSN;
                const u16* Vp = br ? VWT : VST;
                kreg = *(const u32x4*)(Kp + (rowb + kt * 32 + (tid >> 3)) * 128 + g * 64 + (tid & 7) * 8);
                vreg = *(const u32x4*)(Vp + ((size_t)(b * 128 + g * 64 + (tid >> 2))) * 4096 + kt * 32 + (tid & 3) * 8);
            };
            auto stt = [&](const u32x4& kreg, const u32x4& vreg, int p) __attribute__((always_inline)) {
                u16* kb = stage + p * BUFEL;
                *(u32x4*)(kb + (tid >> 3) * KST + (tid & 7) * 8) = kreg;
                *(u32x4*)(kb + 32 * KST + (tid >> 2) * VSTR + (tid & 3) * 8) = vreg;
            };
            f32x16 res[2][2], ao[2][2];
#pragma unroll
            for (int hd = 0; hd < 2; ++hd)
#pragma unroll
                for (int dt = 0; dt < 2; ++dt) { res[hd][dt] = zero16(); ao[hd][dt] = zero16(); }
            float l[2] = {0.f, 0.f};
            int curbr = 1;
            auto finalize = [&](int br) __attribute__((always_inline)) {
#pragma unroll
                for (int hd = 0; hd < 2; ++hd) {
                    const float lt = l[hd] + __shfl_xor(l[hd], 32);
                    const float gsc = GT1[row * 48 + (h0 + hd) * 3 + 1 + br] / lt;
#pragma unroll
                    for (int dt = 0; dt < 2; ++dt)
#pragma unroll
                        for (int i = 0; i < 16; ++i) { res[hd][dt][i] += ao[hd][dt][i] * gsc; ao[hd][dt][i] = 0.f; }
                    l[hd] = 0.f;
                }
            };
            ldt(kr[0], vr[0], tl[0]);
            if (1 < ntile) ldt(kr[1], vr[1], tl[1]);
            if (2 < ntile) ldt(kr[2], vr[2], tl[2]);
            stt(kr[0], vr[0], 0);
            if (3 < ntile) ldt(kr[0], vr[0], tl[3]);
            __syncthreads();
            for (int it0 = 0; it0 < ntile; it0 += 6) {
#pragma unroll
            for (int uu = 0; uu < 6; ++uu) {
                const int it = it0 + uu;
                if (it < ntile) {
                const int e = tl[it], kt = e & 0xffff, br = e >> 16, p = uu & 1;
                if (br != curbr) { finalize(curbr); curbr = br; }
                const u16* kb = stage + p * BUFEL;
                const u16* vb = kb + 32 * KST;
                f32x16 s[2];
                s[0] = zero16(); s[1] = zero16();
#pragma unroll
                for (int st = 0; st < 4; ++st) {
                    const bf16x8 a = *(const bf16x8*)(kb + r * KST + 16 * st + 8 * hh);
                    s[0] = MFMA(a, bq[0][st], s[0]);
                    s[1] = MFMA(a, bq[1][st], s[1]);
                }
                const bool bsel = br ? true : (((selm >> (kt >> 1)) & 1ull) != 0);
                const bool interior = (kt * 32 + 31 <= tq) && (!br || kt * 32 >= tq - 480);
                const bool needmask = !interior || (__ballot(!bsel) != 0ull);
                if (needmask) {
#pragma unroll
                    for (int i = 0; i < 16; ++i) {
                        const int pk = kt * 32 + crow(i, hh);
                        bool ok = bsel && (pk <= t);
                        if (br) ok = ok && (pk > t - 512);
                        if (!ok) { s[0][i] = -1e30f; s[1][i] = -1e30f; }
                    }
                }
#pragma unroll
                for (int hd = 0; hd < 2; ++hd) {
                    float ps = 0.f;
#pragma unroll
                    for (int i = 0; i < 16; ++i) { s[hd][i] = __builtin_amdgcn_exp2f(s[hd][i] - mbound); ps += s[hd][i]; }
                    l[hd] += ps;
                }
#pragma unroll
                for (int s2 = 0; s2 < 2; ++s2) {
                    const bf16x8 pb0 = packp(s[0], s2), pb1 = packp(s[1], s2);
#pragma unroll
                    for (int dt = 0; dt < 2; ++dt) {
                        const u16* vp = vb + (dt * 32 + r) * VSTR + 16 * s2 + 4 * hh;
                        const bf16x8 av = ld8x2(vp, vp + 8);
                        ao[0][dt] = MFMA(av, pb0, ao[0][dt]);
                        ao[1][dt] = MFMA(av, pb1, ao[1][dt]);
                    }
                }
                if (it + 1 < ntile) {
                    stt(kr[(uu + 1) % 3], vr[(uu + 1) % 3], p ^ 1);
                    if (it + 4 < ntile) ldt(kr[(uu + 1) % 3], vr[(uu + 1) % 3], tl[it + 4]);
                }
                __syncthreads();
                }
            }
            }
            finalize(curbr);
#pragma unroll
            for (int hd = 0; hd < 2; ++hd)
#pragma unroll
                for (int dt = 0; dt < 2; ++dt)
#pragma unroll
                    for (int i4 = 0; i4 < 4; ++i4) {
                        const int d = dt * 32 + 8 * i4 + 4 * hh;
                        const u32x2 oc = *(const u32x2*)(OCMP + row * 1024 + (h0 + hd) * 64 + d);
                        u32x2 ov = {pk2(res[hd][dt][i4 * 4 + 0] + bflo(oc.x), res[hd][dt][i4 * 4 + 1] + bfhi(oc.x)),
                                    pk2(res[hd][dt][i4 * 4 + 2] + bflo(oc.y), res[hd][dt][i4 * 4 + 3] + bfhi(oc.y))};
                        *(u32x2*)(OBUF + row * 1024 + (h0 + hd) * 64 + d) = ov;
                    }
        }
        __syncthreads();
    };

    auto ph_15 = [&](bool dry) __attribute__((always_inline)) { if (!dry) resid_gemm((const u16*)(ws + O_OBUF), 1024, (const u16*)(ws + O_WNSAOUT), 1024, P.out, HB0, SS + 4 * MT, 1.f); else resid_gemm((const u16*)(ws + O_OBUF), 1024, (const u16*)(ws + O_WNSAOUT), 1024, P.out, (u16*)nullptr, (u64*)nullptr, 0.f); };
    auto ph_16 = [&](bool dry) __attribute__((always_inline)) { ffn_up_phase(1, HB0, SS + 4 * MT, SS + 7 * MT, !dry); };
    auto ph_17 = [&](bool dry) __attribute__((always_inline)) { if (!dry) resid_gemm((const u16*)(ws + O_ACT), 2816, (const u16*)(ws + O_WDOWN + SZ_WDOWN), 2816, P.out, HB1, SS + 5 * MT, 1.f); else resid_gemm((const u16*)(ws + O_ACT), 2816, (const u16*)(ws + O_WDOWN + SZ_WDOWN), 2816, P.out, (u16*)nullptr, (u64*)nullptr, 0.f); };
    auto ph_18 = [&](bool dry) __attribute__((always_inline)) { gate_phase(1, HB1, SS + 5 * MT, SS + 7 * MT, (u16*)nullptr, (u64*)nullptr, dry ? 0.f : 1.f); };
#define RUNA(k) do { if (PH(k)) ph_##k(); GSYNC(); if ((DUPMASK >> (k)) & 1) { ph_##k(); GSYNC(); } } while (0)
#define RUNB(k) do { if (PH(k)) ph_##k(false); GSYNC(); if ((DUPMASK >> (k)) & 1) { ph_##k(true); GSYNC(); } } while (0)
    RUNA(0); RUNA(1); RUNA(2); RUNA(3); RUNA(4); RUNA(5);
    RUNB(6); RUNB(7); RUNB(8); RUNB(9);
    RUNA(10); RUNA(11); RUNA(12); RUNA(13); RUNA(14);
    RUNB(15); RUNB(16); RUNB(17);
    if (PH(18)) ph_18(false);
    if ((DUPMASK >> 18) & 1) { GSYNC(); ph_18(true); }
}

extern "C" void kernel_launch(void* const* d_in, const int* in_sizes, int n_in, void* d_out, int out_size, void* d_ws, size_t ws_size, hipStream_t stream) {
    static int grid_blocks = 0;
    if (grid_blocks == 0) {
        if (n_in != 32 || out_size != MT * DM || ws_size < WS_NEED) {
            fprintf(stderr, "kernel_launch: unexpected problem (n_in %d, out %d, ws %zu)\n", n_in, out_size, ws_size);
            grid_blocks = -1;
            return;
        }
        int dev = 0, cus = 0, per_cu = 0;
        (void)hipGetDevice(&dev);
        (void)hipDeviceGetAttribute(&cus, hipDeviceAttributeMultiprocessorCount, dev);
        (void)hipOccupancyMaxActiveBlocksPerMultiprocessor(&per_cu, fwd_megakernel, 256, 0);
        if (per_cu < 1) per_cu = 1;
        if (per_cu > 1) per_cu = 1;
        grid_blocks = cus * per_cu;
    }
    if (grid_blocks < 0) return;
    Params p{};
    const float** pp = (const float**)&p;
    for (int i = 0; i < 32; ++i) pp[i] = (const float*)d_in[i];
    p.out = (float*)d_out;
    p.ws = (char*)d_ws;
    (void)hipMemsetAsync((char*)d_ws + O_BAR, 0, 16384, stream);
    void* args[] = {&p};
    hipError_t e = hipLaunchCooperativeKernel((void*)fwd_megakernel, dim3(grid_blocks), dim3(256), args, 0, stream);
    if (e != hipSuccess) fprintf(stderr, "cooperative launch failed: %s (grid %d)\n", hipGetErrorString(e), grid_blocks);
}
```

```cpp
#include <hip/hip_runtime.h>
#include <hip/hip_cooperative_groups.h>
#include <cstdio>
#include <type_traits>
namespace cg = cooperative_groups;

#define DI __device__ __forceinline__
typedef unsigned short u16;
typedef unsigned long long u64;
typedef __attribute__((ext_vector_type(8))) short bf16x8;
typedef __attribute__((ext_vector_type(16))) float f32x16;
typedef __attribute__((ext_vector_type(4))) unsigned u32x4;
typedef __attribute__((ext_vector_type(2))) unsigned u32x2;
#define MFMA(a, b, c) __builtin_amdgcn_mfma_f32_32x32x16_bf16((a), (b), (c), 0, 0, 0)

#ifndef USE_CG
#define USE_CG 0
#endif
#if USE_CG
#define GSYNC() grid.sync()
#else
#define GSYNC() ctr_barrier((unsigned*)(P.ws + O_BAR) + 4096 - 64, bar_gen)
#endif
#ifndef RESTRICT
#define RESTRICT 0
#endif
#define RB(k, id, n) ((((RESTRICT) >> (k)) & 1) && (n) > 256 ? ((id) < 256 ? (id) : 0x3fffffff) : (id))
#define RS(k, n) ((((RESTRICT) >> (k)) & 1) && (n) > 256 ? 256 : (n))
#ifndef P1REP
#define P1REP 1
#endif
#ifndef DUPMASK
#define DUPMASK 0
#endif
#ifndef XCD_CONSEC
#define XCD_CONSEC 1
#endif
#ifndef MINW
#define MINW 1
#endif
#ifndef ONLY
#define PH(k) true
#else
#define PH(k) ((ONLY) == (k))
#endif
constexpr int MT = 16384, DM = 1024, TS = 4096;
constexpr float EPS = 1e-6f;

constexpr size_t O_WABIN = 0;
constexpr size_t O_WABOUT = O_WABIN + 3200ull * 1024 * 2;
constexpr size_t O_WNSAIN = O_WABOUT + 1024ull * 1024 * 2;
constexpr size_t O_WC1K = O_WNSAIN + 1920ull * 1024 * 2;
constexpr size_t O_WC1V = O_WC1K + 256ull * 2048 * 2;
constexpr size_t O_WC2K = O_WC1V + 256ull * 2048 * 2;
constexpr size_t O_WC2V = O_WC2K + 128ull * 256 * 2;
constexpr size_t O_WNSAOUT = O_WC2V + 128ull * 256 * 2;
constexpr size_t O_WUP = O_WNSAOUT + 1024ull * 1024 * 2;
constexpr size_t SZ_WUP = 5632ull * 1024 * 2;
constexpr size_t O_WDOWN = O_WUP + 2 * SZ_WUP;
constexpr size_t SZ_WDOWN = 1024ull * 2816 * 2;
constexpr size_t O_WPLE = O_WDOWN + 2 * SZ_WDOWN;
constexpr size_t SZ_WPLE = 1024ull * 256 * 2;
constexpr size_t O_WGATE = O_WPLE + 2 * SZ_WPLE;
constexpr size_t SZ_WGATE = 1024ull * 1024 * 2;
constexpr size_t O_ROPEC = O_WGATE + 2 * SZ_WGATE;
constexpr size_t O_ROPES = O_ROPEC + 4096ull * 32 * 4;
constexpr size_t O_BIAS1 = O_ROPES + 4096ull * 32 * 4;
constexpr size_t O_BAR = O_BIAS1 + 4096;
constexpr size_t O_SS = O_BAR + 16384;
constexpr size_t O_HB0 = O_SS + 8ull * MT * 8;
constexpr size_t O_HB1 = O_HB0 + (size_t)MT * DM * 2;
constexpr size_t O_BIG = O_HB1 + (size_t)MT * DM * 2;
constexpr size_t O_VT0 = O_BIG;
constexpr size_t O_KT = O_VT0 + 4ull * 1024 * 4096 * 2;
constexpr size_t O_QM = O_KT + 4ull * 256 * 4096 * 2;
constexpr size_t O_KM = O_QM + (size_t)MT * 256 * 2;
constexpr size_t O_KWT = O_KM + (size_t)MT * 256 * 2;
constexpr size_t O_GS = O_KWT + 4ull * 256 * 4096 * 2;
constexpr size_t O_BL = O_GS + 16ull * 4096 * 4;
constexpr size_t O_PM = O_BL + 16ull * 4096 * 4;
constexpr size_t O_BLAST = O_PM + 16ull * 4096 * 4;
constexpr size_t O_GC = O_BLAST + 4096;
constexpr size_t O_MS = O_GC + 4096;
constexpr size_t O_NC = O_MS + 4096;
constexpr size_t O_NS = O_NC + 1024ull * 64 * 4;
constexpr size_t O_GF = O_NS + 1024ull * 64 * 4;
constexpr size_t O_KVT = O_GF + (size_t)MT * 8 * 4;
constexpr size_t O_RT = O_KVT + 512ull * 8192 * 4;
constexpr size_t O_UT = O_RT + 512ull * 8192 * 2;
constexpr size_t O_L0END = O_UT + 1024ull * 8192 * 4;
constexpr size_t O_CT = O_HB1;
constexpr size_t O_ACT = O_BIG;
constexpr size_t O_ERAW = O_ACT + (size_t)MT * 2816 * 2;
constexpr size_t O_FFNEND = O_ERAW + (size_t)MT * DM * 2;
constexpr size_t O_QN = O_BIG;
constexpr size_t O_KCVC = O_QN + (size_t)MT * DM * 2;
constexpr size_t O_KSN = O_KCVC + (size_t)MT * 256 * 2;
constexpr size_t O_KWN = O_KSN + (size_t)MT * 128 * 2;
constexpr size_t O_VST = O_KWN + (size_t)MT * 128 * 2;
constexpr size_t O_VWT = O_VST + (size_t)MT * 128 * 2;
constexpr size_t O_GT1 = O_VWT + (size_t)MT * 128 * 2;
constexpr size_t O_HID = O_GT1 + (size_t)MT * 48 * 4;
constexpr size_t O_KCN = O_HID + 2ull * 2048 * 256 * 2;
constexpr size_t O_VCT = O_KCN + 8ull * 256 * 64 * 2;
constexpr size_t O_SEL = O_VCT + 8ull * 64 * 256 * 2;
constexpr size_t O_OBUF = O_SEL + 8ull * 4096 * 8;
constexpr size_t O_L1END = O_OBUF + (size_t)MT * DM * 2;
constexpr size_t O_OCMP = O_HB1;
constexpr size_t WS_NEED = 256ull << 20;
static_assert(O_L0END <= WS_NEED && O_FFNEND <= WS_NEED && O_L1END <= WS_NEED, "workspace overflow");

struct Params {
    const float *x, *p, *ab_norm_g, *ab_w_in, *ab_conv_w, *ab_conv_b, *ab_ret_norm_g, *ab_ig_b, *ab_fg_b, *ab_m_norm_g, *ab_w_out;
    const float *nsa_norm_g, *nsa_w_in, *nsa_q_norm_g, *nsa_k_norm_g, *nsa_cmp_pos_k, *nsa_cmp_pos_v, *w1k, *w2k, *w1v, *w2v, *nsa_gate_b, *nsa_w_out;
    const float *ffn_norm_g, *ffn_w_up, *ffn_conv_w, *ffn_conv_b, *ffn_w_down, *ple_w, *ple_norm_g, *ple_gate_norm_g, *ple_w_gate;
    float* out;
    char* ws;
};

DI float bf2f(u16 b) { return __uint_as_float(((unsigned)b) << 16); }
typedef float f32x2_t __attribute__((ext_vector_type(2)));
typedef __bf16 bf16x2_t __attribute__((ext_vector_type(2)));
DI unsigned pk2(float a, float b) { f32x2_t v = {a, b}; bf16x2_t o = __builtin_convertvector(v, bf16x2_t); return __builtin_bit_cast(unsigned, o); }
DI u16 f2bf(float x) { return (u16)(pk2(x, 0.f) & 0xffffu); }
DI float bflo(unsigned u) { return __uint_as_float(u << 16); }
DI float bfhi(unsigned u) { return __uint_as_float(u & 0xffff0000u); }
DI int crow(int i, int h) { return (i & 3) + 8 * (i >> 2) + 4 * h; }
DI float sigmoidf_(float x) { return 1.f / (1.f + __expf(-x)); }
DI float gelu_tanh(float x) { float y = 0.7978845608028654f * (x + 0.044715f * x * x * x); float t = 1.f - 2.f / (__expf(2.f * y) + 1.f); return 0.5f * x * (1.f + t); }
DI float red32(float v) { v += __shfl_xor(v, 1); v += __shfl_xor(v, 2); v += __shfl_xor(v, 4); v += __shfl_xor(v, 8); v += __shfl_xor(v, 16); return v; }
DI bf16x8 ld16(const u16* p) { return *(const bf16x8*)p; }
DI bf16x8 ld8x2(const u16* p0, const u16* p1) { u32x2 a = *(const u32x2*)p0, b = *(const u32x2*)p1; u32x4 v = {a.x, a.y, b.x, b.y}; return __builtin_bit_cast(bf16x8, v); }
DI bf16x8 packp(const f32x16& x, int s) {
    u32x4 v = {pk2(x[8 * s + 0], x[8 * s + 1]), pk2(x[8 * s + 2], x[8 * s + 3]), pk2(x[8 * s + 4], x[8 * s + 5]), pk2(x[8 * s + 6], x[8 * s + 7])};
    return __builtin_bit_cast(bf16x8, v);
}
DI f32x16 zero16() { f32x16 z; for (int i = 0; i < 16; ++i) z[i] = 0.f; return z; }
DI u64 ss_fix(float s) { return (u64)(s * 1048576.f + 0.5f); }
DI float ss_rstd(u64 v) { return rsqrtf((float)v * (1.f / (1048576.f * 1024.f)) + EPS); }
DI float gamma_log(int h) { return log1pf(-exp2f(-5.f - (float)h)); }


#define XB_TMO      128
#define XB_XCNT(j)  (256  + 64 * (j))
#define XB_XSUB(j)  (1280 + 64 * (j))
#define XB_XGEN(j)  (2304 + 64 * (j))
#define XB_TOP      3328
#define XB_TOPGEN   3392
#define XCD_BAR_WORDS 3456
#define XB_SPIN_CAP (1u << 22)
#define LAS __attribute__((address_space(3)))
DI unsigned xb_ld(unsigned* p) { return __hip_atomic_load(p, __ATOMIC_RELAXED, __HIP_MEMORY_SCOPE_AGENT); }
DI unsigned xb_add(unsigned* p, unsigned v) { return __hip_atomic_fetch_add(p, v, __ATOMIC_RELAXED, __HIP_MEMORY_SCOPE_AGENT); }
DI unsigned xb_xcc_id() { return (unsigned)__builtin_amdgcn_s_getreg((3 << 11) | 20) & 0xFu; }
#define XB_SPIN(cond, bar) do { unsigned _sp = 0; while (cond) { __builtin_amdgcn_s_sleep(1); \
    if ((++_sp & 255u) == 0u) { if (xb_ld(&(bar)[XB_TMO])) break; if (_sp > XB_SPIN_CAP) { atomicAdd(&(bar)[XB_TMO], 1u); break; } } } } while (0)
struct XcdBarrier { unsigned* bar; unsigned x; volatile LAS unsigned* st; };
DI XcdBarrier xcd_barrier_post(unsigned* bar, volatile LAS unsigned* st) {
    XcdBarrier b; b.bar = bar; b.x = xb_xcc_id(); b.st = st;
    if (threadIdx.x == 0) (void)xb_add(&bar[XB_XCNT(b.x)], 1u);
    return b;
}
DI void xcd_barrier_complete(unsigned* bar, unsigned x, unsigned& nloc, unsigned& nx) {
    const unsigned G = gridDim.x * gridDim.y * gridDim.z;
    unsigned sum, cnt, mine, sp = 0u;
    for (;;) {
        sum = 0u; cnt = 0u; mine = 0u;
#pragma unroll
        for (unsigned j = 0; j < 16; ++j) { const unsigned c = xb_ld(&bar[XB_XCNT(j)]); sum += c; cnt += (c > 0u) ? 1u : 0u; mine = (j == x) ? c : mine; }
        if (sum == G) break;
        __builtin_amdgcn_s_sleep(1);
        if ((++sp & 255u) == 0u) { if (xb_ld(&bar[XB_TMO])) break; if (sp > XB_SPIN_CAP) { atomicAdd(&bar[XB_TMO], 1u); break; } }
    }
    nloc = mine > 0u ? mine : 1u; nx = cnt > 0u ? cnt : 1u;
}
DI void xcd_barrier(const XcdBarrier& b) {
    asm volatile("s_waitcnt vmcnt(0)" ::: "memory");
    __syncthreads();
    if (threadIdx.x == 0) {
        unsigned* bar = b.bar;
        __builtin_amdgcn_s_waitcnt(0);
        unsigned nloc = b.st[0], nx = b.st[1];
        if (nloc == 0u) { xcd_barrier_complete(bar, b.x, nloc, nx); b.st[0] = nloc; b.st[1] = nx; }
        const unsigned old = xb_add(&bar[XB_XSUB(b.x)], 1u);
        const unsigned gen = old / nloc;
        if (old + 1u == (gen + 1u) * nloc) {
            __builtin_amdgcn_fence(__ATOMIC_RELEASE, "agent");
            asm volatile("s_waitcnt vmcnt(0)" ::: "memory");
            const unsigned og = xb_add(&bar[XB_TOP], 1u);
            const unsigned tg = og / nx;
            if (og + 1u == (tg + 1u) * nx) xb_add(&bar[XB_TOPGEN], 1u);
            else XB_SPIN(xb_ld(&bar[XB_TOPGEN]) == tg, bar);
            __builtin_amdgcn_fence(__ATOMIC_ACQUIRE, "agent");
            xb_add(&bar[XB_XGEN(b.x)], 1u);
            asm volatile("s_waitcnt vmcnt(0)" ::: "memory");
        } else {
            XB_SPIN(xb_ld(&bar[XB_XGEN(b.x)]) == gen, bar);
            __builtin_amdgcn_fence(__ATOMIC_ACQUIRE, "agent");
            asm volatile("s_waitcnt vmcnt(0)" ::: "memory");
        }
    }
    __syncthreads();
}

DI void ctr_barrier(unsigned* ctr, unsigned& gen) {
    asm volatile("s_waitcnt vmcnt(0)" ::: "memory");
    __syncthreads();
    gen += 1u;
    if (threadIdx.x == 0) {
        __builtin_amdgcn_fence(__ATOMIC_RELEASE, "agent");
        asm volatile("s_waitcnt vmcnt(0)" ::: "memory");
        (void)__hip_atomic_fetch_add(ctr, 1u, __ATOMIC_RELAXED, __HIP_MEMORY_SCOPE_AGENT);
        const unsigned target = gen * gridDim.x;
        unsigned sp = 0;
        while (__hip_atomic_load(ctr, __ATOMIC_RELAXED, __HIP_MEMORY_SCOPE_AGENT) < target) {
            __builtin_amdgcn_s_sleep(1);
            if (++sp > (1u << 24)) break;
        }
        __builtin_amdgcn_fence(__ATOMIC_ACQUIRE, "agent");
        asm volatile("s_waitcnt vmcnt(0)" ::: "memory");
    }
    __syncthreads();
}

constexpr int LDT = 72;
constexpr int LDS_BYTES = 2 * 2 * 128 * LDT * 2;

template <bool AF32, class RowA>
DI void gemm_main(f32x16 (&acc)[2][2], RowA rowA, const int kmulA, const u16* __restrict__ Bf, int ldb, int n0, int K, u16* As, u16*  ) {
    constexpr int PD = 4;
    constexpr int BUFE = 128 * LDT;
    const int tid = threadIdx.x, lane = tid & 63, wave = tid >> 6;
    const int wm = wave >> 1, wn = wave & 1, r = lane & 31, hh = lane >> 5;
#pragma unroll
    for (int mi = 0; mi < 2; ++mi)
#pragma unroll
        for (int ni = 0; ni < 2; ++ni) acc[mi][ni] = zero16();
    typedef typename std::conditional<AF32, float, u16>::type TA;
    const int row0 = tid >> 3, kc = (tid & 7) * 8;
    const TA* pa[4];
#pragma unroll
    for (int i = 0; i < 4; ++i) pa[i] = (const TA*)rowA(row0 + 32 * i) + kc;
    const int kbn = ldb >> 4;
    const u16* pb = Bf + ((size_t)((n0 + wn * 64) >> 5) * kbn * 64 + lane) * 8;
    u32x4 ra[PD][4];
    bf16x8 rb[PD][8];
    auto loadA = [&](u32x4 (&xa)[4], int k0) __attribute__((always_inline)) {
#pragma unroll
        for (int i = 0; i < 4; ++i) {
            if constexpr (AF32) {
                const float* q = (const float*)pa[i] + k0 * kmulA;
                const float4 v0 = *(const float4*)q, v1 = *(const float4*)(q + 4);
                u32x4 t = {pk2(v0.x, v0.y), pk2(v0.z, v0.w), pk2(v1.x, v1.y), pk2(v1.z, v1.w)};
                xa[i] = t;
            } else {
                xa[i] = *(const u32x4*)((const u16*)pa[i] + k0 * kmulA);
            }
        }
    };
    auto loadB = [&](bf16x8 (&xb)[8], int k0) __attribute__((always_inline)) {
#pragma unroll
        for (int ni = 0; ni < 2; ++ni)
#pragma unroll
            for (int ks = 0; ks < 4; ++ks) xb[ni * 4 + ks] = *(const bf16x8*)(pb + ((size_t)ni * kbn + (k0 >> 4) + ks) * 512);
    };
    auto stores = [&](const u32x4 (&xa)[4], int p) __attribute__((always_inline)) {
        u16* sa = As + p * BUFE + row0 * LDT + kc;
#pragma unroll
        for (int i = 0; i < 4; ++i) *(u32x4*)(sa + 32 * i * LDT) = xa[i];
    };
    const int nk = K >> 6;
#pragma unroll
    for (int d = 0; d < PD; ++d) { loadA(ra[d], d * 64); loadB(rb[d], d * 64); }
    __syncthreads();
    stores(ra[0], 0);
    if (PD < nk) loadA(ra[0], PD * 64);
    __syncthreads();
    const u16* fa = As + (wm * 64 + r) * LDT + hh * 8;
    for (int kb = 0; kb < nk; kb += PD) {
#pragma unroll
        for (int u = 0; u < PD; ++u) {
            const int k = kb + u, p = u & 1;
#pragma unroll
            for (int ks = 0; ks < 4; ++ks) {
                bf16x8 a[2];
#pragma unroll
                for (int mi = 0; mi < 2; ++mi) a[mi] = *(const bf16x8*)(fa + p * BUFE + mi * 32 * LDT + ks * 16);
#pragma unroll
                for (int mi = 0; mi < 2; ++mi)
#pragma unroll
                    for (int ni = 0; ni < 2; ++ni) acc[mi][ni] = MFMA(a[mi], rb[u][ni * 4 + ks], acc[mi][ni]);
            }
            if (k + PD < nk) loadB(rb[u], (k + PD) * 64);
            if (k + 1 < nk) {
                stores(ra[(u + 1) % PD], p ^ 1);
                if (k + 1 + PD < nk) loadA(ra[(u + 1) % PD], (k + 1 + PD) * 64);
            }
            __syncthreads();
        }
    }
}

DI bool tile_decode(int v, int MTl, int NTl, int& mt, int& nt) {
    mt = v / NTl; nt = v - mt * NTl;
    return v < MTl * NTl;
}
DI int tile_bound(int MTl, int NTl) { return MTl * NTl; }

template <class RowMap>
DI void tconv(const float* __restrict__ W, int K, int N, int Npad, const float* __restrict__ g, u16* __restrict__ out, RowMap rm, int gtid, int gsz) {
    const int total = (K / 32) * Npad, kb_per_n = K >> 4;
    for (int u = gtid; u < total; u += gsz) {
        const int n = u % Npad, k32 = u / Npad;
        float v[32];
        if (n < N) {
            const float* wp = W + (size_t)(k32 * 32) * N + n;
#pragma unroll
            for (int j = 0; j < 32; ++j) v[j] = wp[(size_t)j * N];
            if (g) {
#pragma unroll
                for (int j = 0; j < 32; ++j) v[j] *= g[k32 * 32 + j];
            }
        } else {
#pragma unroll
            for (int j = 0; j < 32; ++j) v[j] = 0.f;
        }
        const int np = rm(n), nb = np >> 5, rr = np & 31;
#pragma unroll
        for (int q = 0; q < 4; ++q) {
            u32x4 o = {pk2(v[8 * q + 0], v[8 * q + 1]), pk2(v[8 * q + 2], v[8 * q + 3]), pk2(v[8 * q + 4], v[8 * q + 5]), pk2(v[8 * q + 6], v[8 * q + 7])};
            const size_t blkid = (size_t)nb * kb_per_n + k32 * 2 + (q >> 1);
            *(u32x4*)(out + (blkid * 64 + (q & 1) * 32 + rr) * 8) = o;
        }
    }
}
DI void zfill16(u16* p, size_t n_elems, int gtid, int gsz) {
    u32x4 z = {0u, 0u, 0u, 0u};
    for (size_t u = gtid; u < n_elems / 8; u += gsz) *(u32x4*)(p + u * 8) = z;
}

__global__ void __launch_bounds__(256, MINW) fwd_megakernel(Params P) {
    cg::grid_group grid = cg::this_grid();
    __shared__ __attribute__((aligned(16))) char smem[LDS_BYTES];
    __shared__ uint4 xb_words;
    if (threadIdx.x == 0) xb_words = make_uint4(0u, 0u, 0u, 0u);
    __syncthreads();
    unsigned bar_gen = 0u;
    const XcdBarrier xbar = xcd_barrier_post((unsigned*)(P.ws + O_BAR), (volatile LAS unsigned*)&xb_words);
    u16* As = (u16*)smem;
    u16* Bs = As + 128 * LDT;
    const int tid = threadIdx.x, lane = tid & 63, wave = tid >> 6;
    const int wm = wave >> 1, wn = wave & 1, r = lane & 31, hh = lane >> 5;
    const int nblk = gridDim.x, blk = blockIdx.x;
    const int gtid = blk * 256 + tid, gsz = nblk * 256;
    const int gw = blk * 4 + wave, ngw = nblk * 4;
    char* ws = P.ws;
    u64* SS = (u64*)(ws + O_SS);
    u16* HB0 = (u16*)(ws + O_HB0);
    u16* HB1 = (u16*)(ws + O_HB1);
    const float* ROPEC = (const float*)(ws + O_ROPEC);
    const float* ROPES = (const float*)(ws + O_ROPES);

    auto ph_0 = [&]() __attribute__((always_inline)) {
        auto idm = [](int n) { return n; };
        auto upm = [](int n) { return n < 2816 ? (n >> 6) * 128 + (n & 63) : ((n - 2816) >> 6) * 128 + 64 + ((n - 2816) & 63); };
        tconv(P.ab_w_in, 1024, 3080, 3200, P.ab_norm_g, (u16*)(ws + O_WABIN), idm, gtid, gsz);
        tconv(P.ab_w_out, 1024, 1024, 1024, (const float*)nullptr, (u16*)(ws + O_WABOUT), idm, gtid, gsz);
        tconv(P.nsa_w_in, 1024, 1840, 1920, P.nsa_norm_g, (u16*)(ws + O_WNSAIN), idm, gtid, gsz);
        tconv(P.w1k, 2048, 256, 256, (const float*)nullptr, (u16*)(ws + O_WC1K), idm, gtid, gsz);
        tconv(P.w1v, 2048, 256, 256, (const float*)nullptr, (u16*)(ws + O_WC1V), idm, gtid, gsz);
        tconv(P.w2k, 256, 64, 128, (const float*)nullptr, (u16*)(ws + O_WC2K), idm, gtid, gsz);
        tconv(P.w2v, 256, 64, 128, (const float*)nullptr, (u16*)(ws + O_WC2V), idm, gtid, gsz);
        tconv(P.nsa_w_out, 1024, 1024, 1024, (const float*)nullptr, (u16*)(ws + O_WNSAOUT), idm, gtid, gsz);
        for (int i = 0; i < 2; ++i) {
            tconv(P.ffn_w_up + (size_t)i * 1024 * 5632, 1024, 5632, 5632, P.ffn_norm_g + i * 1024, (u16*)(ws + O_WUP + i * SZ_WUP), upm, gtid, gsz);
            tconv(P.ffn_w_down + (size_t)i * 2816 * 1024, 2816, 1024, 1024, (const float*)nullptr, (u16*)(ws + O_WDOWN + i * SZ_WDOWN), idm, gtid, gsz);
            tconv(P.ple_w + (size_t)i * 256 * 1024, 256, 1024, 1024, (const float*)nullptr, (u16*)(ws + O_WPLE + i * SZ_WPLE), idm, gtid, gsz);
            tconv(P.ple_w_gate + (size_t)i * 1024 * 1024, 1024, 1024, 1024, P.ple_gate_norm_g + i * 1024, (u16*)(ws + O_WGATE + i * SZ_WGATE), idm, gtid, gsz);
        }
        {
            float* rc = (float*)(ws + O_ROPEC);
            float* rs = (float*)(ws + O_ROPES);
            for (int u = gtid; u < 4096 * 32; u += gsz) {
                const int pos = u >> 5, d = u & 31;
                const float inv = powf(10000.f, -(float)d / 32.f);
                const float ang = (float)pos * inv;
                const double a = (double)ang;
                const double n = rint(a * 0.15915494309189535);
                const float rr = (float)(a - n * 6.283185307179586);
                rc[u] = cosf(rr);
                rs[u] = sinf(rr);
            }
        }
        for (int u = gw; u < 512; u += ngw) {
            const int kv = u >> 8, j = u & 255;
            const float* pos = kv ? P.nsa_cmp_pos_v : P.nsa_cmp_pos_k;
            const float* W1 = kv ? P.w1v : P.w1k;
            float s = 0.f;
            for (int k = lane; k < 2048; k += 64) s += pos[k] * W1[(size_t)k * 256 + j];
            s = red32(s); s += __shfl_xor(s, 32);
            if (lane == 0) ((float*)(ws + O_BIAS1))[u] = s;
        }
        for (int u = gtid; u < 7 * MT; u += gsz) SS[MT + u] = 0ull;
        for (int row = gw; row < MT; row += ngw) {
            const float4* xr = (const float4*)(P.x + (size_t)row * DM);
            float s = 0.f;
#pragma unroll
            for (int j = 0; j < 4; ++j) {
                const float4 v = xr[lane + 64 * j];
                s += v.x * v.x + v.y * v.y + v.z * v.z + v.w * v.w;
                u32x2 o = {pk2(v.x, v.y), pk2(v.z, v.w)};
                *(u32x2*)(HB0 + (size_t)row * DM + (lane + 64 * j) * 4) = o;
            }
            s = red32(s); s += __shfl_xor(s, 32);
            if (lane == 0) SS[row] = ss_fix(s);
        }
    };

    auto ph_1 = [&]() __attribute__((always_inline)) {
        u16* Z0 = (u16*)P.out;
        u16* VT0 = (u16*)(ws + O_VT0);
        u16* KT = (u16*)(ws + O_KT);
        float* GF = (float*)(ws + O_GF);
        const u16* Wt = (const u16*)(ws + O_WABIN);
        for (int tile = blk; tile < tile_bound(128, 25); tile += nblk) {
            int mt, nt; if (!tile_decode(tile, 128, 25, mt, nt)) continue;
            const int m0 = mt * 128, n0 = nt * 128;
            f32x16 acc[2][2];
            const u16* Ab = HB0 + (size_t)m0 * DM;
            gemm_main<false>(acc, [&](int row) { return Ab + (size_t)row * DM; }, 1, Wt, 1024, n0, 1024, As, Bs);
            const int colw = n0 + wn * 64;
            float rsv[2][16], cv[2][16], sv[2][16];
#pragma unroll
            for (int mi = 0; mi < 2; ++mi)
#pragma unroll
                for (int i = 0; i < 16; ++i) {
                    const int row = m0 + wm * 64 + mi * 32 + crow(i, hh);
                    rsv[mi][i] = ss_rstd(SS[row]);
                    cv[mi][i] = (nt < 4) ? ROPEC[(row & 4095) * 32 + r] : 0.f;
                    sv[mi][i] = (nt < 4) ? ROPES[(row & 4095) * 32 + r] : 0.f;
                }
#pragma unroll
            for (int mi = 0; mi < 2; ++mi) {
#pragma unroll
                for (int i4 = 0; i4 < 4; ++i4) {
                    float v0[4], v1[4];
                    const int rowb = m0 + wm * 64 + mi * 32 + 8 * i4 + 4 * hh;
#pragma unroll
                    for (int j = 0; j < 4; ++j) {
                        const float rs = rsv[mi][i4 * 4 + j];
                        v0[j] = acc[mi][0][i4 * 4 + j] * rs;
                        v1[j] = acc[mi][1][i4 * 4 + j] * rs;
                    }
                    const int bb = rowb >> 12, t = rowb & 4095;
                    if (nt < 4) {
                        const int head = (colw & 255) >> 6;
                        const float lg = gamma_log(head);
#pragma unroll
                        for (int j = 0; j < 4; ++j) {
                            const float c = cv[mi][i4 * 4 + j], s = sv[mi][i4 * 4 + j];
                            float y0 = v0[j] * c - v1[j] * s, y1 = v0[j] * s + v1[j] * c;
                            if (nt >= 2) { const float sc = 0.125f * __expf(-(float)(((t + j) & 127) + 1) * lg); y0 *= sc; y1 *= sc; }
                            v0[j] = y0; v1[j] = y1;
                            Z0[(size_t)(rowb + j) * 2048 + colw + r] = f2bf(y0);
                            Z0[(size_t)(rowb + j) * 2048 + colw + 32 + r] = f2bf(y1);
                        }
                        if (nt >= 2) {
                            const int kc = colw - 256;
                            u32x2 o0 = {pk2(v0[0], v0[1]), pk2(v0[2], v0[3])}, o1 = {pk2(v1[0], v1[1]), pk2(v1[2], v1[3])};
                            *(u32x2*)(KT + ((size_t)(bb * 256 + kc + r)) * 4096 + t) = o0;
                            *(u32x2*)(KT + ((size_t)(bb * 256 + kc + 32 + r)) * 4096 + t) = o1;
                        }
                    } else if ((nt >= 4 && nt < 8) || (nt >= 16 && nt < 20)) {
                        const int vc = (nt < 8) ? (colw - 512) : (512 + colw - 2048);
                        u32x2 o0 = {pk2(v0[0], v0[1]), pk2(v0[2], v0[3])}, o1 = {pk2(v1[0], v1[1]), pk2(v1[2], v1[3])};
                        *(u32x2*)(VT0 + ((size_t)(bb * 1024 + vc + r)) * 4096 + t) = o0;
                        *(u32x2*)(VT0 + ((size_t)(bb * 1024 + vc + 32 + r)) * 4096 + t) = o1;
                    } else if (nt < 24) {
                        const int zc = (nt < 12) ? (512 + colw - 1024) : (nt < 16) ? (1024 + colw - 1536) : (1536 + colw - 2560);
#pragma unroll
                        for (int j = 0; j < 4; ++j) {
                            Z0[(size_t)(rowb + j) * 2048 + zc + r] = f2bf(v0[j]);
                            Z0[(size_t)(rowb + j) * 2048 + zc + 32 + r] = f2bf(v1[j]);
                        }
                    } else {
                        if (wn == 0 && r < 8) {
#pragma unroll
                            for (int j = 0; j < 4; ++j) GF[(size_t)(rowb + j) * 8 + r] = v0[j];
                        }
                    }
                }
            }
        }
    };

    auto ph_2 = [&]() __attribute__((always_inline)) {
        const u16* Z0 = (const u16*)P.out;
        const float* GF = (const float*)(ws + O_GF);
        float* GS = (float*)(ws + O_GS); float* BL = (float*)(ws + O_BL); float* PM = (float*)(ws + O_PM);
        float* BLAST = (float*)(ws + O_BLAST); float* GC = (float*)(ws + O_GC); float* NC = (float*)(ws + O_NC);
        u16* QM = (u16*)(ws + O_QM); u16* KM = (u16*)(ws + O_KM); u16* KWT = (u16*)(ws + O_KWT);
        for (int u = gw; u < 1024; u += ngw) {
            const int bh = u >> 6, c = u & 63, b = bh >> 2, h = bh & 3, t0 = c * 64;
            const size_t rowb = (size_t)b * 4096;
            const size_t row = rowb + t0 + lane;
            const float f = GF[row * 8 + 4 + h] + P.ab_fg_b[h];
            const float fc = fminf(f, 0.f) - log1pf(__expf(-fabsf(f)));
            const float ic = GF[row * 8 + h] + P.ab_ig_b[h];
            float bcs = fc;
#pragma unroll
            for (int off = 1; off < 64; off <<= 1) { const float o = __shfl_up(bcs, off); if (lane >= off) bcs += o; }
            const float g = ic - bcs;
            float pm = g;
#pragma unroll
            for (int off = 1; off < 64; off <<= 1) { const float o = __shfl_up(pm, off); if (lane >= off) pm = fmaxf(pm, o); }
            const float G = __shfl(pm, 63), bl = __shfl(bcs, 63);
            const float w = __expf(g - G);
            GS[bh * 4096 + t0 + lane] = g; BL[bh * 4096 + t0 + lane] = bcs; PM[bh * 4096 + t0 + lane] = pm;
            if (lane == 0) { BLAST[bh * 64 + c] = bl; GC[bh * 64 + c] = G; }
            {
                const int ch = 256 + h * 64 + lane;
                const float w0 = P.ab_conv_w[ch], w1 = P.ab_conv_w[512 + ch], w2 = P.ab_conv_w[1024 + ch], w3 = P.ab_conv_w[1536 + ch], cb = P.ab_conv_b[ch];
                const u16* zp = Z0 + 1024 + ch;
                float x0 = 0.f, x1 = 0.f, x2 = 0.f;
                if (t0 > 0) { x0 = bf2f(zp[(rowb + t0 - 3) * 2048]); x1 = bf2f(zp[(rowb + t0 - 2) * 2048]); x2 = bf2f(zp[(rowb + t0 - 1) * 2048]); }
                float nsum = 0.f;
                float xr[64];
#pragma unroll
                for (int s = 0; s < 64; ++s) xr[s] = bf2f(zp[(rowb + t0 + s) * 2048]);
#pragma unroll
                for (int s8 = 0; s8 < 8; ++s8) {
                    float vw[8];
#pragma unroll
                    for (int j = 0; j < 8; ++j) {
                        const int s = s8 * 8 + j;
                        const float x3 = xr[s];
                        float v = cb + w0 * x0 + w1 * x1 + w2 * x2 + w3 * x3;
                        v = v / (1.f + __expf(-v));
                        x0 = x1; x1 = x2; x2 = x3;
                        KM[(rowb + t0 + s) * 256 + h * 64 + lane] = f2bf(v);
                        const float wsv = __shfl(w, s);
                        vw[j] = v * wsv; nsum += vw[j];
                    }
                    u32x4 o = {pk2(vw[0], vw[1]), pk2(vw[2], vw[3]), pk2(vw[4], vw[5]), pk2(vw[6], vw[7])};
                    *(u32x4*)(KWT + ((size_t)(b * 256 + h * 64 + lane)) * 4096 + t0 + s8 * 8) = o;
                }
                NC[(size_t)u * 64 + lane] = nsum;
            }
            {
                const int ch = h * 64 + lane;
                const float w0 = P.ab_conv_w[ch], w1 = P.ab_conv_w[512 + ch], w2 = P.ab_conv_w[1024 + ch], w3 = P.ab_conv_w[1536 + ch], cb = P.ab_conv_b[ch];
                const u16* zp = Z0 + 1024 + ch;
                float x0 = 0.f, x1 = 0.f, x2 = 0.f;
                if (t0 > 0) { x0 = bf2f(zp[(rowb + t0 - 3) * 2048]); x1 = bf2f(zp[(rowb + t0 - 2) * 2048]); x2 = bf2f(zp[(rowb + t0 - 1) * 2048]); }
                float xr[64];
#pragma unroll
                for (int s = 0; s < 64; ++s) xr[s] = bf2f(zp[(rowb + t0 + s) * 2048]);
#pragma unroll
                for (int s = 0; s < 64; ++s) {
                    const float x3 = xr[s];
                    float v = cb + w0 * x0 + w1 * x1 + w2 * x2 + w3 * x3;
                    v = v / (1.f + __expf(-v));
                    x0 = x1; x1 = x2; x2 = x3;
                    QM[(rowb + t0 + s) * 256 + h * 64 + lane] = f2bf(v * 0.125f);
                }
            }
        }
    };

    auto ph_3 = [&]() __attribute__((always_inline)) {
        const u16* VT0 = (const u16*)(ws + O_VT0);
        const u16* KT = (const u16*)(ws + O_KT);
        const u16* KWT = (const u16*)(ws + O_KWT);
        float* KVT = (float*)(ws + O_KVT);
        float* UT = (float*)(ws + O_UT);
        for (int u = gw; u < 2048 + 4096; u += ngw) {
            f32x16 a0 = zero16(), a1 = zero16();
            if (u < 2048) {
                const int dt = u & 3, c = (u >> 2) & 31, bh = u >> 7, b = bh >> 2, h = bh & 3, t0 = c * 128;
                const u16* va = VT0 + ((size_t)(b * 1024 + h * 128 + dt * 32 + r)) * 4096 + t0 + 8 * hh;
                const u16* kb = KT + ((size_t)(b * 256 + h * 64 + r)) * 4096 + t0 + 8 * hh;
#pragma unroll
                for (int st = 0; st < 8; ++st) {
                    const bf16x8 a = ld16(va + 16 * st);
                    a0 = MFMA(a, ld16(kb + 16 * st), a0);
                    a1 = MFMA(a, ld16(kb + 32 * 4096 + 16 * st), a1);
                }
                const float cdec = __expf(128.f * gamma_log(h));
                float* o = KVT + (size_t)(bh * 32 + c) * 8192;
#pragma unroll
                for (int i = 0; i < 16; ++i) {
                    o[(dt * 32 + crow(i, hh)) * 64 + r] = cdec * a0[i];
                    o[(dt * 32 + crow(i, hh)) * 64 + 32 + r] = cdec * a1[i];
                }
            } else {
                const int v = u - 2048;
                const int dt = v & 3, c = (v >> 2) & 63, bh = v >> 8, b = bh >> 2, h = bh & 3, t0 = c * 64;
                const u16* va = VT0 + ((size_t)(b * 1024 + 512 + h * 128 + dt * 32 + r)) * 4096 + t0 + 8 * hh;
                const u16* kb = KWT + ((size_t)(b * 256 + h * 64 + r)) * 4096 + t0 + 8 * hh;
#pragma unroll
                for (int st = 0; st < 4; ++st) {
                    const bf16x8 a = ld16(va + 16 * st);
                    a0 = MFMA(a, ld16(kb + 16 * st), a0);
                    a1 = MFMA(a, ld16(kb + 32 * 4096 + 16 * st), a1);
                }
                float* o = UT + (size_t)(bh * 64 + c) * 8192;
#pragma unroll
                for (int i = 0; i < 16; ++i) {
                    o[(dt * 32 + crow(i, hh)) * 64 + r] = a0[i];
                    o[(dt * 32 + crow(i, hh)) * 64 + 32 + r] = a1[i];
                }
            }
        }
    };

    auto ph_4 = [&]() __attribute__((always_inline)) {
        const float* KVT = (const float*)(ws + O_KVT);
        const float* UT = (const float*)(ws + O_UT);
        const float* NC = (const float*)(ws + O_NC);
        const float* BLAST = (const float*)(ws + O_BLAST);
        const float* GC = (const float*)(ws + O_GC);
        u16* RT = (u16*)(ws + O_RT);
        u16* CT = (u16*)(ws + O_CT);
        float* MS = (float*)(ws + O_MS);
        float* NS = (float*)(ws + O_NS);
        for (int e = gtid; e < 131072 * 2 + 1024; e += gsz) {
            if (e < 131072) {
                const int bh = e >> 13, idx = e & 8191;
                const float cdec = __expf(128.f * gamma_log(bh & 3));
                float R = 0.f;
                float kvv[32];
#pragma unroll
                for (int c = 0; c < 32; ++c) kvv[c] = KVT[(size_t)(bh * 32 + c) * 8192 + idx];
#pragma unroll
                for (int c = 0; c < 32; ++c) {
                    RT[(size_t)(bh * 32 + c) * 8192 + idx] = f2bf(R);
                    R = cdec * R + kvv[c];
                }
            } else if (e < 262144) {
                const int e2 = e - 131072, bh = e2 >> 13, idx = e2 & 8191;
                float C = 0.f, m = 0.f;
                float utv[64];
#pragma unroll
                for (int c = 0; c < 64; ++c) utv[c] = UT[(size_t)(bh * 64 + c) * 8192 + idx];
#pragma unroll
                for (int c = 0; c < 64; ++c) {
                    const float G = GC[bh * 64 + c];
                    const float M = fmaxf(m, G);
                    const float dC = __expf(m - M), dU = __expf(G - M);
                    CT[(size_t)(bh * 64 + c) * 8192 + idx] = f2bf(C);
                    if (idx == 0) MS[bh * 64 + c] = m;
                    C = dC * C + dU * utv[c];
                    m = BLAST[bh * 64 + c] + M;
                }
            } else {
                const int e2 = e - 262144, bh = e2 >> 6, dk = e2 & 63;
                float n = 0.f, m = 0.f;
                for (int c = 0; c < 64; ++c) {
                    const float G = GC[bh * 64 + c];
                    const float M = fmaxf(m, G);
                    const float dC = __expf(m - M), dU = __expf(G - M);
                    NS[(size_t)(bh * 64 + c) * 64 + dk] = n;
                    n = dC * n + dU * NC[(size_t)(bh * 64 + c) * 64 + dk];
                    m = BLAST[bh * 64 + c] + M;
                }
            }
        }
    };

    auto ph_5 = [&]() __attribute__((always_inline)) {
        const u16* Z0 = (const u16*)P.out;
        const u16* VT0 = (const u16*)(ws + O_VT0);
        const u16* RT = (const u16*)(ws + O_RT);
        const u16* CT = (const u16*)(ws + O_CT);
        const u16* QM = (const u16*)(ws + O_QM);
        const u16* KM = (const u16*)(ws + O_KM);
        const float* GS = (const float*)(ws + O_GS); const float* BL = (const float*)(ws + O_BL); const float* PM = (const float*)(ws + O_PM);
        const float* MS = (const float*)(ws + O_MS); const float* NS = (const float*)(ws + O_NS);
        u16* MIX = HB0;
        for (int u = gw; u < 4096; u += ngw) {
            f32x16 o[4];
            if (u < 2048) {
                const int qt = u & 3, c = (u >> 2) & 31, bh = u >> 7, b = bh >> 2, h = bh & 3, t0 = c * 128, tq = t0 + qt * 32;
                const size_t rowb = (size_t)b * 4096;
                bf16x8 bq[4];
#pragma unroll
                for (int st = 0; st < 4; ++st) bq[st] = ld16(Z0 + (rowb + tq + r) * 2048 + h * 64 + 16 * st + 8 * hh);
                const u16* rt = RT + (size_t)(bh * 32 + c) * 8192;
#pragma unroll
                for (int dt = 0; dt < 4; ++dt) {
                    o[dt] = zero16();
#pragma unroll
                    for (int st = 0; st < 4; ++st) o[dt] = MFMA(ld16(rt + (dt * 32 + r) * 64 + 16 * st + 8 * hh), bq[st], o[dt]);
                }
                for (int kt = 0; kt <= qt; ++kt) {
                    f32x16 s = zero16();
#pragma unroll
                    for (int st = 0; st < 4; ++st) s = MFMA(ld16(Z0 + (rowb + t0 + kt * 32 + r) * 2048 + 256 + h * 64 + 16 * st + 8 * hh), bq[st], s);
                    if (kt == qt) {
#pragma unroll
                        for (int i = 0; i < 16; ++i) if (crow(i, hh) > r) s[i] = 0.f;
                    }
#pragma unroll
                    for (int s2 = 0; s2 < 2; ++s2) {
                        const bf16x8 pb = packp(s, s2);
#pragma unroll
                        for (int dt = 0; dt < 4; ++dt) {
                            const u16* vp = VT0 + ((size_t)(b * 1024 + h * 128 + dt * 32 + r)) * 4096 + t0 + kt * 32 + 16 * s2 + 4 * hh;
                            o[dt] = MFMA(ld8x2(vp, vp + 8), pb, o[dt]);
                        }
                    }
                }
                const float qdec = __expf((float)(qt * 32 + r + 1) * gamma_log(h));
                float ss = 0.f;
#pragma unroll
                for (int dt = 0; dt < 4; ++dt)
#pragma unroll
                    for (int i = 0; i < 16; ++i) { o[dt][i] *= qdec; ss += o[dt][i] * o[dt][i]; }
                ss += __shfl_xor(ss, 32);
                const float rs = rsqrtf(ss * (1.f / 128.f) + EPS);
                const size_t row = rowb + tq + r;
#pragma unroll
                for (int dt = 0; dt < 4; ++dt)
#pragma unroll
                    for (int i4 = 0; i4 < 4; ++i4) {
                        const int dv = dt * 32 + 8 * i4 + 4 * hh;
                        const u32x2 gv = *(const u32x2*)(Z0 + row * 2048 + 512 + h * 128 + dv);
                        const float g0 = bflo(gv.x), g1 = bfhi(gv.x), g2 = bflo(gv.y), g3 = bfhi(gv.y);
                        const float4 ng = *(const float4*)(P.ab_ret_norm_g + h * 128 + dv);
                        const float y0 = o[dt][i4 * 4 + 0] * rs * ng.x * (g0 * sigmoidf_(g0));
                        const float y1 = o[dt][i4 * 4 + 1] * rs * ng.y * (g1 * sigmoidf_(g1));
                        const float y2 = o[dt][i4 * 4 + 2] * rs * ng.z * (g2 * sigmoidf_(g2));
                        const float y3 = o[dt][i4 * 4 + 3] * rs * ng.w * (g3 * sigmoidf_(g3));
                        u32x2 ov = {pk2(y0, y1), pk2(y2, y3)};
                        *(u32x2*)(MIX + row * 1024 + h * 128 + dv) = ov;
                    }
            } else {
                const int v = u - 2048;
                const int qt = v & 1, c = (v >> 1) & 63, bh = v >> 7, b = bh >> 2, h = bh & 3, t0 = c * 64, tq = t0 + qt * 32;
                const size_t rowb = (size_t)b * 4096;
                const size_t row = rowb + tq + r;
                const float mc = MS[bh * 64 + c];
                const float Ml = fmaxf(mc, PM[bh * 4096 + tq + r]);
                const float bl = BL[bh * 4096 + tq + r];
                const float wint = __expf(mc - Ml);
                bf16x8 bq[4];
#pragma unroll
                for (int st = 0; st < 4; ++st) bq[st] = ld16(QM + row * 256 + h * 64 + 16 * st + 8 * hh);
                const u16* ct = CT + (size_t)(bh * 64 + c) * 8192;
#pragma unroll
                for (int dt = 0; dt < 4; ++dt) {
                    o[dt] = zero16();
#pragma unroll
                    for (int st = 0; st < 4; ++st) o[dt] = MFMA(ld16(ct + (dt * 32 + r) * 64 + 16 * st + 8 * hh), bq[st], o[dt]);
#pragma unroll
                    for (int i = 0; i < 16; ++i) o[dt][i] *= wint;
                }
                float qn = 0.f;
                {
                    const u16* qp = QM + row * 256 + h * 64 + 32 * hh;
                    const float* np = NS + (size_t)(bh * 64 + c) * 64 + 32 * hh;
#pragma unroll
                    for (int j = 0; j < 32; ++j) qn += bf2f(qp[j]) * np[j];
                    qn += __shfl_xor(qn, 32);
                }
                float den = 0.f;
                for (int kt = 0; kt <= qt; ++kt) {
                    f32x16 s = zero16();
#pragma unroll
                    for (int st = 0; st < 4; ++st) s = MFMA(ld16(KM + (rowb + t0 + kt * 32 + r) * 256 + h * 64 + 16 * st + 8 * hh), bq[st], s);
#pragma unroll
                    for (int i4 = 0; i4 < 4; ++i4) {
                        const float4 gg = *(const float4*)(GS + bh * 4096 + t0 + kt * 32 + 8 * i4 + 4 * hh);
                        const float ga[4] = {gg.x, gg.y, gg.z, gg.w};
#pragma unroll
                        for (int j = 0; j < 4; ++j) {
                            const int i = i4 * 4 + j;
                            float d = __expf(ga[j] - Ml);
                            if (kt == qt && crow(i, hh) > r) d = 0.f;
                            s[i] *= d; den += s[i];
                        }
                    }
#pragma unroll
                    for (int s2 = 0; s2 < 2; ++s2) {
                        const bf16x8 pb = packp(s, s2);
#pragma unroll
                        for (int dt = 0; dt < 4; ++dt) {
                            const u16* vp = VT0 + ((size_t)(b * 1024 + 512 + h * 128 + dt * 32 + r)) * 4096 + t0 + kt * 32 + 16 * s2 + 4 * hh;
                            o[dt] = MFMA(ld8x2(vp, vp + 8), pb, o[dt]);
                        }
                    }
                }
                den += __shfl_xor(den, 32);
                den += wint * qn;
                const float dinv = 1.f / fmaxf(fabsf(den), __expf(-(bl + Ml)));
                float ss = 0.f;
#pragma unroll
                for (int dt = 0; dt < 4; ++dt)
#pragma unroll
                    for (int i = 0; i < 16; ++i) { o[dt][i] *= dinv; ss += o[dt][i] * o[dt][i]; }
                ss += __shfl_xor(ss, 32);
                const float rs = rsqrtf(ss * (1.f / 128.f) + EPS);
#pragma unroll
                for (int dt = 0; dt < 4; ++dt)
#pragma unroll
                    for (int i4 = 0; i4 < 4; ++i4) {
                        const int dv = dt * 32 + 8 * i4 + 4 * hh;
                        const u32x2 gv = *(const u32x2*)(Z0 + row * 2048 + 1536 + h * 128 + dv);
                        const float4 ng = *(const float4*)(P.ab_m_norm_g + h * 128 + dv);
                        const float y0 = o[dt][i4 * 4 + 0] * rs * ng.x * sigmoidf_(bflo(gv.x));
                        const float y1 = o[dt][i4 * 4 + 1] * rs * ng.y * sigmoidf_(bfhi(gv.x));
                        const float y2 = o[dt][i4 * 4 + 2] * rs * ng.z * sigmoidf_(bflo(gv.y));
                        const float y3 = o[dt][i4 * 4 + 3] * rs * ng.w * sigmoidf_(bfhi(gv.y));
                        u32x2 ov = {pk2(y0, y1), pk2(y2, y3)};
                        *(u32x2*)(MIX + row * 1024 + 512 + h * 128 + dv) = ov;
                    }
            }
        }
    };

    auto resid_gemm = [&](const u16* A, int lda, const u16* Wt, int K, const float* resid, u16* hb_out, u64* ss_out, float scale) __attribute__((always_inline)) {
        for (int tile = blk; tile < tile_bound(128, 8); tile += nblk) {
            int mt, nt; if (!tile_decode(tile, 128, 8, mt, nt)) continue;
            const int m0 = mt * 128, n0 = nt * 128;
            f32x16 acc[2][2];
            const u16* Ab = A + (size_t)m0 * lda;
            gemm_main<false>(acc, [&](int row) { return Ab + (size_t)row * lda; }, 1, Wt, K, n0, K, As, Bs);
            const size_t rbase = (size_t)(m0 + wm * 64 + 4 * hh) * 1024 + n0 + wn * 64 + r;
            float rv[2][2][16];
#pragma unroll
            for (int mi = 0; mi < 2; ++mi)
#pragma unroll
                for (int ni = 0; ni < 2; ++ni)
#pragma unroll
                    for (int i = 0; i < 16; ++i) rv[mi][ni][i] = resid[rbase + (size_t)(mi * 32 + (i & 3) + 8 * (i >> 2)) * 1024 + ni * 32];
            float sqv[2][16];
#pragma unroll
            for (int mi = 0; mi < 2; ++mi)
#pragma unroll
                for (int i = 0; i < 16; ++i) {
                    float sq = 0.f;
#pragma unroll
                    for (int ni = 0; ni < 2; ++ni) {
                        const size_t o = rbase + (size_t)(mi * 32 + (i & 3) + 8 * (i >> 2)) * 1024 + ni * 32;
                        const float hv = rv[mi][ni][i] + scale * acc[mi][ni][i];
                        P.out[o] = hv;
                        if (hb_out) hb_out[o] = f2bf(hv);
                        sq += hv * hv;
                    }
                    sqv[mi][i] = sq;
                }
            if (ss_out) {
#pragma unroll
                for (int mi = 0; mi < 2; ++mi)
#pragma unroll
                    for (int i = 0; i < 16; ++i) {
                        const float s = red32(sqv[mi][i]);
                        if (r == 0) atomicAdd(ss_out + (m0 + wm * 64 + mi * 32 + crow(i, hh)), ss_fix(s));
                    }
            }
        }
    };
    auto ffn_up_phase = [&](int li, const u16* hb, const u64* ss_in, u64* sse, bool do_ss) __attribute__((always_inline)) {
        const u16* Wt = (const u16*)(ws + O_WUP + li * SZ_WUP);
        const u16* Wp = (const u16*)(ws + O_WPLE + li * SZ_WPLE);
        u16* ACT = (u16*)(ws + O_ACT);
        u16* ERAW = (u16*)(ws + O_ERAW);
        const float* cw = P.ffn_conv_w + li * 3 * 2816;
        const float* cb = P.ffn_conv_b + li * 2816;
        const float* pin = P.p + (size_t)li * MT * 256;
        u16* SA = (u16*)smem;
        u16* SB = SA + 128 * 66;
        for (int pass = 0; pass < 2; ++pass)
        for (int tile = blk; tile < (pass ? tile_bound(128, 8) : tile_bound(132, 44)); tile += nblk) {
            f32x16 acc[2][2];
            int mt, nt; if (!tile_decode(tile, pass ? 128 : 132, pass ? 8 : 44, mt, nt)) continue;
            if (pass == 0) {
                const int b = mt / 33, jt = mt % 33, tok0 = jt * 126 - 2, n0 = nt * 128;
                const u16* Ab = hb + (size_t)b * 4096 * DM;
                gemm_main<false>(acc, [&](int row) { int tk = tok0 + row; tk = tk < 0 ? 0 : (tk > 4095 ? 4095 : tk); return Ab + (size_t)tk * DM; }, 1, Wt, 1024, n0, 1024, As, Bs);
                __syncthreads();
#pragma unroll
                for (int mi = 0; mi < 2; ++mi)
#pragma unroll
                    for (int i = 0; i < 16; ++i) {
                        const int rl = wm * 64 + mi * 32 + crow(i, hh);
                        const int tok = tok0 + rl;
                        const int tkc = tok < 0 ? 0 : (tok > 4095 ? 4095 : tok);
                        const float rs = ss_rstd(ss_in[b * 4096 + tkc]);
#pragma unroll
                        for (int ni = 0; ni < 2; ++ni) {
                            float v = acc[mi][ni][i] * rs;
                            if (tok < 0) v = 0.f;
                            (wn == 0 ? SA : SB)[rl * 66 + ni * 32 + r] = f2bf(v);
                        }
                    }
                __syncthreads();
                for (int e = tid; e < 126 * 64; e += 256) {
                    const int rl = 2 + (e >> 6), cl = e & 63, tok = tok0 + rl;
                    if (tok < 4096) {
                        const int f = nt * 64 + cl;
                        const float a = cb[f] + cw[f] * bf2f(SA[(rl - 2) * 66 + cl]) + cw[2816 + f] * bf2f(SA[(rl - 1) * 66 + cl]) + cw[5632 + f] * bf2f(SA[rl * 66 + cl]);
                        ACT[((size_t)b * 4096 + tok) * 2816 + f] = f2bf(gelu_tanh(a) * bf2f(SB[rl * 66 + cl]));
                    }
                }
            } else {
                const int m0 = mt * 128, n0 = nt * 128;
                const float* Ab = pin + (size_t)m0 * 256;
                gemm_main<true>(acc, [&](int row) { return Ab + (size_t)row * 256; }, 1, Wp, 256, n0, 256, As, Bs);
#pragma unroll
                for (int mi = 0; mi < 2; ++mi)
#pragma unroll
                    for (int i = 0; i < 16; ++i) {
                        const size_t row = m0 + wm * 64 + mi * 32 + crow(i, hh);
                        float sq = 0.f;
#pragma unroll
                        for (int ni = 0; ni < 2; ++ni) {
                            const int col = n0 + wn * 64 + ni * 32 + r;
                            const float v = acc[mi][ni][i];
                            ERAW[row * 1024 + col] = f2bf(v);
                            sq += v * v;
                        }
                        sq = red32(sq); if (do_ss && r == 0) atomicAdd(sse + row, ss_fix(sq));
                    }
            }
        }
    };
    auto gate_phase = [&](int li, const u16* hb, const u64* ss_in, const u64* sse, u16* hb_out, u64* ss_out, float scale) __attribute__((always_inline)) {
        const u16* Wt = (const u16*)(ws + O_WGATE + li * SZ_WGATE);
        const u16* ERAW = (const u16*)(ws + O_ERAW);
        const float* eg = P.ple_norm_g + li * 1024;
        for (int tile = blk; tile < tile_bound(128, 8); tile += nblk) {
            int mt, nt; if (!tile_decode(tile, 128, 8, mt, nt)) continue;
            const int m0 = mt * 128, n0 = nt * 128;
            f32x16 acc[2][2];
            const u16* Ab = hb + (size_t)m0 * DM;
            gemm_main<false>(acc, [&](int row) { return Ab + (size_t)row * DM; }, 1, Wt, 1024, n0, 1024, As, Bs);
            const size_t rbase = (size_t)(m0 + wm * 64 + 4 * hh) * 1024 + n0 + wn * 64 + r;
            float ov[2][2][16], ev[2][2][16], rsv[2][16], rev[2][16];
#pragma unroll
            for (int mi = 0; mi < 2; ++mi)
#pragma unroll
                for (int i = 0; i < 16; ++i) {
                    const int row = m0 + wm * 64 + mi * 32 + crow(i, hh);
                    rsv[mi][i] = ss_rstd(ss_in[row]);
                    rev[mi][i] = ss_rstd(sse[row]);
#pragma unroll
                    for (int ni = 0; ni < 2; ++ni) {
                        const size_t o = rbase + (size_t)(mi * 32 + (i & 3) + 8 * (i >> 2)) * 1024 + ni * 32;
                        ov[mi][ni][i] = P.out[o];
                        ev[mi][ni][i] = bf2f(ERAW[o]);
                    }
                }
            const float eg0 = eg[n0 + wn * 64 + r], eg1 = eg[n0 + wn * 64 + 32 + r];
            float sqv[2][16];
#pragma unroll
            for (int mi = 0; mi < 2; ++mi)
#pragma unroll
                for (int i = 0; i < 16; ++i) {
                    float sq = 0.f;
#pragma unroll
                    for (int ni = 0; ni < 2; ++ni) {
                        const size_t o = rbase + (size_t)(mi * 32 + (i & 3) + 8 * (i >> 2)) * 1024 + ni * 32;
                        const float gt = sigmoidf_(acc[mi][ni][i] * rsv[mi][i]);
                        const float e = ev[mi][ni][i] * rev[mi][i] * (ni ? eg1 : eg0);
                        const float hv = ov[mi][ni][i] + scale * gt * e;
                        P.out[o] = hv;
                        if (hb_out) hb_out[o] = f2bf(hv);
                        sq += hv * hv;
                    }
                    sqv[mi][i] = sq;
                }
            if (ss_out) {
#pragma unroll
                for (int mi = 0; mi < 2; ++mi)
#pragma unroll
                    for (int i = 0; i < 16; ++i) {
                        const float s = red32(sqv[mi][i]);
                        if (r == 0) atomicAdd(ss_out + (m0 + wm * 64 + mi * 32 + crow(i, hh)), ss_fix(s));
                    }
            }
        }
    };

    auto ph_6 = [&](bool dry) __attribute__((always_inline)) { if (!dry) resid_gemm(HB0, 1024, (const u16*)(ws + O_WABOUT), 1024, P.x, HB1, SS + 1 * MT, 1.f); else resid_gemm(HB0, 1024, (const u16*)(ws + O_WABOUT), 1024, P.out, (u16*)nullptr, (u64*)nullptr, 0.f); };
    auto ph_7 = [&](bool dry) __attribute__((always_inline)) { ffn_up_phase(0, HB1, SS + 1 * MT, SS + 6 * MT, !dry); };
    auto ph_8 = [&](bool dry) __attribute__((always_inline)) { if (!dry) resid_gemm((const u16*)(ws + O_ACT), 2816, (const u16*)(ws + O_WDOWN), 2816, P.out, HB0, SS + 2 * MT, 1.f); else resid_gemm((const u16*)(ws + O_ACT), 2816, (const u16*)(ws + O_WDOWN), 2816, P.out, (u16*)nullptr, (u64*)nullptr, 0.f); };
    auto ph_9 = [&](bool dry) __attribute__((always_inline)) { if (!dry) gate_phase(0, HB0, SS + 2 * MT, SS + 6 * MT, HB1, SS + 3 * MT, 1.f); else gate_phase(0, HB0, SS + 2 * MT, SS + 6 * MT, (u16*)nullptr, (u64*)nullptr, 0.f); };

    auto ph_10 = [&]() __attribute__((always_inline)) {
        const u16* Wt = (const u16*)(ws + O_WNSAIN);
        u16* QN = (u16*)(ws + O_QN); u16* KCVC = (u16*)(ws + O_KCVC); u16* KSN = (u16*)(ws + O_KSN); u16* KWN = (u16*)(ws + O_KWN);
        u16* VST = (u16*)(ws + O_VST); u16* VWT = (u16*)(ws + O_VWT); float* GT1 = (float*)(ws + O_GT1);
        const u64* ssin = SS + 3 * MT;
        for (int tile = blk; tile < tile_bound(128, 15); tile += nblk) {
            int mt, nt; if (!tile_decode(tile, 128, 15, mt, nt)) continue;
            const int m0 = mt * 128, n0 = nt * 128;
            f32x16 acc[2][2];
            const u16* Ab = HB1 + (size_t)m0 * DM;
            gemm_main<false>(acc, [&](int row) { return Ab + (size_t)row * DM; }, 1, Wt, 1024, n0, 1024, As, Bs);
            const int colw = n0 + wn * 64;
            float rsv[2][16];
#pragma unroll
            for (int mi = 0; mi < 2; ++mi)
#pragma unroll
                for (int i = 0; i < 16; ++i) rsv[mi][i] = ss_rstd(ssin[m0 + wm * 64 + mi * 32 + crow(i, hh)]);
#pragma unroll
            for (int mi = 0; mi < 2; ++mi) {
#pragma unroll
                for (int i4 = 0; i4 < 4; ++i4) {
                    float v0[4], v1[4];
                    const int rowb = m0 + wm * 64 + mi * 32 + 8 * i4 + 4 * hh;
#pragma unroll
                    for (int j = 0; j < 4; ++j) {
                        const float rs = rsv[mi][i4 * 4 + j];
                        v0[j] = acc[mi][0][i4 * 4 + j] * rs;
                        v1[j] = acc[mi][1][i4 * 4 + j] * rs;
                    }
                    const int bb = rowb >> 12, t = rowb & 4095;
                    if (nt < 8 || nt == 10 || nt == 12) {
                        const float* gn = (nt < 8) ? P.nsa_q_norm_g : (nt == 10 ? P.nsa_k_norm_g + 64 : P.nsa_k_norm_g + 128);
                        const float g0 = gn[r], g1 = gn[32 + r];
                        const float sc = (nt < 8) ? 0.125f * 1.4426950408889634f : 1.f;
#pragma unroll
                        for (int j = 0; j < 4; ++j) {
                            const float ss = red32(v0[j] * v0[j] + v1[j] * v1[j]);
                            const float rn = rsqrtf(ss * (1.f / 64.f) + EPS) * sc;
                            const u16 y0 = f2bf(v0[j] * rn * g0), y1 = f2bf(v1[j] * rn * g1);
                            if (nt < 8) { QN[(size_t)(rowb + j) * 1024 + colw + r] = y0; QN[(size_t)(rowb + j) * 1024 + colw + 32 + r] = y1; }
                            else {
                                u16* dst = (nt == 10) ? KSN : KWN;
                                dst[(size_t)(rowb + j) * 128 + wn * 64 + r] = y0; dst[(size_t)(rowb + j) * 128 + wn * 64 + 32 + r] = y1;
                            }
                        }
                    } else if (nt == 8 || nt == 9) {
                        const int cc = (nt - 8) * 128 + wn * 64;
#pragma unroll
                        for (int j = 0; j < 4; ++j) {
                            KCVC[(size_t)(rowb + j) * 256 + cc + r] = f2bf(v0[j]);
                            KCVC[(size_t)(rowb + j) * 256 + cc + 32 + r] = f2bf(v1[j]);
                        }
                    } else if (nt == 11 || nt == 13) {
                        u16* dst = (nt == 11) ? VST : VWT;
                        u32x2 o0 = {pk2(v0[0], v0[1]), pk2(v0[2], v0[3])}, o1 = {pk2(v1[0], v1[1]), pk2(v1[2], v1[3])};
                        *(u32x2*)(dst + ((size_t)(bb * 128 + wn * 64 + r)) * 4096 + t) = o0;
                        *(u32x2*)(dst + ((size_t)(bb * 128 + wn * 64 + 32 + r)) * 4096 + t) = o1;
                    } else {
                        if (wn == 0) {
#pragma unroll
                            for (int j = 0; j < 4; ++j) {
                                GT1[(size_t)(rowb + j) * 48 + r] = sigmoidf_(v0[j] + P.nsa_gate_b[r]);
                                if (r < 16) GT1[(size_t)(rowb + j) * 48 + 32 + r] = sigmoidf_(v1[j] + P.nsa_gate_b[32 + r]);
                            }
                        }
                    }
                }
            }
        }
    };

    auto ph_11 = [&]() __attribute__((always_inline)) {
        const u16* KCVC = (const u16*)(ws + O_KCVC);
        u16* HID = (u16*)(ws + O_HID);
        const float* B1 = (const float*)(ws + O_BIAS1);
        for (int tile = RB(5, blk, nblk); tile < 64; tile += RS(5, nblk)) {
            const int kv = tile >> 5, mt = (tile >> 1) & 15, nt = tile & 1, m0 = mt * 128, n0 = nt * 128;
            const u16* Wt = (const u16*)(ws + (kv ? O_WC1V : O_WC1K));
            f32x16 acc[2][2];
            gemm_main<false>(acc, [&](int row) {
                int R = m0 + row; R = R > 2039 ? 2039 : R;
                const int bg = R / 255, n = R - bg * 255, b = bg >> 1, g = bg & 1;
                return KCVC + ((size_t)b * 4096 + 16 * n) * 256 + kv * 128 + g * 64;
            }, 4, Wt, 2048, n0, 2048, As, Bs);
#pragma unroll
            for (int mi = 0; mi < 2; ++mi)
#pragma unroll
                for (int i = 0; i < 16; ++i) {
                    const int R = m0 + wm * 64 + mi * 32 + crow(i, hh);
#pragma unroll
                    for (int ni = 0; ni < 2; ++ni) {
                        const int col = n0 + wn * 64 + ni * 32 + r;
                        if (R < 2040) HID[((size_t)kv * 2048 + R) * 256 + col] = f2bf(gelu_tanh(acc[mi][ni][i] + B1[kv * 256 + col]));
                    }
                }
        }
    };

    auto ph_12 = [&]() __attribute__((always_inline)) {
        const u16* HID = (const u16*)(ws + O_HID);
        u16* KCN = (u16*)(ws + O_KCN);
        u16* VCT = (u16*)(ws + O_VCT);
        for (int tile = RB(6, blk, nblk); tile < 32; tile += RS(6, nblk)) {
            const int kv = tile >> 4, mt = tile & 15, m0 = mt * 128;
            const u16* Wt = (const u16*)(ws + (kv ? O_WC2V : O_WC2K));
            const u16* Ab = HID + ((size_t)kv * 2048 + m0) * 256;
            f32x16 acc[2][2];
            gemm_main<false>(acc, [&](int row) { return Ab + (size_t)row * 256; }, 1, Wt, 256, 0, 256, As, Bs);
            if (wn == 0) {
#pragma unroll
                for (int mi = 0; mi < 2; ++mi)
#pragma unroll
                    for (int i = 0; i < 16; ++i) {
                        const int R = m0 + wm * 64 + mi * 32 + crow(i, hh);
                        const float v0 = acc[mi][0][i], v1 = acc[mi][1][i];
                        const float ss = red32(v0 * v0 + v1 * v1);
                        if (R < 2040) {
                            const int bg = R / 255, n = R - bg * 255;
                            if (kv == 0) {
                                const float rn = rsqrtf(ss * (1.f / 64.f) + EPS);
                                KCN[((size_t)bg * 256 + n) * 64 + r] = f2bf(v0 * rn * P.nsa_k_norm_g[r]);
                                KCN[((size_t)bg * 256 + n) * 64 + 32 + r] = f2bf(v1 * rn * P.nsa_k_norm_g[32 + r]);
                            } else {
                                VCT[((size_t)bg * 64 + r) * 256 + n] = f2bf(v0);
                                VCT[((size_t)bg * 64 + 32 + r) * 256 + n] = f2bf(v1);
                            }
                        }
                    }
            }
        }
        for (int u = gtid; u < 8 * 64; u += gsz) { KCN[((size_t)(u >> 6) * 256 + 255) * 64 + (u & 63)] = 0; VCT[((size_t)u) * 256 + 255] = 0; }
    };

    auto ph_13 = [&]() __attribute__((always_inline)) {
        const u16* QN = (const u16*)(ws + O_QN);
        const u16* KCN = (const u16*)(ws + O_KCN);
        const u16* VCT = (const u16*)(ws + O_VCT);
        const float* GT1 = (const float*)(ws + O_GT1);
        u16* OCMP = (u16*)(ws + O_OCMP);
        u64* SEL = (u64*)(ws + O_SEL);
        float* sc_lds = (float*)smem + wave * (32 * 65);
        float mbound4;
        {
            float gq = fabsf(P.nsa_q_norm_g[lane]), gk = fabsf(P.nsa_k_norm_g[lane]);
#pragma unroll
            for (int off = 1; off < 64; off <<= 1) { gq = fmaxf(gq, __shfl_xor(gq, off)); gk = fmaxf(gk, __shfl_xor(gk, off)); }
            mbound4 = 8.f * 1.4426950408889634f * gq * gk * 1.02f;
        }
        for (int u0 = blk * 4; u0 < 1024; u0 += nblk * 4) {
            const int u = u0 + wave;
            const int qt = u & 127, bg = u >> 7, b = bg >> 1, g = bg & 1, tq = qt * 32, t = tq + r;
            const size_t row = (size_t)b * 4096 + t;
            const int nkt = (tq >> 9) + 1;
            u16* kl = (u16*)smem;
            u16* vl = kl + 256 * 72;
            __syncthreads();
#pragma unroll
            for (int c8 = 0; c8 < 8; ++c8) {
                const int c = tid + 256 * c8;
                *(u32x4*)(kl + (c >> 3) * 72 + (c & 7) * 8) = *(const u32x4*)(KCN + ((size_t)bg * 256 + (c >> 3)) * 64 + (c & 7) * 8);
                *(u32x4*)(vl + (c >> 5) * 264 + (c & 31) * 8) = *(const u32x4*)(VCT + ((size_t)bg * 64 + (c >> 5)) * 256 + (c & 31) * 8);
            }
            __syncthreads();
            f32x16 imp[2];
            imp[0] = zero16(); imp[1] = zero16();
            for (int hg = 0; hg < 8; ++hg) {
                const int head = g * 8 + hg;
                bf16x8 bq[4];
#pragma unroll
                for (int st = 0; st < 4; ++st) bq[st] = ld16(QN + row * 1024 + head * 64 + 16 * st + 8 * hh);
                f32x16 ao[2], ih[2];
                ao[0] = zero16(); ao[1] = zero16(); ih[0] = zero16(); ih[1] = zero16();
                float l = 0.f;
                for (int kt = 0; kt < nkt; ++kt) {
                    f32x16 s = zero16();
#pragma unroll
                    for (int st = 0; st < 4; ++st) s = MFMA(ld16(kl + (kt * 32 + r) * 72 + 16 * st + 8 * hh), bq[st], s);
#pragma unroll
                    for (int i = 0; i < 16; ++i) {
                        const int n = kt * 32 + crow(i, hh);
                        s[i] = (16 * n + 31 > t) ? 0.f : __builtin_amdgcn_exp2f(s[i] - mbound4);
                        l += s[i];
                    }
#pragma unroll
                    for (int s2 = 0; s2 < 2; ++s2) {
                        const bf16x8 pb = packp(s, s2);
#pragma unroll
                        for (int dt = 0; dt < 2; ++dt) {
                            const u16* vp = vl + (dt * 32 + r) * 264 + kt * 32 + 16 * s2 + 4 * hh;
                            ao[dt] = MFMA(ld8x2(vp, vp + 8), pb, ao[dt]);
                        }
#pragma unroll
                        for (int bt = 0; bt < 2; ++bt) {
                            const int sb = bt * 32 + r;
                            bf16x8 ov;
#pragma unroll
                            for (int j = 0; j < 8; ++j) {
                                const int n = kt * 32 + 16 * s2 + 8 * (j >> 2) + 4 * hh + (j & 3);
                                ov[j] = (n >= 4 * sb - 1 && n <= 4 * sb + 3) ? (short)0x3F80 : (short)0;
                            }
                            ih[bt] = MFMA(ov, pb, ih[bt]);
                        }
                    }
                }
                l += __shfl_xor(l, 32);
                const float inv = (t >= 31) ? 1.f / l : 0.f;
#pragma unroll
                for (int bt = 0; bt < 2; ++bt)
#pragma unroll
                    for (int i = 0; i < 16; ++i) imp[bt][i] += ih[bt][i] * inv;
                const float g0 = GT1[row * 48 + head * 3 + 0] * inv;
#pragma unroll
                for (int dt = 0; dt < 2; ++dt)
#pragma unroll
                    for (int i4 = 0; i4 < 4; ++i4) {
                        const int d = dt * 32 + 8 * i4 + 4 * hh;
                        u32x2 ov = {pk2(ao[dt][i4 * 4 + 0] * g0, ao[dt][i4 * 4 + 1] * g0), pk2(ao[dt][i4 * 4 + 2] * g0, ao[dt][i4 * 4 + 3] * g0)};
                        *(u32x2*)(OCMP + row * 1024 + head * 64 + d) = ov;
                    }
            }
            const int cur = t >> 6;
            __syncthreads();
#pragma unroll
            for (int bt = 0; bt < 2; ++bt)
#pragma unroll
                for (int i = 0; i < 16; ++i) {
                    const int sb = bt * 32 + crow(i, hh);
                    const bool forced = (sb == 0) || (sb == cur) || (sb == cur - 1);
                    const float sc = forced ? 1e30f : (sb <= cur ? imp[bt][i] : -1e30f);
                    sc_lds[r * 65 + sb] = sc;
                }
            __syncthreads();
            for (int q = 0; q < 32; ++q) {
                const float v = sc_lds[q * 65 + lane];
                int cnt = 0;
                for (int sp = 0; sp < 64; ++sp) {
                    const float c = __shfl(v, sp);
                    cnt += ((c > v) || (c == v && sp < lane)) ? 1 : 0;
                }
                const u64 mask = __ballot(cnt < 16);
                if (lane == 0) SEL[(size_t)bg * 4096 + tq + q] = mask;
            }
        }
        __syncthreads();
    };

    auto ph_14 = [&]() __attribute__((always_inline)) {
        const u16* QN = (const u16*)(ws + O_QN);
        const u16* KSN = (const u16*)(ws + O_KSN); const u16* KWN = (const u16*)(ws + O_KWN);
        const u16* VST = (const u16*)(ws + O_VST); const u16* VWT = (const u16*)(ws + O_VWT);
        const float* GT1 = (const float*)(ws + O_GT1);
        const u16* OCMP = (const u16*)(ws + O_OCMP);
        const u64* SEL = (const u64*)(ws + O_SEL);
        u16* OBUF = (u16*)(ws + O_OBUF);
        constexpr int KST = 72, VSTR = 40, BUFEL = 32 * KST + 64 * VSTR;
        float mbound;
        {
            float gq = fabsf(P.nsa_q_norm_g[lane]);
            float gk = fmaxf(fabsf(P.nsa_k_norm_g[64 + lane]), fabsf(P.nsa_k_norm_g[128 + lane]));
#pragma unroll
            for (int off = 1; off < 64; off <<= 1) { gq = fmaxf(gq, __shfl_xor(gq, off)); gk = fmaxf(gk, __shfl_xor(gk, off)); }
            mbound = 8.f * 1.4426950408889634f * gq * gk * 1.02f;
        }
        u16* stage = (u16*)smem;
        int* tl = (int*)(stage + 2 * BUFEL);
        for (int item = blk; item < 1024; item += nblk) {
            const int kk = item / nblk, v = item - kk * nblk;
            const int q0 = v & 127, bg = (nblk == 256) ? ((v >> 7) * 4 + kk) : (item >> 7);
            const int qt = (nblk == 256) ? ((kk & 1) ? 127 - q0 : q0) : (item & 127);
            const int b = bg >> 1, g = bg & 1, tq = qt * 32, t = tq + r;
            const size_t rowb = (size_t)b * 4096, row = rowb + t;
            const int h0 = g * 8 + wave * 2;
            bf16x8 bq[2][4];
#pragma unroll
            for (int hd = 0; hd < 2; ++hd)
#pragma unroll
                for (int st = 0; st < 4; ++st) bq[hd][st] = ld16(QN + row * 1024 + (h0 + hd) * 64 + 16 * st + 8 * hh);
            const u64 selm = SEL[(size_t)bg * 4096 + t];
            unsigned ulo = (unsigned)selm, uhi = (unsigned)(selm >> 32);
#pragma unroll
            for (int off = 1; off < 32; off <<= 1) { ulo |= __shfl_xor(ulo, off); uhi |= __shfl_xor(uhi, off); }
            const u64 uni = ((u64)uhi << 32) | ulo;
            __syncthreads();
            if (tid == 0) {
                int n = 0;
                for (int kt = (qt > 16 ? qt - 16 : 0); kt <= qt; ++kt) tl[n++] = kt | (1 << 16);
                const int jmax = (tq + 31) >> 6;
                for (int j = 0; j <= jmax; ++j)
                    if ((uni >> j) & 1ull) { tl[n++] = 2 * j; if ((2 * j + 1) * 32 <= tq + 31) tl[n++] = 2 * j + 1; }
                tl[159] = n;
            }
            __syncthreads();
            const int ntile = tl[159];
            u32x4 kr[3], vr[3];
            auto ldt = [&](u32x4& kreg, u32x4& vreg, int e) __attribute__((always_inline)) {
                const int kt = e & 0xffff, br = e >> 16;
                const u16* Kp = br ? KWN : KSN;
                const u16* Vp = br ? VWT : VST;
                kreg = *(const u32x4*)(Kp + (rowb + kt * 32 + (tid >> 3)) * 128 + g * 64 + (tid & 7) * 8);
                vreg = *(const u32x4*)(Vp + ((size_t)(b * 128 + g * 64 + (tid >> 2))) * 4096 + kt * 32 + (tid & 3) * 8);
            };
            auto stt = [&](const u32x4& kreg, const u32x4& vreg, int p) __attribute__((always_inline)) {
                u16* kb = stage + p * BUFEL;
                *(u32x4*)(kb + (tid >> 3) * KST + (tid & 7) * 8) = kreg;
                *(u32x4*)(kb + 32 * KST + (tid >> 2) * VSTR + (tid & 3) * 8) = vreg;
            };
            f32x16 res[2][2], ao[2][2];
#pragma unroll
            for (int hd = 0; hd < 2; ++hd)
#pragma unroll
                for (int dt = 0; dt < 2; ++dt) { res[hd][dt] = zero16(); ao[hd][dt] = zero16(); }
            float l[2] = {0.f, 0.f};
            int curbr = 1;
            auto finalize = [&](int br) __attribute__((always_inline)) {
#pragma unroll
                for (int hd = 0; hd < 2; ++hd) {
                    const float lt = l[hd] + __shfl_xor(l[hd], 32);
                    const float gsc = GT1[row * 48 + (h0 + hd) * 3 + 1 + br] / lt;
#pragma unroll
                    for (int dt = 0; dt < 2; ++dt)
#pragma unroll
                        for (int i = 0; i < 16; ++i) { res[hd][dt][i] += ao[hd][dt][i] * gsc; ao[hd][dt][i] = 0.f; }
                    l[hd] = 0.f;
                }
            };
            ldt(kr[0], vr[0], tl[0]);
            if (1 < ntile) ldt(kr[1], vr[1], tl[1]);
            if (2 < ntile) ldt(kr[2], vr[2], tl[2]);
            stt(kr[0], vr[0], 0);
            if (3 < ntile) ldt(kr[0], vr[0], tl[3]);
            __syncthreads();
            for (int it0 = 0; it0 < ntile; it0 += 6) {
#pragma unroll
            for (int uu = 0; uu < 6; ++uu) {
                const int it = it0 + uu;
                if (it < ntile) {
                const int e = tl[it], kt = e & 0xffff, br = e >> 16, p = uu & 1;
                if (br != curbr) { finalize(curbr); curbr = br; }
                const u16* kb = stage + p * BUFEL;
                const u16* vb = kb + 32 * KST;
                f32x16 s[2];
                s[0] = zero16(); s[1] = zero16();
#pragma unroll
                for (int st = 0; st < 4; ++st) {
                    const bf16x8 a = *(const bf16x8*)(kb + r * KST + 16 * st + 8 * hh);
                    s[0] = MFMA(a, bq[0][st], s[0]);
                    s[1] = MFMA(a, bq[1][st], s[1]);
                }
                const bool bsel = br ? true : (((selm >> (kt >> 1)) & 1ull) != 0);
                const bool interior = (kt * 32 + 31 <= tq) && (!br || kt * 32 >= tq - 480);
                const bool needmask = !interior || (__ballot(!bsel) != 0ull);
                if (needmask) {
#pragma unroll
                    for (int i = 0; i < 16; ++i) {
                        const int pk = kt * 32 + crow(i, hh);
                        bool ok = bsel && (pk <= t);
                        if (br) ok = ok && (pk > t - 512);
                        if (!ok) { s[0][i] = -1e30f; s[1][i] = -1e30f; }
                    }
                }
#pragma unroll
                for (int hd = 0; hd < 2; ++hd) {
                    float ps = 0.f;
#pragma unroll
                    for (int i = 0; i < 16; ++i) { s[hd][i] = __builtin_amdgcn_exp2f(s[hd][i] - mbound); ps += s[hd][i]; }
                    l[hd] += ps;
                }
#pragma unroll
                for (int s2 = 0; s2 < 2; ++s2) {
                    const bf16x8 pb0 = packp(s[0], s2), pb1 = packp(s[1], s2);
#pragma unroll
                    for (int dt = 0; dt < 2; ++dt) {
                        const u16* vp = vb + (dt * 32 + r) * VSTR + 16 * s2 + 4 * hh;
                        const bf16x8 av = ld8x2(vp, vp + 8);
                        ao[0][dt] = MFMA(av, pb0, ao[0][dt]);
                        ao[1][dt] = MFMA(av, pb1, ao[1][dt]);
                    }
                }
                if (it + 1 < ntile) {
                    stt(kr[(uu + 1) % 3], vr[(uu + 1) % 3], p ^ 1);
                    if (it + 4 < ntile) ldt(kr[(uu + 1) % 3], vr[(uu + 1) % 3], tl[it + 4]);
                }
                __syncthreads();
                }
            }
            }
            finalize(curbr);
#pragma unroll
            for (int hd = 0; hd < 2; ++hd)
#pragma unroll
                for (int dt = 0; dt < 2; ++dt)
#pragma unroll
                    for (int i4 = 0; i4 < 4; ++i4) {
                        const int d = dt * 32 + 8 * i4 + 4 * hh;
                        const u32x2 oc = *(const u32x2*)(OCMP + row * 1024 + (h0 + hd) * 64 + d);
                        u32x2 ov = {pk2(res[hd][dt][i4 * 4 + 0] + bflo(oc.x), res[hd][dt][i4 * 4 + 1] + bfhi(oc.x)),
                                    pk2(res[hd][dt][i4 * 4 + 2] + bflo(oc.y), res[hd][dt][i4 * 4 + 3] + bfhi(oc.y))};
                        *(u32x2*)(OBUF + row * 1024 + (h0 + hd) * 64 + d) = ov;
                    }
        }
        __syncthreads();
    };

    auto ph_15 = [&](bool dry) __attribute__((always_inline)) { if (!dry) resid_gemm((const u16*)(ws + O_OBUF), 1024, (const u16*)(ws + O_WNSAOUT), 1024, P.out, HB0, SS + 4 * MT, 1.f); else resid_gemm((const u16*)(ws + O_OBUF), 1024, (const u16*)(ws + O_WNSAOUT), 1024, P.out, (u16*)nullptr, (u64*)nullptr, 0.f); };
    auto ph_16 = [&](bool dry) __attribute__((always_inline)) { ffn_up_phase(1, HB0, SS + 4 * MT, SS + 7 * MT, !dry); };
    auto ph_17 = [&](bool dry) __attribute__((always_inline)) { if (!dry) resid_gemm((const u16*)(ws + O_ACT), 2816, (const u16*)(ws + O_WDOWN + SZ_WDOWN), 2816, P.out, HB1, SS + 5 * MT, 1.f); else resid_gemm((const u16*)(ws + O_ACT), 2816, (const u16*)(ws + O_WDOWN + SZ_WDOWN), 2816, P.out, (u16*)nullptr, (u64*)nullptr, 0.f); };
    auto ph_18 = [&](bool dry) __attribute__((always_inline)) { gate_phase(1, HB1, SS + 5 * MT, SS + 7 * MT, (u16*)nullptr, (u64*)nullptr, dry ? 0.f : 1.f); };
#define RUNA(k) do { if (PH(k)) ph_##k(); GSYNC(); if ((DUPMASK >> (k)) & 1) { ph_##k(); GSYNC(); } } while (0)
#define RUNB(k) do { if (PH(k)) ph_##k(false); GSYNC(); if ((DUPMASK >> (k)) & 1) { ph_##k(true); GSYNC(); } } while (0)
    RUNA(0); RUNA(1); RUNA(2); RUNA(3); RUNA(4); RUNA(5);
    RUNB(6); RUNB(7); RUNB(8); RUNB(9);
    RUNA(10); RUNA(11); RUNA(12); RUNA(13); RUNA(14);
    RUNB(15); RUNB(16); RUNB(17);
    if (PH(18)) ph_18(false);
    if ((DUPMASK >> 18) & 1) { GSYNC(); ph_18(true); }
}

extern "C" void kernel_launch(void* const* d_in, const int* in_sizes, int n_in, void* d_out, int out_size, void* d_ws, size_t ws_size, hipStream_t stream) {
    static int grid_blocks = 0;
    if (grid_blocks == 0) {
        if (n_in != 32 || out_size != MT * DM || ws_size < WS_NEED) {
            fprintf(stderr, "kernel_launch: unexpected problem (n_in %d, out %d, ws %zu)\n", n_in, out_size, ws_size);
            grid_blocks = -1;
            return;
        }
        int dev = 0, cus = 0, per_cu = 0;
        (void)hipGetDevice(&dev);
        (void)hipDeviceGetAttribute(&cus, hipDeviceAttributeMultiprocessorCount, dev);
        (void)hipOccupancyMaxActiveBlocksPerMultiprocessor(&per_cu, fwd_megakernel, 256, 0);
        if (per_cu < 1) per_cu = 1;
        if (per_cu > 1) per_cu = 1;
        grid_blocks = cus * per_cu;
    }
    if (grid_blocks < 0) return;
    Params p{};
    const float** pp = (const float**)&p;
    for (int i = 0; i < 32; ++i) pp[i] = (const float*)d_in[i];
    p.out = (float*)d_out;
    p.ws = (char*)d_ws;
    (void)hipMemsetAsync((char*)d_ws + O_BAR, 0, 16384, stream);
    void* args[] = {&p};
    hipError_t e = hipLaunchCooperativeKernel((void*)fwd_megakernel, dim3(grid_blocks), dim3(256), args, 0, stream);
    if (e != hipSuccess) fprintf(stderr, "cooperative launch failed: %s (grid %d)\n", hipGetErrorString(e), grid_blocks);
}
```

```cpp
#include <hip/hip_runtime.h>
#include <hip/hip_cooperative_groups.h>
#include <cstdio>
#include <type_traits>
namespace cg = cooperative_groups;

#define DI __device__ __forceinline__
typedef unsigned short u16;
typedef unsigned long long u64;
typedef __attribute__((ext_vector_type(8))) short bf16x8;
typedef __attribute__((ext_vector_type(16))) float f32x16;
typedef __attribute__((ext_vector_type(4))) unsigned u32x4;
typedef __attribute__((ext_vector_type(2))) unsigned u32x2;
#define MFMA(a, b, c) __builtin_amdgcn_mfma_f32_32x32x16_bf16((a), (b), (c), 0, 0, 0)

#ifndef USE_CG
#define USE_CG 0
#endif
#if USE_CG
#define GSYNC() grid.sync()
#else
#define GSYNC() ctr_barrier((unsigned*)(P.ws + O_BAR) + 4096 - 64, bar_gen)
#endif
#ifndef RESTRICT
#define RESTRICT 0
#endif
#define RB(k, id, n) ((((RESTRICT) >> (k)) & 1) && (n) > 256 ? ((id) < 256 ? (id) : 0x3fffffff) : (id))
#define RS(k, n) ((((RESTRICT) >> (k)) & 1) && (n) > 256 ? 256 : (n))
#ifndef P1REP
#define P1REP 1
#endif
#ifndef DUPMASK
#define DUPMASK 0
#endif
#ifndef XCD_CONSEC
#define XCD_CONSEC 1
#endif
#ifndef MINW
#define MINW 1
#endif
#ifndef ONLY
#define PH(k) true
#else
#define PH(k) ((ONLY) == (k))
#endif
constexpr int MT = 16384, DM = 1024, TS = 4096;
constexpr float EPS = 1e-6f;

constexpr size_t O_WABIN = 0;
constexpr size_t O_WABOUT = O_WABIN + 3200ull * 1024 * 2;
constexpr size_t O_WNSAIN = O_WABOUT + 1024ull * 1024 * 2;
constexpr size_t O_WC1K = O_WNSAIN + 1920ull * 1024 * 2;
constexpr size_t O_WC1V = O_WC1K + 256ull * 2048 * 2;
constexpr size_t O_WC2K = O_WC1V + 256ull * 2048 * 2;
constexpr size_t O_WC2V = O_WC2K + 128ull * 256 * 2;
constexpr size_t O_WNSAOUT = O_WC2V + 128ull * 256 * 2;
constexpr size_t O_WUP = O_WNSAOUT + 1024ull * 1024 * 2;
constexpr size_t SZ_WUP = 5632ull * 1024 * 2;
constexpr size_t O_WDOWN = O_WUP + 2 * SZ_WUP;
constexpr size_t SZ_WDOWN = 1024ull * 2816 * 2;
constexpr size_t O_WPLE = O_WDOWN + 2 * SZ_WDOWN;
constexpr size_t SZ_WPLE = 1024ull * 256 * 2;
constexpr size_t O_WGATE = O_WPLE + 2 * SZ_WPLE;
constexpr size_t SZ_WGATE = 1024ull * 1024 * 2;
constexpr size_t O_ROPEC = O_WGATE + 2 * SZ_WGATE;
constexpr size_t O_ROPES = O_ROPEC + 4096ull * 32 * 4;
constexpr size_t O_BIAS1 = O_ROPES + 4096ull * 32 * 4;
constexpr size_t O_BAR = O_BIAS1 + 4096;
constexpr size_t O_SS = O_BAR + 16384;
constexpr size_t O_HB0 = O_SS + 8ull * MT * 8;
constexpr size_t O_HB1 = O_HB0 + (size_t)MT * DM * 2;
constexpr size_t O_BIG = O_HB1 + (size_t)MT * DM * 2;
constexpr size_t O_VT0 = O_BIG;
constexpr size_t O_KT = O_VT0 + 4ull * 1024 * 4096 * 2;
constexpr size_t O_QM = O_KT + 4ull * 256 * 4096 * 2;
constexpr size_t O_KM = O_QM + (size_t)MT * 256 * 2;
constexpr size_t O_KWT = O_KM + (size_t)MT * 256 * 2;
constexpr size_t O_GS = O_KWT + 4ull * 256 * 4096 * 2;
constexpr size_t O_BL = O_GS + 16ull * 4096 * 4;
constexpr size_t O_PM = O_BL + 16ull * 4096 * 4;
constexpr size_t O_BLAST = O_PM + 16ull * 4096 * 4;
constexpr size_t O_GC = O_BLAST + 4096;
constexpr size_t O_MS = O_GC + 4096;
constexpr size_t O_NC = O_MS + 4096;
constexpr size_t O_NS = O_NC + 1024ull * 64 * 4;
constexpr size_t O_GF = O_NS + 1024ull * 64 * 4;
constexpr size_t O_KVT = O_GF + (size_t)MT * 8 * 4;
constexpr size_t O_RT = O_KVT + 512ull * 8192 * 4;
constexpr size_t O_UT = O_RT + 512ull * 8192 * 2;
constexpr size_t O_L0END = O_UT + 1024ull * 8192 * 4;
constexpr size_t O_CT = O_HB1;
constexpr size_t O_ACT = O_BIG;
constexpr size_t O_ERAW = O_ACT + (size_t)MT * 2816 * 2;
constexpr size_t O_FFNEND = O_ERAW + (size_t)MT * DM * 2;
constexpr size_t O_QN = O_BIG;
constexpr size_t O_KCVC = O_QN + (size_t)MT * DM * 2;
constexpr size_t O_KSN = O_KCVC + (size_t)MT * 256 * 2;
constexpr size_t O_KWN = O_KSN + (size_t)MT * 128 * 2;
constexpr size_t O_VST = O_KWN + (size_t)MT * 128 * 2;
constexpr size_t O_VWT = O_VST + (size_t)MT * 128 * 2;
constexpr size_t O_GT1 = O_VWT + (size_t)MT * 128 * 2;
constexpr size_t O_HID = O_GT1 + (size_t)MT * 48 * 4;
constexpr size_t O_KCN = O_HID + 2ull * 2048 * 256 * 2;
constexpr size_t O_VCT = O_KCN + 8ull * 256 * 64 * 2;
constexpr size_t O_SEL = O_VCT + 8ull * 64 * 256 * 2;
constexpr size_t O_OBUF = O_SEL + 8ull * 4096 * 8;
constexpr size_t O_L1END = O_OBUF + (size_t)MT * DM * 2;
constexpr size_t O_OCMP = O_HB1;
constexpr size_t WS_NEED = 256ull << 20;
static_assert(O_L0END <= WS_NEED && O_FFNEND <= WS_NEED && O_L1END <= WS_NEED, "workspace overflow");

struct Params {
    const float *x, *p, *ab_norm_g, *ab_w_in, *ab_conv_w, *ab_conv_b, *ab_ret_norm_g, *ab_ig_b, *ab_fg_b, *ab_m_norm_g, *ab_w_out;
    const float *nsa_norm_g, *nsa_w_in, *nsa_q_norm_g, *nsa_k_norm_g, *nsa_cmp_pos_k, *nsa_cmp_pos_v, *w1k, *w2k, *w1v, *w2v, *nsa_gate_b, *nsa_w_out;
    const float *ffn_norm_g, *ffn_w_up, *ffn_conv_w, *ffn_conv_b, *ffn_w_down, *ple_w, *ple_norm_g, *ple_gate_norm_g, *ple_w_gate;
    float* out;
    char* ws;
};

DI float bf2f(u16 b) { return __uint_as_float(((unsigned)b) << 16); }
typedef float f32x2_t __attribute__((ext_vector_type(2)));
typedef __bf16 bf16x2_t __attribute__((ext_vector_type(2)));
DI unsigned pk2(float a, float b) { f32x2_t v = {a, b}; bf16x2_t o = __builtin_convertvector(v, bf16x2_t); return __builtin_bit_cast(unsigned, o); }
DI u16 f2bf(float x) { return (u16)(pk2(x, 0.f) & 0xffffu); }
DI float bflo(unsigned u) { return __uint_as_float(u << 16); }
DI float bfhi(unsigned u) { return __uint_as_float(u & 0xffff0000u); }
DI int crow(int i, int h) { return (i & 3) + 8 * (i >> 2) + 4 * h; }
DI float sigmoidf_(float x) { return 1.f / (1.f + __expf(-x)); }
DI float gelu_tanh(float x) { float y = 0.7978845608028654f * (x + 0.044715f * x * x * x); float t = 1.f - 2.f / (__expf(2.f * y) + 1.f); return 0.5f * x * (1.f + t); }
DI float red32(float v) { v += __shfl_xor(v, 1); v += __shfl_xor(v, 2); v += __shfl_xor(v, 4); v += __shfl_xor(v, 8); v += __shfl_xor(v, 16); return v; }
DI bf16x8 ld16(const u16* p) { return *(const bf16x8*)p; }
DI bf16x8 ld8x2(const u16* p0, const u16* p1) { u32x2 a = *(const u32x2*)p0, b = *(const u32x2*)p1; u32x4 v = {a.x, a.y, b.x, b.y}; return __builtin_bit_cast(bf16x8, v); }
DI bf16x8 packp(const f32x16& x, int s) {
    u32x4 v = {pk2(x[8 * s + 0], x[8 * s + 1]), pk2(x[8 * s + 2], x[8 * s + 3]), pk2(x[8 * s + 4], x[8 * s + 5]), pk2(x[8 * s + 6], x[8 * s + 7])};
    return __builtin_bit_cast(bf16x8, v);
}
DI f32x16 zero16() { f32x16 z; for (int i = 0; i < 16; ++i) z[i] = 0.f; return z; }
DI u64 ss_fix(float s) { return (u64)(s * 1048576.f + 0.5f); }
DI float ss_rstd(u64 v) { return rsqrtf((float)v * (1.f / (1048576.f * 1024.f)) + EPS); }
DI float gamma_log(int h) { return log1pf(-exp2f(-5.f - (float)h)); }


#define XB_TMO      128
#define XB_XCNT(j)  (256  + 64 * (j))
#define XB_XSUB(j)  (1280 + 64 * (j))
#define XB_XGEN(j)  (2304 + 64 * (j))
#define XB_TOP      3328
#define XB_TOPGEN   3392
#define XCD_BAR_WORDS 3456
#define XB_SPIN_CAP (1u << 22)
#define LAS __attribute__((address_space(3)))
DI unsigned xb_ld(unsigned* p) { return __hip_atomic_load(p, __ATOMIC_RELAXED, __HIP_MEMORY_SCOPE_AGENT); }
DI unsigned xb_add(unsigned* p, unsigned v) { return __hip_atomic_fetch_add(p, v, __ATOMIC_RELAXED, __HIP_MEMORY_SCOPE_AGENT); }
DI unsigned xb_xcc_id() { return (unsigned)__builtin_amdgcn_s_getreg((3 << 11) | 20) & 0xFu; }
#define XB_SPIN(cond, bar) do { unsigned _sp = 0; while (cond) { __builtin_amdgcn_s_sleep(1); \
    if ((++_sp & 255u) == 0u) { if (xb_ld(&(bar)[XB_TMO])) break; if (_sp > XB_SPIN_CAP) { atomicAdd(&(bar)[XB_TMO], 1u); break; } } } } while (0)
struct XcdBarrier { unsigned* bar; unsigned x; volatile LAS unsigned* st; };
DI XcdBarrier xcd_barrier_post(unsigned* bar, volatile LAS unsigned* st) {
    XcdBarrier b; b.bar = bar; b.x = xb_xcc_id(); b.st = st;
    if (threadIdx.x == 0) (void)xb_add(&bar[XB_XCNT(b.x)], 1u);
    return b;
}
DI void xcd_barrier_complete(unsigned* bar, unsigned x, unsigned& nloc, unsigned& nx) {
    const unsigned G = gridDim.x * gridDim.y * gridDim.z;
    unsigned sum, cnt, mine, sp = 0u;
    for (;;) {
        sum = 0u; cnt = 0u; mine = 0u;
#pragma unroll
        for (unsigned j = 0; j < 16; ++j) { const unsigned c = xb_ld(&bar[XB_XCNT(j)]); sum += c; cnt += (c > 0u) ? 1u : 0u; mine = (j == x) ? c : mine; }
        if (sum == G) break;
        __builtin_amdgcn_s_sleep(1);
        if ((++sp & 255u) == 0u) { if (xb_ld(&bar[XB_TMO])) break; if (sp > XB_SPIN_CAP) { atomicAdd(&bar[XB_TMO], 1u); break; } }
    }
    nloc = mine > 0u ? mine : 1u; nx = cnt > 0u ? cnt : 1u;
}
DI void xcd_barrier(const XcdBarrier& b) {
    asm volatile("s_waitcnt vmcnt(0)" ::: "memory");
    __syncthreads();
    if (threadIdx.x == 0) {
        unsigned* bar = b.bar;
        __builtin_amdgcn_s_waitcnt(0);
        unsigned nloc = b.st[0], nx = b.st[1];
        if (nloc == 0u) { xcd_barrier_complete(bar, b.x, nloc, nx); b.st[0] = nloc; b.st[1] = nx; }
        const unsigned old = xb_add(&bar[XB_XSUB(b.x)], 1u);
        const unsigned gen = old / nloc;
        if (old + 1u == (gen + 1u) * nloc) {
            __builtin_amdgcn_fence(__ATOMIC_RELEASE, "agent");
            asm volatile("s_waitcnt vmcnt(0)" ::: "memory");
            const unsigned og = xb_add(&bar[XB_TOP], 1u);
            const unsigned tg = og / nx;
            if (og + 1u == (tg + 1u) * nx) xb_add(&bar[XB_TOPGEN], 1u);
            else XB_SPIN(xb_ld(&bar[XB_TOPGEN]) == tg, bar);
            __builtin_amdgcn_fence(__ATOMIC_ACQUIRE, "agent");
            xb_add(&bar[XB_XGEN(b.x)], 1u);
            asm volatile("s_waitcnt vmcnt(0)" ::: "memory");
        } else {
            XB_SPIN(xb_ld(&bar[XB_XGEN(b.x)]) == gen, bar);
            __builtin_amdgcn_fence(__ATOMIC_ACQUIRE, "agent");
            asm volatile("s_waitcnt vmcnt(0)" ::: "memory");
        }
    }
    __syncthreads();
}

DI void ctr_barrier(unsigned* ctr, unsigned& gen) {
    asm volatile("s_waitcnt vmcnt(0)" ::: "memory");
    __syncthreads();
    gen += 1u;
    if (threadIdx.x == 0) {
        __builtin_amdgcn_fence(__ATOMIC_RELEASE, "agent");
        asm volatile("s_waitcnt vmcnt(0)" ::: "memory");
        (void)__hip_atomic_fetch_add(ctr, 1u, __ATOMIC_RELAXED, __HIP_MEMORY_SCOPE_AGENT);
        const unsigned target = gen * gridDim.x;
        unsigned sp = 0;
        while (__hip_atomic_load(ctr, __ATOMIC_RELAXED, __HIP_MEMORY_SCOPE_AGENT) < target) {
            __builtin_amdgcn_s_sleep(1);
            if (++sp > (1u << 24)) break;
        }
        __builtin_amdgcn_fence(__ATOMIC_ACQUIRE, "agent");
        asm volatile("s_waitcnt vmcnt(0)" ::: "memory");
    }
    __syncthreads();
}

constexpr int LDT = 72;
constexpr int LDS_BYTES = 2 * 2 * 128 * LDT * 2;

template <bool AF32, class RowA>
DI void gemm_main(f32x16 (&acc)[2][2], RowA rowA, const int kmulA, const u16* __restrict__ Bf, int ldb, int n0, int K, u16* As, u16*  ) {
    constexpr int PD = 4;
    constexpr int BUFE = 128 * LDT;
    const int tid = threadIdx.x, lane = tid & 63, wave = tid >> 6;
    const int wm = wave >> 1, wn = wave & 1, r = lane & 31, hh = lane >> 5;
#pragma unroll
    for (int mi = 0; mi < 2; ++mi)
#pragma unroll
        for (int ni = 0; ni < 2; ++ni) acc[mi][ni] = zero16();
    typedef typename std::conditional<AF32, float, u16>::type TA;
    const int row0 = tid >> 3, kc = (tid & 7) * 8;
    const TA* pa[4];
#pragma unroll
    for (int i = 0; i < 4; ++i) pa[i] = (const TA*)rowA(row0 + 32 * i) + kc;
    const int kbn = ldb >> 4;
    const u16* pb = Bf + ((size_t)((n0 + wn * 64) >> 5) * kbn * 64 + lane) * 8;
    u32x4 ra[PD][4];
    bf16x8 rb[PD][8];
    auto loadA = [&](u32x4 (&xa)[4], int k0) __attribute__((always_inline)) {
#pragma unroll
        for (int i = 0; i < 4; ++i) {
            if constexpr (AF32) {
                const float* q = (const float*)pa[i] + k0 * kmulA;
                const float4 v0 = *(const float4*)q, v1 = *(const float4*)(q + 4);
                u32x4 t = {pk2(v0.x, v0.y), pk2(v0.z, v0.w), pk2(v1.x, v1.y), pk2(v1.z, v1.w)};
                xa[i] = t;
            } else {
                xa[i] = *(const u32x4*)((const u16*)pa[i] + k0 * kmulA);
            }
        }
    };
    auto loadB = [&](bf16x8 (&xb)[8], int k0) __attribute__((always_inline)) {
#pragma unroll
        for (int ni = 0; ni < 2; ++ni)
#pragma unroll
            for (int ks = 0; ks < 4; ++ks) xb[ni * 4 + ks] = *(const bf16x8*)(pb + ((size_t)ni * kbn + (k0 >> 4) + ks) * 512);
    };
    auto stores = [&](const u32x4 (&xa)[4], int p) __attribute__((always_inline)) {
        u16* sa = As + p * BUFE + row0 * LDT + kc;
#pragma unroll
        for (int i = 0; i < 4; ++i) *(u32x4*)(sa + 32 * i * LDT) = xa[i];
    };
    const int nk = K >> 6;
#pragma unroll
    for (int d = 0; d < PD; ++d) { loadA(ra[d], d * 64); loadB(rb[d], d * 64); }
    __syncthreads();
    stores(ra[0], 0);
    if (PD < nk) loadA(ra[0], PD * 64);
    __syncthreads();
    const u16* fa = As + (wm * 64 + r) * LDT + hh * 8;
    for (int kb = 0; kb < nk; kb += PD) {
#pragma unroll
        for (int u = 0; u < PD; ++u) {
            const int k = kb + u, p = u & 1;
#pragma unroll
            for (int ks = 0; ks < 4; ++ks) {
                bf16x8 a[2];
#pragma unroll
                for (int mi = 0; mi < 2; ++mi) a[mi] = *(const bf16x8*)(fa + p * BUFE + mi * 32 * LDT + ks * 16);
#pragma unroll
                for (int mi = 0; mi < 2; ++mi)
#pragma unroll
                    for (int ni = 0; ni < 2; ++ni) acc[mi][ni] = MFMA(a[mi], rb[u][ni * 4 + ks], acc[mi][ni]);
            }
            if (k + PD < nk) loadB(rb[u], (k + PD) * 64);
            if (k + 1 < nk) {
                stores(ra[(u + 1) % PD], p ^ 1);
                if (k + 1 + PD < nk) loadA(ra[(u + 1) % PD], (k + 1 + PD) * 64);
            }
            __syncthreads();
        }
    }
}

DI bool tile_decode(int v, int MTl, int NTl, int& mt, int& nt) {
    mt = v / NTl; nt = v - mt * NTl;
    return v < MTl * NTl;
}
DI int tile_bound(int MTl, int NTl) { return MTl * NTl; }

template <class RowMap>
DI void tconv(const float* __restrict__ W, int K, int N, int Npad, const float* __restrict__ g, u16* __restrict__ out, RowMap rm, int gtid, int gsz) {
    const int total = (K / 32) * Npad, kb_per_n = K >> 4;
    for (int u = gtid; u < total; u += gsz) {
        const int n = u % Npad, k32 = u / Npad;
        float v[32];
        if (n < N) {
            const float* wp = W + (size_t)(k32 * 32) * N + n;
#pragma unroll
            for (int j = 0; j < 32; ++j) v[j] = wp[(size_t)j * N];
            if (g) {
#pragma unroll
                for (int j = 0; j < 32; ++j) v[j] *= g[k32 * 32 + j];
            }
        } else {
#pragma unroll
            for (int j = 0; j < 32; ++j) v[j] = 0.f;
        }
        const int np = rm(n), nb = np >> 5, rr = np & 31;
#pragma unroll
        for (int q = 0; q < 4; ++q) {
            u32x4 o = {pk2(v[8 * q + 0], v[8 * q + 1]), pk2(v[8 * q + 2], v[8 * q + 3]), pk2(v[8 * q + 4], v[8 * q + 5]), pk2(v[8 * q + 6], v[8 * q + 7])};
            const size_t blkid = (size_t)nb * kb_per_n + k32 * 2 + (q >> 1);
            *(u32x4*)(out + (blkid * 64 + (q & 1) * 32 + rr) * 8) = o;
        }
    }
}
DI void zfill16(u16* p, size_t n_elems, int gtid, int gsz) {
    u32x4 z = {0u, 0u, 0u, 0u};
    for (size_t u = gtid; u < n_elems / 8; u += gsz) *(u32x4*)(p + u * 8) = z;
}

__global__ void __launch_bounds__(256, MINW) fwd_megakernel(Params P) {
    cg::grid_group grid = cg::this_grid();
    __shared__ __attribute__((aligned(16))) char smem[LDS_BYTES];
    __shared__ uint4 xb_words;
    if (threadIdx.x == 0) xb_words = make_uint4(0u, 0u, 0u, 0u);
    __syncthreads();
    unsigned bar_gen = 0u;
    const XcdBarrier xbar = xcd_barrier_post((unsigned*)(P.ws + O_BAR), (volatile LAS unsigned*)&xb_words);
    u16* As = (u16*)smem;
    u16* Bs = As + 128 * LDT;
    const int tid = threadIdx.x, lane = tid & 63, wave = tid >> 6;
    const int wm = wave >> 1, wn = wave & 1, r = lane & 31, hh = lane >> 5;
    const int nblk = gridDim.x, blk = blockIdx.x;
    const int gtid = blk * 256 + tid, gsz = nblk * 256;
    const int gw = blk * 4 + wave, ngw = nblk * 4;
    char* ws = P.ws;
    u64* SS = (u64*)(ws + O_SS);
    u16* HB0 = (u16*)(ws + O_HB0);
    u16* HB1 = (u16*)(ws + O_HB1);
    const float* ROPEC = (const float*)(ws + O_ROPEC);
    const float* ROPES = (const float*)(ws + O_ROPES);

    auto ph_0 = [&]() __attribute__((always_inline)) {
        auto idm = [](int n) { return n; };
        auto upm = [](int n) { return n < 2816 ? (n >> 6) * 128 + (n & 63) : ((n - 2816) >> 6) * 128 + 64 + ((n - 2816) & 63); };
        tconv(P.ab_w_in, 1024, 3080, 3200, P.ab_norm_g, (u16*)(ws + O_WABIN), idm, gtid, gsz);
        tconv(P.ab_w_out, 1024, 1024, 1024, (const float*)nullptr, (u16*)(ws + O_WABOUT), idm, gtid, gsz);
        tconv(P.nsa_w_in, 1024, 1840, 1920, P.nsa_norm_g, (u16*)(ws + O_WNSAIN), idm, gtid, gsz);
        tconv(P.w1k, 2048, 256, 256, (const float*)nullptr, (u16*)(ws + O_WC1K), idm, gtid, gsz);
        tconv(P.w1v, 2048, 256, 256, (const float*)nullptr, (u16*)(ws + O_WC1V), idm, gtid, gsz);
        tconv(P.w2k, 256, 64, 128, (const float*)nullptr, (u16*)(ws + O_WC2K), idm, gtid, gsz);
        tconv(P.w2v, 256, 64, 128, (const float*)nullptr, (u16*)(ws + O_WC2V), idm, gtid, gsz);
        tconv(P.nsa_w_out, 1024, 1024, 1024, (const float*)nullptr, (u16*)(ws + O_WNSAOUT), idm, gtid, gsz);
        for (int i = 0; i < 2; ++i) {
            tconv(P.ffn_w_up + (size_t)i * 1024 * 5632, 1024, 5632, 5632, P.ffn_norm_g + i * 1024, (u16*)(ws + O_WUP + i * SZ_WUP), upm, gtid, gsz);
            tconv(P.ffn_w_down + (size_t)i * 2816 * 1024, 2816, 1024, 1024, (const float*)nullptr, (u16*)(ws + O_WDOWN + i * SZ_WDOWN), idm, gtid, gsz);
            tconv(P.ple_w + (size_t)i * 256 * 1024, 256, 1024, 1024, (const float*)nullptr, (u16*)(ws + O_WPLE + i * SZ_WPLE), idm, gtid, gsz);
            tconv(P.ple_w_gate + (size_t)i * 1024 * 1024, 1024, 1024, 1024, P.ple_gate_norm_g + i * 1024, (u16*)(ws + O_WGATE + i * SZ_WGATE), idm, gtid, gsz);
        }
        {
            float* rc = (float*)(ws + O_ROPEC);
            float* rs = (float*)(ws + O_ROPES);
            for (int u = gtid; u < 4096 * 32; u += gsz) {
                const int pos = u >> 5, d = u & 31;
                const float inv = powf(10000.f, -(float)d / 32.f);
                const float ang = (float)pos * inv;
                const double a = (double)ang;
                const double n = rint(a * 0.15915494309189535);
                const float rr = (float)(a - n * 6.283185307179586);
                rc[u] = cosf(rr);
                rs[u] = sinf(rr);
            }
        }
        for (int u = gw; u < 512; u += ngw) {
            const int kv = u >> 8, j = u & 255;
            const float* pos = kv ? P.nsa_cmp_pos_v : P.nsa_cmp_pos_k;
            const float* W1 = kv ? P.w1v : P.w1k;
            float s = 0.f;
            for (int k = lane; k < 2048; k += 64) s += pos[k] * W1[(size_t)k * 256 + j];
            s = red32(s); s += __shfl_xor(s, 32);
            if (lane == 0) ((float*)(ws + O_BIAS1))[u] = s;
        }
        for (int u = gtid; u < 7 * MT; u += gsz) SS[MT + u] = 0ull;
        for (int row = gw; row < MT; row += ngw) {
            const float4* xr = (const float4*)(P.x + (size_t)row * DM);
            float s = 0.f;
#pragma unroll
            for (int j = 0; j < 4; ++j) {
                const float4 v = xr[lane + 64 * j];
                s += v.x * v.x + v.y * v.y + v.z * v.z + v.w * v.w;
                u32x2 o = {pk2(v.x, v.y), pk2(v.z, v.w)};
                *(u32x2*)(HB0 + (size_t)row * DM + (lane + 64 * j) * 4) = o;
            }
            s = red32(s); s += __shfl_xor(s, 32);
            if (lane == 0) SS[row] = ss_fix(s);
        }
    };

    auto ph_1 = [&]() __attribute__((always_inline)) {
        u16* Z0 = (u16*)P.out;
        u16* VT0 = (u16*)(ws + O_VT0);
        u16* KT = (u16*)(ws + O_KT);
        float* GF = (float*)(ws + O_GF);
        const u16* Wt = (const u16*)(ws + O_WABIN);
        for (int tile = blk; tile < tile_bound(128, 25); tile += nblk) {
            int mt, nt; if (!tile_decode(tile, 128, 25, mt, nt)) continue;
            const int m0 = mt * 128, n0 = nt * 128;
            f32x16 acc[2][2];
            const u16* Ab = HB0 + (size_t)m0 * DM;
            gemm_main<false>(acc, [&](int row) { return Ab + (size_t)row * DM; }, 1, Wt, 1024, n0, 1024, As, Bs);
            const int colw = n0 + wn * 64;
            float rsv[2][16], cv[2][16], sv[2][16];
#pragma unroll
            for (int mi = 0; mi < 2; ++mi)
#pragma unroll
                for (int i = 0; i < 16; ++i) {
                    const int row = m0 + wm * 64 + mi * 32 + crow(i, hh);
                    rsv[mi][i] = ss_rstd(SS[row]);
                    cv[mi][i] = (nt < 4) ? ROPEC[(row & 4095) * 32 + r] : 0.f;
                    sv[mi][i] = (nt < 4) ? ROPES[(row & 4095) * 32 + r] : 0.f;
                }
#pragma unroll
            for (int mi = 0; mi < 2; ++mi) {
#pragma unroll
                for (int i4 = 0; i4 < 4; ++i4) {
                    float v0[4], v1[4];
                    const int rowb = m0 + wm * 64 + mi * 32 + 8 * i4 + 4 * hh;
#pragma unroll
                    for (int j = 0; j < 4; ++j) {
                        const float rs = rsv[mi][i4 * 4 + j];
                        v0[j] = acc[mi][0][i4 * 4 + j] * rs;
                        v1[j] = acc[mi][1][i4 * 4 + j] * rs;
                    }
                    const int bb = rowb >> 12, t = rowb & 4095;
                    if (nt < 4) {
                        const int head = (colw & 255) >> 6;
                        const float lg = gamma_log(head);
#pragma unroll
                        for (int j = 0; j < 4; ++j) {
                            const float c = cv[mi][i4 * 4 + j], s = sv[mi][i4 * 4 + j];
                            float y0 = v0[j] * c - v1[j] * s, y1 = v0[j] * s + v1[j] * c;
                            if (nt >= 2) { const float sc = 0.125f * __expf(-(float)(((t + j) & 127) + 1) * lg); y0 *= sc; y1 *= sc; }
                            v0[j] = y0; v1[j] = y1;
                            Z0[(size_t)(rowb + j) * 2048 + colw + r] = f2bf(y0);
                            Z0[(size_t)(rowb + j) * 2048 + colw + 32 + r] = f2bf(y1);
                        }
                        if (nt >= 2) {
                            const int kc = colw - 256;
                            u32x2 o0 = {pk2(v0[0], v0[1]), pk2(v0[2], v0[3])}, o1 = {pk2(v1[0], v1[1]), pk2(v1[2], v1[3])};
                            *(u32x2*)(KT + ((size_t)(bb * 256 + kc + r)) * 4096 + t) = o0;
                            *(u32x2*)(KT + ((size_t)(bb * 256 + kc + 32 + r)) * 4096 + t) = o1;
                        }
                    } else if ((nt >= 4 && nt < 8) || (nt >= 16 && nt < 20)) {
                        const int vc = (nt < 8) ? (colw - 512) : (512 + colw - 2048);
                        u32x2 o0 = {pk2(v0[0], v0[1]), pk2(v0[2], v0[3])}, o1 = {pk2(v1[0], v1[1]), pk2(v1[2], v1[3])};
                        *(u32x2*)(VT0 + ((size_t)(bb * 1024 + vc + r)) * 4096 + t) = o0;
                        *(u32x2*)(VT0 + ((size_t)(bb * 1024 + vc + 32 + r)) * 4096 + t) = o1;
                    } else if (nt < 24) {
                        const int zc = (nt < 12) ? (512 + colw - 1024) : (nt < 16) ? (1024 + colw - 1536) : (1536 + colw - 2560);
#pragma unroll
                        for (int j = 0; j < 4; ++j) {
                            Z0[(size_t)(rowb + j) * 2048 + zc + r] = f2bf(v0[j]);
                            Z0[(size_t)(rowb + j) * 2048 + zc + 32 + r] = f2bf(v1[j]);
                        }
                    } else {
                        if (wn == 0 && r < 8) {
#pragma unroll
                            for (int j = 0; j < 4; ++j) GF[(size_t)(rowb + j) * 8 + r] = v0[j];
                        }
                    }
                }
            }
        }
    };

    auto ph_2 = [&]() __attribute__((always_inline)) {
        const u16* Z0 = (const u16*)P.out;
        const float* GF = (const float*)(ws + O_GF);
        float* GS = (float*)(ws + O_GS); float* BL = (float*)(ws + O_BL); float* PM = (float*)(ws + O_PM);
        float* BLAST = (float*)(ws + O_BLAST); float* GC = (float*)(ws + O_GC); float* NC = (float*)(ws + O_NC);
        u16* QM = (u16*)(ws + O_QM); u16* KM = (u16*)(ws + O_KM); u16* KWT = (u16*)(ws + O_KWT);
        for (int u = gw; u < 1024; u += ngw) {
            const int bh = u >> 6, c = u & 63, b = bh >> 2, h = bh & 3, t0 = c * 64;
            const size_t rowb = (size_t)b * 4096;
            const size_t row = rowb + t0 + lane;
            const float f = GF[row * 8 + 4 + h] + P.ab_fg_b[h];
            const float fc = fminf(f, 0.f) - log1pf(__expf(-fabsf(f)));
            const float ic = GF[row * 8 + h] + P.ab_ig_b[h];
            float bcs = fc;
#pragma unroll
            for (int off = 1; off < 64; off <<= 1) { const float o = __shfl_up(bcs, off); if (lane >= off) bcs += o; }
            const float g = ic - bcs;
            float pm = g;
#pragma unroll
            for (int off = 1; off < 64; off <<= 1) { const float o = __shfl_up(pm, off); if (lane >= off) pm = fmaxf(pm, o); }
            const float G = __shfl(pm, 63), bl = __shfl(bcs, 63);
            const float w = __expf(g - G);
            GS[bh * 4096 + t0 + lane] = g; BL[bh * 4096 + t0 + lane] = bcs; PM[bh * 4096 + t0 + lane] = pm;
            if (lane == 0) { BLAST[bh * 64 + c] = bl; GC[bh * 64 + c] = G; }
            {
                const int ch = 256 + h * 64 + lane;
                const float w0 = P.ab_conv_w[ch], w1 = P.ab_conv_w[512 + ch], w2 = P.ab_conv_w[1024 + ch], w3 = P.ab_conv_w[1536 + ch], cb = P.ab_conv_b[ch];
                const u16* zp = Z0 + 1024 + ch;
                float x0 = 0.f, x1 = 0.f, x2 = 0.f;
                if (t0 > 0) { x0 = bf2f(zp[(rowb + t0 - 3) * 2048]); x1 = bf2f(zp[(rowb + t0 - 2) * 2048]); x2 = bf2f(zp[(rowb + t0 - 1) * 2048]); }
                float nsum = 0.f;
                float xr[64];
#pragma unroll
                for (int s = 0; s < 64; ++s) xr[s] = bf2f(zp[(rowb + t0 + s) * 2048]);
#pragma unroll
                for (int s8 = 0; s8 < 8; ++s8) {
                    float vw[8];
#pragma unroll
                    for (int j = 0; j < 8; ++j) {
                        const int s = s8 * 8 + j;
                        const float x3 = xr[s];
                        float v = cb + w0 * x0 + w1 * x1 + w2 * x2 + w3 * x3;
                        v = v / (1.f + __expf(-v));
                        x0 = x1; x1 = x2; x2 = x3;
                        KM[(rowb + t0 + s) * 256 + h * 64 + lane] = f2bf(v);
                        const float wsv = __shfl(w, s);
                        vw[j] = v * wsv; nsum += vw[j];
                    }
                    u32x4 o = {pk2(vw[0], vw[1]), pk2(vw[2], vw[3]), pk2(vw[4], vw[5]), pk2(vw[6], vw[7])};
                    *(u32x4*)(KWT + ((size_t)(b * 256 + h * 64 + lane)) * 4096 + t0 + s8 * 8) = o;
                }
                NC[(size_t)u * 64 + lane] = nsum;
            }
            {
                const int ch = h * 64 + lane;
                const float w0 = P.ab_conv_w[ch], w1 = P.ab_conv_w[512 + ch], w2 = P.ab_conv_w[1024 + ch], w3 = P.ab_conv_w[1536 + ch], cb = P.ab_conv_b[ch];
                const u16* zp = Z0 + 1024 + ch;
                float x0 = 0.f, x1 = 0.f, x2 = 0.f;
                if (t0 > 0) { x0 = bf2f(zp[(rowb + t0 - 3) * 2048]); x1 = bf2f(zp[(rowb + t0 - 2) * 2048]); x2 = bf2f(zp[(rowb + t0 - 1) * 2048]); }
                float xr[64];
#pragma unroll
                for (int s = 0; s < 64; ++s) xr[s] = bf2f(zp[(rowb + t0 + s) * 2048]);
#pragma unroll
                for (int s = 0; s < 64; ++s) {
                    const float x3 = xr[s];
                    float v = cb + w0 * x0 + w1 * x1 + w2 * x2 + w3 * x3;
                    v = v / (1.f + __expf(-v));
                    x0 = x1; x1 = x2; x2 = x3;
                    QM[(rowb + t0 + s) * 256 + h * 64 + lane] = f2bf(v * 0.125f);
                }
            }
        }
    };

    auto ph_3 = [&]() __attribute__((always_inline)) {
        const u16* VT0 = (const u16*)(ws + O_VT0);
        const u16* KT = (const u16*)(ws + O_KT);
        const u16* KWT = (const u16*)(ws + O_KWT);
        float* KVT = (float*)(ws + O_KVT);
        float* UT = (float*)(ws + O_UT);
        for (int u = gw; u < 2048 + 4096; u += ngw) {
            f32x16 a0 = zero16(), a1 = zero16();
            if (u < 2048) {
                const int dt = u & 3, c = (u >> 2) & 31, bh = u >> 7, b = bh >> 2, h = bh & 3, t0 = c * 128;
                const u16* va = VT0 + ((size_t)(b * 1024 + h * 128 + dt * 32 + r)) * 4096 + t0 + 8 * hh;
                const u16* kb = KT + ((size_t)(b * 256 + h * 64 + r)) * 4096 + t0 + 8 * hh;
#pragma unroll
                for (int st = 0; st < 8; ++st) {
                    const bf16x8 a = ld16(va + 16 * st);
                    a0 = MFMA(a, ld16(kb + 16 * st), a0);
                    a1 = MFMA(a, ld16(kb + 32 * 4096 + 16 * st), a1);
                }
                const float cdec = __expf(128.f * gamma_log(h));
                float* o = KVT + (size_t)(bh * 32 + c) * 8192;
#pragma unroll
                for (int i = 0; i < 16; ++i) {
                    o[(dt * 32 + crow(i, hh)) * 64 + r] = cdec * a0[i];
                    o[(dt * 32 + crow(i, hh)) * 64 + 32 + r] = cdec * a1[i];
                }
            } else {
                const int v = u - 2048;
                const int dt = v & 3, c = (v >> 2) & 63, bh = v >> 8, b = bh >> 2, h = bh & 3, t0 = c * 64;
                const u16* va = VT0 + ((size_t)(b * 1024 + 512 + h * 128 + dt * 32 + r)) * 4096 + t0 + 8 * hh;
                const u16* kb = KWT + ((size_t)(b * 256 + h * 64 + r)) * 4096 + t0 + 8 * hh;
#pragma unroll
                for (int st = 0; st < 4; ++st) {
                    const bf16x8 a = ld16(va + 16 * st);
                    a0 = MFMA(a, ld16(kb + 16 * st), a0);
                    a1 = MFMA(a, ld16(kb + 32 * 4096 + 16 * st), a1);
                }
                float* o = UT + (size_t)(bh * 64 + c) * 8192;
#pragma unroll
                for (int i = 0; i < 16; ++i) {
                    o[(dt * 32 + crow(i, hh)) * 64 + r] = a0[i];
                    o[(dt * 32 + crow(i, hh)) * 64 + 32 + r] = a1[i];
                }
            }
        }
    };

    auto ph_4 = [&]() __attribute__((always_inline)) {
        const float* KVT = (const float*)(ws + O_KVT);
        const float* UT = (const float*)(ws + O_UT);
        const float* NC = (const float*)(ws + O_NC);
        const float* BLAST = (const float*)(ws + O_BLAST);
        const float* GC = (const float*)(ws + O_GC);
        u16* RT = (u16*)(ws + O_RT);
        u16* CT = (u16*)(ws + O_CT);
        float* MS = (float*)(ws + O_MS);
        float* NS = (float*)(ws + O_NS);
        for (int e = gtid; e < 131072 * 2 + 1024; e += gsz) {
            if (e < 131072) {
                const int bh = e >> 13, idx = e & 8191;
                const float cdec = __expf(128.f * gamma_log(bh & 3));
                float R = 0.f;
                float kvv[32];
#pragma unroll
                for (int c = 0; c < 32; ++c) kvv[c] = KVT[(size_t)(bh * 32 + c) * 8192 + idx];
#pragma unroll
                for (int c = 0; c < 32; ++c) {
                    RT[(size_t)(bh * 32 + c) * 8192 + idx] = f2bf(R);
                    R = cdec * R + kvv[c];
                }
            } else if (e < 262144) {
                const int e2 = e - 131072, bh = e2 >> 13, idx = e2 & 8191;
                float C = 0.f, m = 0.f;
                float utv[64];
#pragma unroll
                for (int c = 0; c < 64; ++c) utv[c] = UT[(size_t)(bh * 64 + c) * 8192 + idx];
#pragma unroll
                for (int c = 0; c < 64; ++c) {
                    const float G = GC[bh * 64 + c];
                    const float M = fmaxf(m, G);
                    const float dC = __expf(m - M), dU = __expf(G - M);
                    CT[(size_t)(bh * 64 + c) * 8192 + idx] = f2bf(C);
                    if (idx == 0) MS[bh * 64 + c] = m;
                    C = dC * C + dU * utv[c];
                    m = BLAST[bh * 64 + c] + M;
                }
            } else {
                const int e2 = e - 262144, bh = e2 >> 6, dk = e2 & 63;
                float n = 0.f, m = 0.f;
                for (int c = 0; c < 64; ++c) {
                    const float G = GC[bh * 64 + c];
                    const float M = fmaxf(m, G);
                    const float dC = __expf(m - M), dU = __expf(G - M);
                    NS[(size_t)(bh * 64 + c) * 64 + dk] = n;
                    n = dC * n + dU * NC[(size_t)(bh * 64 + c) * 64 + dk];
                    m = BLAST[bh * 64 + c] + M;
                }
            }
        }
    };

    auto ph_5 = [&]() __attribute__((always_inline)) {
        const u16* Z0 = (const u16*)P.out;
        const u16* VT0 = (const u16*)(ws + O_VT0);
        const u16* RT = (const u16*)(ws + O_RT);
        const u16* CT = (const u16*)(ws + O_CT);
        const u16* QM = (const u16*)(ws + O_QM);
        const u16* KM = (const u16*)(ws + O_KM);
        const float* GS = (const float*)(ws + O_GS); const float* BL = (const float*)(ws + O_BL); const float* PM = (const float*)(ws + O_PM);
        const float* MS = (const float*)(ws + O_MS); const float* NS = (const float*)(ws + O_NS);
        u16* MIX = HB0;
        for (int u = gw; u < 4096; u += ngw) {
            f32x16 o[4];
            if (u < 2048) {
                const int qt = u & 3, c = (u >> 2) & 31, bh = u >> 7, b = bh >> 2, h = bh & 3, t0 = c * 128, tq = t0 + qt * 32;
                const size_t rowb = (size_t)b * 4096;
                bf16x8 bq[4];
#pragma unroll
                for (int st = 0; st < 4; ++st) bq[st] = ld16(Z0 + (rowb + tq + r) * 2048 + h * 64 + 16 * st + 8 * hh);
                const u16* rt = RT + (size_t)(bh * 32 + c) * 8192;
#pragma unroll
                for (int dt = 0; dt < 4; ++dt) {
                    o[dt] = zero16();
#pragma unroll
                    for (int st = 0; st < 4; ++st) o[dt] = MFMA(ld16(rt + (dt * 32 + r) * 64 + 16 * st + 8 * hh), bq[st], o[dt]);
                }
                for (int kt = 0; kt <= qt; ++kt) {
                    f32x16 s = zero16();
#pragma unroll
                    for (int st = 0; st < 4; ++st) s = MFMA(ld16(Z0 + (rowb + t0 + kt * 32 + r) * 2048 + 256 + h * 64 + 16 * st + 8 * hh), bq[st], s);
                    if (kt == qt) {
#pragma unroll
                        for (int i = 0; i < 16; ++i) if (crow(i, hh) > r) s[i] = 0.f;
                    }
#pragma unroll
                    for (int s2 = 0; s2 < 2; ++s2) {
                        const bf16x8 pb = packp(s, s2);
#pragma unroll
                        for (int dt = 0; dt < 4; ++dt) {
                            const u16* vp = VT0 + ((size_t)(b * 1024 + h * 128 + dt * 32 + r)) * 4096 + t0 + kt * 32 + 16 * s2 + 4 * hh;
                            o[dt] = MFMA(ld8x2(vp, vp + 8), pb, o[dt]);
                        }
                    }
                }
                const float qdec = __expf((float)(qt * 32 + r + 1) * gamma_log(h));
                float ss = 0.f;
#pragma unroll
                for (int dt = 0; dt < 4; ++dt)
#pragma unroll
                    for (int i = 0; i < 16; ++i) { o[dt][i] *= qdec; ss += o[dt][i] * o[dt][i]; }
                ss += __shfl_xor(ss, 32);
                const float rs = rsqrtf(ss * (1.f / 128.f) + EPS);
                const size_t row = rowb + tq + r;
#pragma unroll
                for (int dt = 0; dt < 4; ++dt)
#pragma unroll
                    for (int i4 = 0; i4 < 4; ++i4) {
                        const int dv = dt * 32 + 8 * i4 + 4 * hh;
                        const u32x2 gv = *(const u32x2*)(Z0 + row * 2048 + 512 + h * 128 + dv);
                        const float g0 = bflo(gv.x), g1 = bfhi(gv.x), g2 = bflo(gv.y), g3 = bfhi(gv.y);
                        const float4 ng = *(const float4*)(P.ab_ret_norm_g + h * 128 + dv);
                        const float y0 = o[dt][i4 * 4 + 0] * rs * ng.x * (g0 * sigmoidf_(g0));
                        const float y1 = o[dt][i4 * 4 + 1] * rs * ng.y * (g1 * sigmoidf_(g1));
                        const float y2 = o[dt][i4 * 4 + 2] * rs * ng.z * (g2 * sigmoidf_(g2));
                        const float y3 = o[dt][i4 * 4 + 3] * rs * ng.w * (g3 * sigmoidf_(g3));
                        u32x2 ov = {pk2(y0, y1), pk2(y2, y3)};
                        *(u32x2*)(MIX + row * 1024 + h * 128 + dv) = ov;
                    }
            } else {
                const int v = u - 2048;
                const int qt = v & 1, c = (v >> 1) & 63, bh = v >> 7, b = bh >> 2, h = bh & 3, t0 = c * 64, tq = t0 + qt * 32;
                const size_t rowb = (size_t)b * 4096;
                const size_t row = rowb + tq + r;
                const float mc = MS[bh * 64 + c];
                const float Ml = fmaxf(mc, PM[bh * 4096 + tq + r]);
                const float bl = BL[bh * 4096 + tq + r];
                const float wint = __expf(mc - Ml);
                bf16x8 bq[4];
#pragma unroll
                for (int st = 0; st < 4; ++st) bq[st] = ld16(QM + row * 256 + h * 64 + 16 * st + 8 * hh);
                const u16* ct = CT + (size_t)(bh * 64 + c) * 8192;
#pragma unroll
                for (int dt = 0; dt < 4; ++dt) {
                    o[dt] = zero16();
#pragma unroll
                    for (int st = 0; st < 4; ++st) o[dt] = MFMA(ld16(ct + (dt * 32 + r) * 64 + 16 * st + 8 * hh), bq[st], o[dt]);
#pragma unroll
                    for (int i = 0; i < 16; ++i) o[dt][i] *= wint;
                }
                float qn = 0.f;
                {
                    const u16* qp = QM + row * 256 + h * 64 + 32 * hh;
                    const float* np = NS + (size_t)(bh * 64 + c) * 64 + 32 * hh;
#pragma unroll
                    for (int j = 0; j < 32; ++j) qn += bf2f(qp[j]) * np[j];
                    qn += __shfl_xor(qn, 32);
                }
                float den = 0.f;
                for (int kt = 0; kt <= qt; ++kt) {
                    f32x16 s = zero16();
#pragma unroll
                    for (int st = 0; st < 4; ++st) s = MFMA(ld16(KM + (rowb + t0 + kt * 32 + r) * 256 + h * 64 + 16 * st + 8 * hh), bq[st], s);
#pragma unroll
                    for (int i4 = 0; i4 < 4; ++i4) {
                        const float4 gg = *(const float4*)(GS + bh * 4096 + t0 + kt * 32 + 8 * i4 + 4 * hh);
                        const float ga[4] = {gg.x, gg.y, gg.z, gg.w};
#pragma unroll
                        for (int j = 0; j < 4; ++j) {
                            const int i = i4 * 4 + j;
                            float d = __expf(ga[j] - Ml);
                            if (kt == qt && crow(i, hh) > r) d = 0.f;
                            s[i] *= d; den += s[i];
                        }
                    }
#pragma unroll
                    for (int s2 = 0; s2 < 2; ++s2) {
                        const bf16x8 pb = packp(s, s2);
#pragma unroll
                        for (int dt = 0; dt < 4; ++dt) {
                            const u16* vp = VT0 + ((size_t)(b * 1024 + 512 + h * 128 + dt * 32 + r)) * 4096 + t0 + kt * 32 + 16 * s2 + 4 * hh;
                            o[dt] = MFMA(ld8x2(vp, vp + 8), pb, o[dt]);
                        }
                    }
                }
                den += __shfl_xor(den, 32);
                den += wint * qn;
                const float dinv = 1.f / fmaxf(fabsf(den), __expf(-(bl + Ml)));
                float ss = 0.f;
#pragma unroll
                for (int dt = 0; dt < 4; ++dt)
#pragma unroll
                    for (int i = 0; i < 16; ++i) { o[dt][i] *= dinv; ss += o[dt][i] * o[dt][i]; }
                ss += __shfl_xor(ss, 32);
                const float rs = rsqrtf(ss * (1.f / 128.f) + EPS);
#pragma unroll
                for (int dt = 0; dt < 4; ++dt)
#pragma unroll
                    for (int i4 = 0; i4 < 4; ++i4) {
                        const int dv = dt * 32 + 8 * i4 + 4 * hh;
                        const u32x2 gv = *(const u32x2*)(Z0 + row * 2048 + 1536 + h * 128 + dv);
                        const float4 ng = *(const float4*)(P.ab_m_norm_g + h * 128 + dv);
                        const float y0 = o[dt][i4 * 4 + 0] * rs * ng.x * sigmoidf_(bflo(gv.x));
                        const float y1 = o[dt][i4 * 4 + 1] * rs * ng.y * sigmoidf_(bfhi(gv.x));
                        const float y2 = o[dt][i4 * 4 + 2] * rs * ng.z * sigmoidf_(bflo(gv.y));
                        const float y3 = o[dt][i4 * 4 + 3] * rs * ng.w * sigmoidf_(bfhi(gv.y));
                        u32x2 ov = {pk2(y0, y1), pk2(y2, y3)};
                        *(u32x2*)(MIX + row * 1024 + 512 + h * 128 + dv) = ov;
                    }
            }
        }
    };

    auto resid_gemm = [&](const u16* A, int lda, const u16* Wt, int K, const float* resid, u16* hb_out, u64* ss_out, float scale) __attribute__((always_inline)) {
        for (int tile = blk; tile < tile_bound(128, 8); tile += nblk) {
            int mt, nt; if (!tile_decode(tile, 128, 8, mt, nt)) continue;
            const int m0 = mt * 128, n0 = nt * 128;
            f32x16 acc[2][2];
            const u16* Ab = A + (size_t)m0 * lda;
            gemm_main<false>(acc, [&](int row) { return Ab + (size_t)row * lda; }, 1, Wt, K, n0, K, As, Bs);
            const size_t rbase = (size_t)(m0 + wm * 64 + 4 * hh) * 1024 + n0 + wn * 64 + r;
            float rv[2][2][16];
#pragma unroll
            for (int mi = 0; mi < 2; ++mi)
#pragma unroll
                for (int ni = 0; ni < 2; ++ni)
#pragma unroll
                    for (int i = 0; i < 16; ++i) rv[mi][ni][i] = resid[rbase + (size_t)(mi * 32 + (i & 3) + 8 * (i >> 2)) * 1024 + ni * 32];
            float sqv[2][16];
#pragma unroll
            for (int mi = 0; mi < 2; ++mi)
#pragma unroll
                for (int i = 0; i < 16; ++i) {
                    float sq = 0.f;
#pragma unroll
                    for (int ni = 0; ni < 2; ++ni) {
                        const size_t o = rbase + (size_t)(mi * 32 + (i & 3) + 8 * (i >> 2)) * 1024 + ni * 32;
                        const float hv = rv[mi][ni][i] + scale * acc[mi][ni][i];
                        P.out[o] = hv;
                        if (hb_out) hb_out[o] = f2bf(hv);
                        sq += hv * hv;
                    }
                    sqv[mi][i] = sq;
                }
            if (ss_out) {
#pragma unroll
                for (int mi = 0; mi < 2; ++mi)
#pragma unroll
                    for (int i = 0; i < 16; ++i) {
                        const float s = red32(sqv[mi][i]);
                        if (r == 0) atomicAdd(ss_out + (m0 + wm * 64 + mi * 32 + crow(i, hh)), ss_fix(s));
                    }
            }
        }
    };
    auto ffn_up_phase = [&](int li, const u16* hb, const u64* ss_in, u64* sse, bool do_ss) __attribute__((always_inline)) {
        const u16* Wt = (const u16*)(ws + O_WUP + li * SZ_WUP);
        const u16* Wp = (const u16*)(ws + O_WPLE + li * SZ_WPLE);
        u16* ACT = (u16*)(ws + O_ACT);
        u16* ERAW = (u16*)(ws + O_ERAW);
        const float* cw = P.ffn_conv_w + li * 3 * 2816;
        const float* cb = P.ffn_conv_b + li * 2816;
        const float* pin = P.p + (size_t)li * MT * 256;
        u16* SA = (u16*)smem;
        u16* SB = SA + 128 * 66;
        for (int pass = 0; pass < 2; ++pass)
        for (int tile = blk; tile < (pass ? tile_bound(128, 8) : tile_bound(132, 44)); tile += nblk) {
            f32x16 acc[2][2];
            int mt, nt; if (!tile_decode(tile, pass ? 128 : 132, pass ? 8 : 44, mt, nt)) continue;
            if (pass == 0) {
                const int b = mt / 33, jt = mt % 33, tok0 = jt * 126 - 2, n0 = nt * 128;
                const u16* Ab = hb + (size_t)b * 4096 * DM;
                gemm_main<false>(acc, [&](int row) { int tk = tok0 + row; tk = tk < 0 ? 0 : (tk > 4095 ? 4095 : tk); return Ab + (size_t)tk * DM; }, 1, Wt, 1024, n0, 1024, As, Bs);
                __syncthreads();
#pragma unroll
                for (int mi = 0; mi < 2; ++mi)
#pragma unroll
                    for (int i = 0; i < 16; ++i) {
                        const int rl = wm * 64 + mi * 32 + crow(i, hh);
                        const int tok = tok0 + rl;
                        const int tkc = tok < 0 ? 0 : (tok > 4095 ? 4095 : tok);
                        const float rs = ss_rstd(ss_in[b * 4096 + tkc]);
#pragma unroll
                        for (int ni = 0; ni < 2; ++ni) {
                            float v = acc[mi][ni][i] * rs;
                            if (tok < 0) v = 0.f;
                            (wn == 0 ? SA : SB)[rl * 66 + ni * 32 + r] = f2bf(v);
                        }
                    }
                __syncthreads();
                for (int e = tid; e < 126 * 64; e += 256) {
                    const int rl = 2 + (e >> 6), cl = e & 63, tok = tok0 + rl;
                    if (tok < 4096) {
                        const int f = nt * 64 + cl;
                        const float a = cb[f] + cw[f] * bf2f(SA[(rl - 2) * 66 + cl]) + cw[2816 + f] * bf2f(SA[(rl - 1) * 66 + cl]) + cw[5632 + f] * bf2f(SA[rl * 66 + cl]);
                        ACT[((size_t)b * 4096 + tok) * 2816 + f] = f2bf(gelu_tanh(a) * bf2f(SB[rl * 66 + cl]));
                    }
                }
            } else {
                const int m0 = mt * 128, n0 = nt * 128;
                const float* Ab = pin + (size_t)m0 * 256;
                gemm_main<true>(acc, [&](int row) { return Ab + (size_t)row * 256; }, 1, Wp, 256, n0, 256, As, Bs);
#pragma unroll
                for (int mi = 0; mi < 2; ++mi)
#pragma unroll
                    for (int i = 0; i < 16; ++i) {
                        const size_t row = m0 + wm * 64 + mi * 32 + crow(i, hh);
                        float sq = 0.f;
#pragma unroll
                        for (int ni = 0; ni < 2; ++ni) {
                            const int col = n0 + wn * 64 + ni * 32 + r;
                            const float v = acc[mi][ni][i];
                            ERAW[row * 1024 + col] = f2bf(v);
                            sq += v * v;
                        }
                        sq = red32(sq); if (do_ss && r == 0) atomicAdd(sse + row, ss_fix(sq));
                    }
            }
        }
    };
    auto gate_phase = [&](int li, const u16* hb, const u64* ss_in, const u64* sse, u16* hb_out, u64* ss_out, float scale) __attribute__((always_inline)) {
        const u16* Wt = (const u16*)(ws + O_WGATE + li * SZ_WGATE);
        const u16* ERAW = (const u16*)(ws + O_ERAW);
        const float* eg = P.ple_norm_g + li * 1024;
        for (int tile = blk; tile < tile_bound(128, 8); tile += nblk) {
            int mt, nt; if (!tile_decode(tile, 128, 8, mt, nt)) continue;
            const int m0 = mt * 128, n0 = nt * 128;
            f32x16 acc[2][2];
            const u16* Ab = hb + (size_t)m0 * DM;
            gemm_main<false>(acc, [&](int row) { return Ab + (size_t)row * DM; }, 1, Wt, 1024, n0, 1024, As, Bs);
            const size_t rbase = (size_t)(m0 + wm * 64 + 4 * hh) * 1024 + n0 + wn * 64 + r;
            float ov[2][2][16], ev[2][2][16], rsv[2][16], rev[2][16];
#pragma unroll
            for (int mi = 0; mi < 2; ++mi)
#pragma unroll
                for (int i = 0; i < 16; ++i) {
                    const int row = m0 + wm * 64 + mi * 32 + crow(i, hh);
                    rsv[mi][i] = ss_rstd(ss_in[row]);
                    rev[mi][i] = ss_rstd(sse[row]);
#pragma unroll
                    for (int ni = 0; ni < 2; ++ni) {
                        const size_t o = rbase + (size_t)(mi * 32 + (i & 3) + 8 * (i >> 2)) * 1024 + ni * 32;
                        ov[mi][ni][i] = P.out[o];
                        ev[mi][ni][i] = bf2f(ERAW[o]);
                    }
                }
            const float eg0 = eg[n0 + wn * 64 + r], eg1 = eg[n0 + wn * 64 + 32 + r];
            float sqv[2][16];
#pragma unroll
            for (int mi = 0; mi < 2; ++mi)
#pragma unroll
                for (int i = 0; i < 16; ++i) {
                    float sq = 0.f;
#pragma unroll
                    for (int ni = 0; ni < 2; ++ni) {
                        const size_t o = rbase + (size_t)(mi * 32 + (i & 3) + 8 * (i >> 2)) * 1024 + ni * 32;
                        const float gt = sigmoidf_(acc[mi][ni][i] * rsv[mi][i]);
                        const float e = ev[mi][ni][i] * rev[mi][i] * (ni ? eg1 : eg0);
                        const float hv = ov[mi][ni][i] + scale * gt * e;
                        P.out[o] = hv;
                        if (hb_out) hb_out[o] = f2bf(hv);
                        sq += hv * hv;
                    }
                    sqv[mi][i] = sq;
                }
            if (ss_out) {
#pragma unroll
                for (int mi = 0; mi < 2; ++mi)
#pragma unroll
                    for (int i = 0; i < 16; ++i) {
                        const float s = red32(sqv[mi][i]);
                        if (r == 0) atomicAdd(ss_out + (m0 + wm * 64 + mi * 32 + crow(i, hh)), ss_fix(s));
                    }
            }
        }
    };

    auto ph_6 = [&](bool dry) __attribute__((always_inline)) { if (!dry) resid_gemm(HB0, 1024, (const u16*)(ws + O_WABOUT), 1024, P.x, HB1, SS + 1 * MT, 1.f); else resid_gemm(HB0, 1024, (const u16*)(ws + O_WABOUT), 1024, P.out, (u16*)nullptr, (u64*)nullptr, 0.f); };
    auto ph_7 = [&](bool dry) __attribute__((always_inline)) { ffn_up_phase(0, HB1, SS + 1 * MT, SS + 6 * MT, !dry); };
    auto ph_8 = [&](bool dry) __attribute__((always_inline)) { if (!dry) resid_gemm((const u16*)(ws + O_ACT), 2816, (const u16*)(ws + O_WDOWN), 2816, P.out, HB0, SS + 2 * MT, 1.f); else resid_gemm((const u16*)(ws + O_ACT), 2816, (const u16*)(ws + O_WDOWN), 2816, P.out, (u16*)nullptr, (u64*)nullptr, 0.f); };
    auto ph_9 = [&](bool dry) __attribute__((always_inline)) { if (!dry) gate_phase(0, HB0, SS + 2 * MT, SS + 6 * MT, HB1, SS + 3 * MT, 1.f); else gate_phase(0, HB0, SS + 2 * MT, SS + 6 * MT, (u16*)nullptr, (u64*)nullptr, 0.f); };

    auto ph_10 = [&]() __attribute__((always_inline)) {
        const u16* Wt = (const u16*)(ws + O_WNSAIN);
        u16* QN = (u16*)(ws + O_QN); u16* KCVC = (u16*)(ws + O_KCVC); u16* KSN = (u16*)(ws + O_KSN); u16* KWN = (u16*)(ws + O_KWN);
        u16* VST = (u16*)(ws + O_VST); u16* VWT = (u16*)(ws + O_VWT); float* GT1 = (float*)(ws + O_GT1);
        const u64* ssin = SS + 3 * MT;
        for (int tile = blk; tile < tile_bound(128, 15); tile += nblk) {
            int mt, nt; if (!tile_decode(tile, 128, 15, mt, nt)) continue;
            const int m0 = mt * 128, n0 = nt * 128;
            f32x16 acc[2][2];
            const u16* Ab = HB1 + (size_t)m0 * DM;
            gemm_main<false>(acc, [&](int row) { return Ab + (size_t)row * DM; }, 1, Wt, 1024, n0, 1024, As, Bs);
            const int colw = n0 + wn * 64;
            float rsv[2][16];
#pragma unroll
            for (int mi = 0; mi < 2; ++mi)
#pragma unroll
                for (int i = 0; i < 16; ++i) rsv[mi][i] = ss_rstd(ssin[m0 + wm * 64 + mi * 32 + crow(i, hh)]);
#pragma unroll
            for (int mi = 0; mi < 2; ++mi) {
#pragma unroll
                for (int i4 = 0; i4 < 4; ++i4) {
                    float v0[4], v1[4];
                    const int rowb = m0 + wm * 64 + mi * 32 + 8 * i4 + 4 * hh;
#pragma unroll
                    for (int j = 0; j < 4; ++j) {
                        const float rs = rsv[mi][i4 * 4 + j];
                        v0[j] = acc[mi][0][i4 * 4 + j] * rs;
                        v1[j] = acc[mi][1][i4 * 4 + j] * rs;
                    }
                    const int bb = rowb >> 12, t = rowb & 4095;
                    if (nt < 8 || nt == 10 || nt == 12) {
                        const float* gn = (nt < 8) ? P.nsa_q_norm_g : (nt == 10 ? P.nsa_k_norm_g + 64 : P.nsa_k_norm_g + 128);
                        const float g0 = gn[r], g1 = gn[32 + r];
                        const float sc = (nt < 8) ? 0.125f * 1.4426950408889634f : 1.f;
#pragma unroll
                        for (int j = 0; j < 4; ++j) {
                            const float ss = red32(v0[j] * v0[j] + v1[j] * v1[j]);
                            const float rn = rsqrtf(ss * (1.f / 64.f) + EPS) * sc;
                            const u16 y0 = f2bf(v0[j] * rn * g0), y1 = f2bf(v1[j] * rn * g1);
                            if (nt < 8) { QN[(size_t)(rowb + j) * 1024 + colw + r] = y0; QN[(size_t)(rowb + j) * 1024 + colw + 32 + r] = y1; }
                            else {
                                u16* dst = (nt == 10) ? KSN : KWN;
                                dst[(size_t)(rowb + j) * 128 + wn * 64 + r] = y0; dst[(size_t)(rowb + j) * 128 + wn * 64 + 32 + r] = y1;
                            }
                        }
                    } else if (nt == 8 || nt == 9) {
                        const int cc = (nt - 8) * 128 + wn * 64;
#pragma unroll
                        for (int j = 0; j < 4; ++j) {
                            KCVC[(size_t)(rowb + j) * 256 + cc + r] = f2bf(v0[j]);
                            KCVC[(size_t)(rowb + j) * 256 + cc + 32 + r] = f2bf(v1[j]);
                        }
                    } else if (nt == 11 || nt == 13) {
                        u16* dst = (nt == 11) ? VST : VWT;
                        u32x2 o0 = {pk2(v0[0], v0[1]), pk2(v0[2], v0[3])}, o1 = {pk2(v1[0], v1[1]), pk2(v1[2], v1[3])};
                        *(u32x2*)(dst + ((size_t)(bb * 128 + wn * 64 + r)) * 4096 + t) = o0;
                        *(u32x2*)(dst + ((size_t)(bb * 128 + wn * 64 + 32 + r)) * 4096 + t) = o1;
                    } else {
                        if (wn == 0) {
#pragma unroll
                            for (int j = 0; j < 4; ++j) {
                                GT1[(size_t)(rowb + j) * 48 + r] = sigmoidf_(v0[j] + P.nsa_gate_b[r]);
                                if (r < 16) GT1[(size_t)(rowb + j) * 48 + 32 + r] = sigmoidf_(v1[j] + P.nsa_gate_b[32 + r]);
                            }
                        }
                    }
                }
            }
        }
    };

    auto ph_11 = [&]() __attribute__((always_inline)) {
        const u16* KCVC = (const u16*)(ws + O_KCVC);
        u16* HID = (u16*)(ws + O_HID);
        const float* B1 = (const float*)(ws + O_BIAS1);
        for (int tile = RB(5, blk, nblk); tile < 64; tile += RS(5, nblk)) {
            const int kv = tile >> 5, mt = (tile >> 1) & 15, nt = tile & 1, m0 = mt * 128, n0 = nt * 128;
            const u16* Wt = (const u16*)(ws + (kv ? O_WC1V : O_WC1K));
            f32x16 acc[2][2];
            gemm_main<false>(acc, [&](int row) {
                int R = m0 + row; R = R > 2039 ? 2039 : R;
                const int bg = R / 255, n = R - bg * 255, b = bg >> 1, g = bg & 1;
                return KCVC + ((size_t)b * 4096 + 16 * n) * 256 + kv * 128 + g * 64;
            }, 4, Wt, 2048, n0, 2048, As, Bs);
#pragma unroll
            for (int mi = 0; mi < 2; ++mi)
#pragma unroll
                for (int i = 0; i < 16; ++i) {
                    const int R = m0 + wm * 64 + mi * 32 + crow(i, hh);
#pragma unroll
                    for (int ni = 0; ni < 2; ++ni) {
                        const int col = n0 + wn * 64 + ni * 32 + r;
                        if (R < 2040) HID[((size_t)kv * 2048 + R) * 256 + col] = f2bf(gelu_tanh(acc[mi][ni][i] + B1[kv * 256 + col]));
                    }
                }
        }
    };

    auto ph_12 = [&]() __attribute__((always_inline)) {
        const u16* HID = (const u16*)(ws + O_HID);
        u16* KCN = (u16*)(ws + O_KCN);
        u16* VCT = (u16*)(ws + O_VCT);
        for (int tile = RB(6, blk, nblk); tile < 32; tile += RS(6, nblk)) {
            const int kv = tile >> 4, mt = tile & 15, m0 = mt * 128;
            const u16* Wt = (const u16*)(ws + (kv ? O_WC2V : O_WC2K));
            const u16* Ab = HID + ((size_t)kv * 2048 + m0) * 256;
            f32x16 acc[2][2];
            gemm_main<false>(acc, [&](int row) { return Ab + (size_t)row * 256; }, 1, Wt, 256, 0, 256, As, Bs);
            if (wn == 0) {
#pragma unroll
                for (int mi = 0; mi < 2; ++mi)
#pragma unroll
                    for (int i = 0; i < 16; ++i) {
                        const int R = m0 + wm * 64 + mi * 32 + crow(i, hh);
                        const float v0 = acc[mi][0][i], v1 = acc[mi][1][i];
                        const float ss = red32(v0 * v0 + v1 * v1);
                        if (R < 2040) {
                            const int bg = R / 255, n = R - bg * 255;
                            if (kv == 0) {
                                const float rn = rsqrtf(ss * (1.f / 64.f) + EPS);
                                KCN[((size_t)bg * 256 + n) * 64 + r] = f2bf(v0 * rn * P.nsa_k_norm_g[r]);
                                KCN[((size_t)bg * 256 + n) * 64 + 32 + r] = f2bf(v1 * rn * P.nsa_k_norm_g[32 + r]);
                            } else {
                                VCT[((size_t)bg * 64 + r) * 256 + n] = f2bf(v0);
                                VCT[((size_t)bg * 64 + 32 + r) * 256 + n] = f2bf(v1);
                            }
                        }
                    }
            }
        }
        for (int u = gtid; u < 8 * 64; u += gsz) { KCN[((size_t)(u >> 6) * 256 + 255) * 64 + (u & 63)] = 0; VCT[((size_t)u) * 256 + 255] = 0; }
    };

    auto ph_13 = [&]() __attribute__((always_inline)) {
        const u16* QN = (const u16*)(ws + O_QN);
        const u16* KCN = (const u16*)(ws + O_KCN);
        const u16* VCT = (const u16*)(ws + O_VCT);
        const float* GT1 = (const float*)(ws + O_GT1);
        u16* OCMP = (u16*)(ws + O_OCMP);
        u64* SEL = (u64*)(ws + O_SEL);
        float* sc_lds = (float*)smem + wave * (32 * 65);
        float mbound4;
        {
            float gq = fabsf(P.nsa_q_norm_g[lane]), gk = fabsf(P.nsa_k_norm_g[lane]);
#pragma unroll
            for (int off = 1; off < 64; off <<= 1) { gq = fmaxf(gq, __shfl_xor(gq, off)); gk = fmaxf(gk, __shfl_xor(gk, off)); }
            mbound4 = 8.f * 1.4426950408889634f * gq * gk * 1.02f;
        }
        for (int u0 = blk * 4; u0 < 1024; u0 += nblk * 4) {
            const int u = u0 + wave;
            const int qt = u & 127, bg = u >> 7, b = bg >> 1, g = bg & 1, tq = qt * 32, t = tq + r;
            const size_t row = (size_t)b * 4096 + t;
            const int nkt = (tq >> 9) + 1;
            u16* kl = (u16*)smem;
            u16* vl = kl + 256 * 72;
            __syncthreads();
#pragma unroll
            for (int c8 = 0; c8 < 8; ++c8) {
                const int c = tid + 256 * c8;
                *(u32x4*)(kl + (c >> 3) * 72 + (c & 7) * 8) = *(const u32x4*)(KCN + ((size_t)bg * 256 + (c >> 3)) * 64 + (c & 7) * 8);
                *(u32x4*)(vl + (c >> 5) * 264 + (c & 31) * 8) = *(const u32x4*)(VCT + ((size_t)bg * 64 + (c >> 5)) * 256 + (c & 31) * 8);
            }
            __syncthreads();
            f32x16 imp[2];
            imp[0] = zero16(); imp[1] = zero16();
            for (int hg = 0; hg < 8; ++hg) {
                const int head = g * 8 + hg;
                bf16x8 bq[4];
#pragma unroll
                for (int st = 0; st < 4; ++st) bq[st] = ld16(QN + row * 1024 + head * 64 + 16 * st + 8 * hh);
                f32x16 ao[2], ih[2];
                ao[0] = zero16(); ao[1] = zero16(); ih[0] = zero16(); ih[1] = zero16();
                float l = 0.f;
                for (int kt = 0; kt < nkt; ++kt) {
                    f32x16 s = zero16();
#pragma unroll
                    for (int st = 0; st < 4; ++st) s = MFMA(ld16(kl + (kt * 32 + r) * 72 + 16 * st + 8 * hh), bq[st], s);
#pragma unroll
                    for (int i = 0; i < 16; ++i) {
                        const int n = kt * 32 + crow(i, hh);
                        s[i] = (16 * n + 31 > t) ? 0.f : __builtin_amdgcn_exp2f(s[i] - mbound4);
                        l += s[i];
                    }
#pragma unroll
                    for (int s2 = 0; s2 < 2; ++s2) {
                        const bf16x8 pb = packp(s, s2);
#pragma unroll
                        for (int dt = 0; dt < 2; ++dt) {
                            const u16* vp = vl + (dt * 32 + r) * 264 + kt * 32 + 16 * s2 + 4 * hh;
                            ao[dt] = MFMA(ld8x2(vp, vp + 8), pb, ao[dt]);
                        }
#pragma unroll
                        for (int bt = 0; bt < 2; ++bt) {
                            const int sb = bt * 32 + r;
                            bf16x8 ov;
#pragma unroll
                            for (int j = 0; j < 8; ++j) {
                                const int n = kt * 32 + 16 * s2 + 8 * (j >> 2) + 4 * hh + (j & 3);
                                ov[j] = (n >= 4 * sb - 1 && n <= 4 * sb + 3) ? (short)0x3F80 : (short)0;
                            }
                            ih[bt] = MFMA(ov, pb, ih[bt]);
                        }
                    }
                }
                l += __shfl_xor(l, 32);
                const float inv = (t >= 31) ? 1.f / l : 0.f;
#pragma unroll
                for (int bt = 0; bt < 2; ++bt)
#pragma unroll
                    for (int i = 0; i < 16; ++i) imp[bt][i] += ih[bt][i] * inv;
                const float g0 = GT1[row * 48 + head * 3 + 0] * inv;
#pragma unroll
                for (int dt = 0; dt < 2; ++dt)
#pragma unroll
                    for (int i4 = 0; i4 < 4; ++i4) {
                        const int d = dt * 32 + 8 * i4 + 4 * hh;
                        u32x2 ov = {pk2(ao[dt][i4 * 4 + 0] * g0, ao[dt][i4 * 4 + 1] * g0), pk2(ao[dt][i4 * 4 + 2] * g0, ao[dt][i4 * 4 + 3] * g0)};
                        *(u32x2*)(OCMP + row * 1024 + head * 64 + d) = ov;
                    }
            }
            const int cur = t >> 6;
            __syncthreads();
#pragma unroll
            for (int bt = 0; bt < 2; ++bt)
#pragma unroll
                for (int i = 0; i < 16; ++i) {
                    const int sb = bt * 32 + crow(i, hh);
                    const bool forced = (sb == 0) || (sb == cur) || (sb == cur - 1);
                    const float sc = forced ? 1e30f : (sb <= cur ? imp[bt][i] : -1e30f);
                    sc_lds[r * 65 + sb] = sc;
                }
            __syncthreads();
            for (int q = 0; q < 32; ++q) {
                const float v = sc_lds[q * 65 + lane];
                int cnt = 0;
                for (int sp = 0; sp < 64; ++sp) {
                    const float c = __shfl(v, sp);
                    cnt += ((c > v) || (c == v && sp < lane)) ? 1 : 0;
                }
                const u64 mask = __ballot(cnt < 16);
                if (lane == 0) SEL[(size_t)bg * 4096 + tq + q] = mask;
            }
        }
        __syncthreads();
    };

    auto ph_14 = [&]() __attribute__((always_inline)) {
        const u16* QN = (const u16*)(ws + O_QN);
        const u16* KSN = (const u16*)(ws + O_KSN); const u16* KWN = (const u16*)(ws + O_KWN);
        const u16* VST = (const u16*)(ws + O_VST); const u16* VWT = (const u16*)(ws + O_VWT);
        const float* GT1 = (const float*)(ws + O_GT1);
        const u16* OCMP = (const u16*)(ws + O_OCMP);
        const u64* SEL = (const u64*)(ws + O_SEL);
        u16* OBUF = (u16*)(ws + O_OBUF);
        constexpr int KST = 72, VSTR = 40, BUFEL = 32 * KST + 64 * VSTR;
        float mbound;
        {
            float gq = fabsf(P.nsa_q_norm_g[lane]);
            float gk = fmaxf(fabsf(P.nsa_k_norm_g[64 + lane]), fabsf(P.nsa_k_norm_g[128 + lane]));
#pragma unroll
            for (int off = 1; off < 64; off <<= 1) { gq = fmaxf(gq, __shfl_xor(gq, off)); gk = fmaxf(gk, __shfl_xor(gk, off)); }
            mbound = 8.f * 1.4426950408889634f * gq * gk * 1.02f;
        }
        u16* stage = (u16*)smem;
        int* tl = (int*)(stage + 2 * BUFEL);
        for (int item = blk; item < 1024; item += nblk) {
            const int kk = item / nblk, v = item - kk * nblk;
            const int q0 = v & 127, bg = (nblk == 256) ? ((v >> 7) * 4 + kk) : (item >> 7);
            const int qt = (nblk == 256) ? ((kk & 1) ? 127 - q0 : q0) : (item & 127);
            const int b = bg >> 1, g = bg & 1, tq = qt * 32, t = tq + r;
            const size_t rowb = (size_t)b * 4096, row = rowb + t;
            const int h0 = g * 8 + wave * 2;
            bf16x8 bq[2][4];
#pragma unroll
            for (int hd = 0; hd < 2; ++hd)
#pragma unroll
                for (int st = 0; st < 4; ++st) bq[hd][st] = ld16(QN + row * 1024 + (h0 + hd) * 64 + 16 * st + 8 * hh);
            const u64 selm = SEL[(size_t)bg * 4096 + t];
            unsigned ulo = (unsigned)selm, uhi = (unsigned)(selm >> 32);
#pragma unroll
            for (int off = 1; off < 32; off <<= 1) { ulo |= __shfl_xor(ulo, off); uhi |= __shfl_xor(uhi, off); }
            const u64 uni = ((u64)uhi << 32) | ulo;
            __syncthreads();
            if (tid == 0) {
                int n = 0;
                for (int kt = (qt > 16 ? qt - 16 : 0); kt <= qt; ++kt) tl[n++] = kt | (1 << 16);
                const int jmax = (tq + 31) >> 6;
                for (int j = 0; j <= jmax; ++j)
                    if ((uni >> j) & 1ull) { tl[n++] = 2 * j; if ((2 * j + 1) * 32 <= tq + 31) tl[n++] = 2 * j + 1; }
                tl[159] = n;
            }
            __syncthreads();
            const int ntile = tl[159];
            u32x4 kr[3], vr[3];
            auto ldt = [&](u32x4& kreg, u32x4& vreg, int e) __attribute__((always_inline)) {
                const int kt = e & 0xffff, br = e >> 16;
                const u16* Kp = br ? KWN : KSN;
                const u16* Vp = br ? VWT : VST;
                kreg = *(const u32x4*)(Kp + (rowb + kt * 32 + (tid >> 3)) * 128 + g * 64 + (tid & 7) * 8);
                vreg = *(const u32x4*)(Vp + ((size_t)(b * 128 + g * 64 + (tid >> 2))) * 4096 + kt * 32 + (tid & 3) * 8);
            };
            auto stt = [&](const u32x4& kreg, const u32x4& vreg, int p) __attribute__((always_inline)) {
                u16* kb = stage + p * BUFEL;
                *(u32x4*)(kb + (tid >> 3) * KST + (tid & 7) * 8) = kreg;
                *(u32x4*)(kb + 32 * KST + (tid >> 2) * VSTR + (tid & 3) * 8) = vreg;
            };
            f32x16 res[2][2], ao[2][2];
#pragma unroll
            for (int hd = 0; hd < 2; ++hd)
#pragma unroll
                for (int dt = 0; dt < 2; ++dt) { res[hd][dt] = zero16(); ao[hd][dt] = zero16(); }
            float l[2] = {0.f, 0.f};
            int curbr = 1;
            auto finalize = [&](int br) __attribute__((always_inline)) {
#pragma unroll
                for (int hd = 0; hd < 2; ++hd) {
                    const float lt = l[hd] + __shfl_xor(l[hd], 32);
                    const float gsc = GT1[row * 48 + (h0 + hd) * 3 + 1 + br] / lt;
#pragma unroll
                    for (int dt = 0; dt < 2; ++dt)
#pragma unroll
                        for (int i = 0; i < 16; ++i) { res[hd][dt][i] += ao[hd][dt][i] * gsc; ao[hd][dt][i] = 0.f; }
                    l[hd] = 0.f;
                }
            };
            ldt(kr[0], vr[0], tl[0]);
            if (1 < ntile) ldt(kr[1], vr[1], tl[1]);
            if (2 < ntile) ldt(kr[2], vr[2], tl[2]);
            stt(kr[0], vr[0], 0);
            if (3 < ntile) ldt(kr[0], vr[0], tl[3]);
            __syncthreads();
            for (int it0 = 0; it0 < ntile; it0 += 6) {
#pragma unroll
            for (int uu = 0; uu < 6; ++uu) {
                const int it = it0 + uu;
                if (it < ntile) {
                const int e = tl[it], kt = e & 0xffff, br = e >> 16, p = uu & 1;
                if (br != curbr) { finalize(curbr); curbr = br; }
                const u16* kb = stage + p * BUFEL;
                const u16* vb = kb + 32 * KST;
                f32x16 s[2];
                s[0] = zero16(); s[1] = zero16();
#pragma unroll
                for (int st = 0; st < 4; ++st) {
                    const bf16x8 a = *(const bf16x8*)(kb + r * KST + 16 * st + 8 * hh);
                    s[0] = MFMA(a, bq[0][st], s[0]);
                    s[1] = MFMA(a, bq[1][st], s[1]);
                }
                const bool bsel = br ? true : (((selm >> (kt >> 1)) & 1ull) != 0);
                const bool interior = (kt * 32 + 31 <= tq) && (!br || kt * 32 >= tq - 480);
                const bool needmask = !interior || (__ballot(!bsel) != 0ull);
                if (needmask) {
                    if (interior) {
#pragma unroll
                        for (int i = 0; i < 16; ++i) { s[0][i] = bsel ? s[0][i] : -1e30f; s[1][i] = bsel ? s[1][i] : -1e30f; }
                    } else {
#pragma unroll
                        for (int i = 0; i < 16; ++i) {
                            const int pk = kt * 32 + crow(i, hh);
                            bool ok = bsel && (pk <= t);
                            if (br) ok = ok && (pk > t - 512);
                            if (!ok) { s[0][i] = -1e30f; s[1][i] = -1e30f; }
                        }
                    }
                }
#pragma unroll
                for (int hd = 0; hd < 2; ++hd) {
                    float ps = 0.f;
#pragma unroll
                    for (int i = 0; i < 16; ++i) { s[hd][i] = __builtin_amdgcn_exp2f(s[hd][i] - mbound); ps += s[hd][i]; }
                    l[hd] += ps;
                }
#pragma unroll
                for (int s2 = 0; s2 < 2; ++s2) {
                    const bf16x8 pb0 = packp(s[0], s2), pb1 = packp(s[1], s2);
#pragma unroll
                    for (int dt = 0; dt < 2; ++dt) {
                        const u16* vp = vb + (dt * 32 + r) * VSTR + 16 * s2 + 4 * hh;
                        const bf16x8 av = ld8x2(vp, vp + 8);
                        ao[0][dt] = MFMA(av, pb0, ao[0][dt]);
                        ao[1][dt] = MFMA(av, pb1, ao[1][dt]);
                    }
                }
                if (it + 1 < ntile) {
                    stt(kr[(uu + 1) % 3], vr[(uu + 1) % 3], p ^ 1);
                    if (it + 4 < ntile) ldt(kr[(uu + 1) % 3], vr[(uu + 1) % 3], tl[it + 4]);
                }
                __syncthreads();
                }
            }
            }
            finalize(curbr);
#pragma unroll
            for (int hd = 0; hd < 2; ++hd)
#pragma unroll
                for (int dt = 0; dt < 2; ++dt)
#pragma unroll
                    for (int i4 = 0; i4 < 4; ++i4) {
                        const int d = dt * 32 + 8 * i4 + 4 * hh;
                        const u32x2 oc = *(const u32x2*)(OCMP + row * 1024 + (h0 + hd) * 64 + d);
                        u32x2 ov = {pk2(res[hd][dt][i4 * 4 + 0] + bflo(oc.x), res[hd][dt][i4 * 4 + 1] + bfhi(oc.x)),
                                    pk2(res[hd][dt][i4 * 4 + 2] + bflo(oc.y), res[hd][dt][i4 * 4 + 3] + bfhi(oc.y))};
                        *(u32x2*)(OBUF + row * 1024 + (h0 + hd) * 64 + d) = ov;
                    }
        }
        __syncthreads();
    };

    auto ph_15 = [&](bool dry) __attribute__((always_inline)) { if (!dry) resid_gemm((const u16*)(ws + O_OBUF), 1024, (const u16*)(ws + O_WNSAOUT), 1024, P.out, HB0, SS + 4 * MT, 1.f); else resid_gemm((const u16*)(ws + O_OBUF), 1024, (const u16*)(ws + O_WNSAOUT), 1024, P.out, (u16*)nullptr, (u64*)nullptr, 0.f); };
    auto ph_16 = [&](bool dry) __attribute__((always_inline)) { ffn_up_phase(1, HB0, SS + 4 * MT, SS + 7 * MT, !dry); };
    auto ph_17 = [&](bool dry) __attribute__((always_inline)) { if (!dry) resid_gemm((const u16*)(ws + O_ACT), 2816, (const u16*)(ws + O_WDOWN + SZ_WDOWN), 2816, P.out, HB1, SS + 5 * MT, 1.f); else resid_gemm((const u16*)(ws + O_ACT), 2816, (const u16*)(ws + O_WDOWN + SZ_WDOWN), 2816, P.out, (u16*)nullptr, (u64*)nullptr, 0.f); };
    auto ph_18 = [&](bool dry) __attribute__((always_inline)) { gate_phase(1, HB1, SS + 5 * MT, SS + 7 * MT, (u16*)nullptr, (u64*)nullptr, dry ? 0.f : 1.f); };
#define RUNA(k) do { if (PH(k)) ph_##k(); GSYNC(); if ((DUPMASK >> (k)) & 1) { ph_##k(); GSYNC(); } } while (0)
#define RUNB(k) do { if (PH(k)) ph_##k(false); GSYNC(); if ((DUPMASK >> (k)) & 1) { ph_##k(true); GSYNC(); } } while (0)
    RUNA(0); RUNA(1); RUNA(2); RUNA(3); RUNA(4); RUNA(5);
    RUNB(6); RUNB(7); RUNB(8); RUNB(9);
    RUNA(10); RUNA(11); RUNA(12); RUNA(13); RUNA(14);
    RUNB(15); RUNB(16); RUNB(17);
    if (PH(18)) ph_18(false);
    if ((DUPMASK >> 18) & 1) { GSYNC(); ph_18(true); }
}

extern "C" void kernel_launch(void* const* d_in, const int* in_sizes, int n_in, void* d_out, int out_size, void* d_ws, size_t ws_size, hipStream_t stream) {
    static int grid_blocks = 0;
    if (grid_blocks == 0) {
        if (n_in != 32 || out_size != MT * DM || ws_size < WS_NEED) {
            fprintf(stderr, "kernel_launch: unexpected problem (n_in %d, out %d, ws %zu)\n", n_in, out_size, ws_size);
            grid_blocks = -1;
            return;
        }
        int dev = 0, cus = 0, per_cu = 0;
        (void)hipGetDevice(&dev);
        (void)hipDeviceGetAttribute(&cus, hipDeviceAttributeMultiprocessorCount, dev);
        (void)hipOccupancyMaxActiveBlocksPerMultiprocessor(&per_cu, fwd_megakernel, 256, 0);
        if (per_cu < 1) per_cu = 1;
        if (per_cu > 1) per_cu = 1;
        grid_blocks = cus * per_cu;
    }
    if (grid_blocks < 0) return;
    Params p{};
    const float** pp = (const float**)&p;
    for (int i = 0; i < 32; ++i) pp[i] = (const float*)d_in[i];
    p.out = (float*)d_out;
    p.ws = (char*)d_ws;
    (void)hipMemsetAsync((char*)d_ws + O_BAR, 0, 16384, stream);
    void* args[] = {&p};
    hipError_t e = hipLaunchCooperativeKernel((void*)fwd_megakernel, dim3(grid_blocks), dim3(256), args, 0, stream);
    if (e != hipSuccess) fprintf(stderr, "cooperative launch failed: %s (grid %d)\n", hipGetErrorString(e), grid_blocks);
}
```

```cpp
#include <hip/hip_runtime.h>
#include <hip/hip_cooperative_groups.h>
#include <cstdio>
#include <type_traits>
namespace cg = cooperative_groups;

#define DI __device__ __forceinline__
typedef unsigned short u16;
typedef unsigned long long u64;
typedef __attribute__((ext_vector_type(8))) short bf16x8;
typedef __attribute__((ext_vector_type(16))) float f32x16;
typedef __attribute__((ext_vector_type(4))) unsigned u32x4;
typedef __attribute__((ext_vector_type(2))) unsigned u32x2;
#define MFMA(a, b, c) __builtin_amdgcn_mfma_f32_32x32x16_bf16((a), (b), (c), 0, 0, 0)

#ifndef USE_CG
#define USE_CG 0
#endif
#if USE_CG
#define GSYNC() grid.sync()
#else
#define GSYNC() ctr_barrier((unsigned*)(P.ws + O_BAR) + 4096 - 64, bar_gen)
#endif
#ifndef RESTRICT
#define RESTRICT 0
#endif
#define RB(k, id, n) ((((RESTRICT) >> (k)) & 1) && (n) > 256 ? ((id) < 256 ? (id) : 0x3fffffff) : (id))
#define RS(k, n) ((((RESTRICT) >> (k)) & 1) && (n) > 256 ? 256 : (n))
#ifndef P1REP
#define P1REP 1
#endif
#ifndef DUPMASK
#define DUPMASK 0
#endif
#ifndef XCD_CONSEC
#define XCD_CONSEC 1
#endif
#ifndef MINW
#define MINW 1
#endif
#ifndef ONLY
#define PH(k) true
#else
#define PH(k) ((ONLY) == (k))
#endif
constexpr int MT = 16384, DM = 1024, TS = 4096;
constexpr float EPS = 1e-6f;

constexpr size_t O_WABIN = 0;
constexpr size_t O_WABOUT = O_WABIN + 3200ull * 1024 * 2;
constexpr size_t O_WNSAIN = O_WABOUT + 1024ull * 1024 * 2;
constexpr size_t O_WC1K = O_WNSAIN + 1920ull * 1024 * 2;
constexpr size_t O_WC1V = O_WC1K + 256ull * 2048 * 2;
constexpr size_t O_WC2K = O_WC1V + 256ull * 2048 * 2;
constexpr size_t O_WC2V = O_WC2K + 128ull * 256 * 2;
constexpr size_t O_WNSAOUT = O_WC2V + 128ull * 256 * 2;
constexpr size_t O_WUP = O_WNSAOUT + 1024ull * 1024 * 2;
constexpr size_t SZ_WUP = 5632ull * 1024 * 2;
constexpr size_t O_WDOWN = O_WUP + 2 * SZ_WUP;
constexpr size_t SZ_WDOWN = 1024ull * 2816 * 2;
constexpr size_t O_WPLE = O_WDOWN + 2 * SZ_WDOWN;
constexpr size_t SZ_WPLE = 1024ull * 256 * 2;
constexpr size_t O_WGATE = O_WPLE + 2 * SZ_WPLE;
constexpr size_t SZ_WGATE = 1024ull * 1024 * 2;
constexpr size_t O_ROPEC = O_WGATE + 2 * SZ_WGATE;
constexpr size_t O_ROPES = O_ROPEC + 4096ull * 32 * 4;
constexpr size_t O_BIAS1 = O_ROPES + 4096ull * 32 * 4;
constexpr size_t O_BAR = O_BIAS1 + 4096;
constexpr size_t O_SS = O_BAR + 16384;
constexpr size_t O_HB0 = O_SS + 8ull * MT * 8;
constexpr size_t O_HB1 = O_HB0 + (size_t)MT * DM * 2;
constexpr size_t O_BIG = O_HB1 + (size_t)MT * DM * 2;
constexpr size_t O_VT0 = O_BIG;
constexpr size_t O_KT = O_VT0 + 4ull * 1024 * 4096 * 2;
constexpr size_t O_QM = O_KT + 4ull * 256 * 4096 * 2;
constexpr size_t O_KM = O_QM + (size_t)MT * 256 * 2;
constexpr size_t O_KWT = O_KM + (size_t)MT * 256 * 2;
constexpr size_t O_GS = O_KWT + 4ull * 256 * 4096 * 2;
constexpr size_t O_BL = O_GS + 16ull * 4096 * 4;
constexpr size_t O_PM = O_BL + 16ull * 4096 * 4;
constexpr size_t O_BLAST = O_PM + 16ull * 4096 * 4;
constexpr size_t O_GC = O_BLAST + 4096;
constexpr size_t O_MS = O_GC + 4096;
constexpr size_t O_NC = O_MS + 4096;
constexpr size_t O_NS = O_NC + 1024ull * 64 * 4;
constexpr size_t O_GF = O_NS + 1024ull * 64 * 4;
constexpr size_t O_KVT = O_GF + (size_t)MT * 8 * 4;
constexpr size_t O_RT = O_KVT + 512ull * 8192 * 4;
constexpr size_t O_UT = O_RT + 512ull * 8192 * 2;
constexpr size_t O_L0END = O_UT + 1024ull * 8192 * 4;
constexpr size_t O_CT = O_HB1;
constexpr size_t O_ACT = O_BIG;
constexpr size_t O_ERAW = O_ACT + (size_t)MT * 2816 * 2;
constexpr size_t O_FFNEND = O_ERAW + (size_t)MT * DM * 2;
constexpr size_t O_QN = O_BIG;
constexpr size_t O_KCVC = O_QN + (size_t)MT * DM * 2;
constexpr size_t O_KSN = O_KCVC + (size_t)MT * 256 * 2;
constexpr size_t O_KWN = O_KSN + (size_t)MT * 128 * 2;
constexpr size_t O_VST = O_KWN + (size_t)MT * 128 * 2;
constexpr size_t O_VWT = O_VST + (size_t)MT * 128 * 2;
constexpr size_t O_GT1 = O_VWT + (size_t)MT * 128 * 2;
constexpr size_t O_HID = O_GT1 + (size_t)MT * 48 * 4;
constexpr size_t O_KCN = O_HID + 2ull * 2048 * 256 * 2;
constexpr size_t O_VCT = O_KCN + 8ull * 256 * 64 * 2;
constexpr size_t O_SEL = O_VCT + 8ull * 64 * 256 * 2;
constexpr size_t O_OBUF = O_SEL + 8ull * 4096 * 8;
constexpr size_t O_L1END = O_OBUF + (size_t)MT * DM * 2;
constexpr size_t O_OCMP = O_HB1;
constexpr size_t WS_NEED = 256ull << 20;
static_assert(O_L0END <= WS_NEED && O_FFNEND <= WS_NEED && O_L1END <= WS_NEED, "workspace overflow");

struct Params {
    const float *x, *p, *ab_norm_g, *ab_w_in, *ab_conv_w, *ab_conv_b, *ab_ret_norm_g, *ab_ig_b, *ab_fg_b, *ab_m_norm_g, *ab_w_out;
    const float *nsa_norm_g, *nsa_w_in, *nsa_q_norm_g, *nsa_k_norm_g, *nsa_cmp_pos_k, *nsa_cmp_pos_v, *w1k, *w2k, *w1v, *w2v, *nsa_gate_b, *nsa_w_out;
    const float *ffn_norm_g, *ffn_w_up, *ffn_conv_w, *ffn_conv_b, *ffn_w_down, *ple_w, *ple_norm_g, *ple_gate_norm_g, *ple_w_gate;
    float* out;
    char* ws;
};

DI float bf2f(u16 b) { return __uint_as_float(((unsigned)b) << 16); }
typedef float f32x2_t __attribute__((ext_vector_type(2)));
typedef __bf16 bf16x2_t __attribute__((ext_vector_type(2)));
DI unsigned pk2(float a, float b) { f32x2_t v = {a, b}; bf16x2_t o = __builtin_convertvector(v, bf16x2_t); return __builtin_bit_cast(unsigned, o); }
DI u16 f2bf(float x) { return (u16)(pk2(x, 0.f) & 0xffffu); }
DI float bflo(unsigned u) { return __uint_as_float(u << 16); }
DI float bfhi(unsigned u) { return __uint_as_float(u & 0xffff0000u); }
DI int crow(int i, int h) { return (i & 3) + 8 * (i >> 2) + 4 * h; }
DI float sigmoidf_(float x) { return 1.f / (1.f + __expf(-x)); }
DI float gelu_tanh(float x) { float y = 0.7978845608028654f * (x + 0.044715f * x * x * x); float t = 1.f - 2.f / (__expf(2.f * y) + 1.f); return 0.5f * x * (1.f + t); }
DI float red32(float v) { v += __shfl_xor(v, 1); v += __shfl_xor(v, 2); v += __shfl_xor(v, 4); v += __shfl_xor(v, 8); v += __shfl_xor(v, 16); return v; }
DI bf16x8 ld16(const u16* p) { return *(const bf16x8*)p; }
DI bf16x8 ld8x2(const u16* p0, const u16* p1) { u32x2 a = *(const u32x2*)p0, b = *(const u32x2*)p1; u32x4 v = {a.x, a.y, b.x, b.y}; return __builtin_bit_cast(bf16x8, v); }
DI bf16x8 packp(const f32x16& x, int s) {
    u32x4 v = {pk2(x[8 * s + 0], x[8 * s + 1]), pk2(x[8 * s + 2], x[8 * s + 3]), pk2(x[8 * s + 4], x[8 * s + 5]), pk2(x[8 * s + 6], x[8 * s + 7])};
    return __builtin_bit_cast(bf16x8, v);
}
DI f32x16 zero16() { f32x16 z; for (int i = 0; i < 16; ++i) z[i] = 0.f; return z; }
DI u64 ss_fix(float s) { return (u64)(s * 1048576.f + 0.5f); }
DI float ss_rstd(u64 v) { return rsqrtf((float)v * (1.f / (1048576.f * 1024.f)) + EPS); }
DI float gamma_log(int h) { return log1pf(-exp2f(-5.f - (float)h)); }


#define XB_TMO      128
#define XB_XCNT(j)  (256  + 64 * (j))
#define XB_XSUB(j)  (1280 + 64 * (j))
#define XB_XGEN(j)  (2304 + 64 * (j))
#define XB_TOP      3328
#define XB_TOPGEN   3392
#define XCD_BAR_WORDS 3456
#define XB_SPIN_CAP (1u << 22)
#define LAS __attribute__((address_space(3)))
DI unsigned xb_ld(unsigned* p) { return __hip_atomic_load(p, __ATOMIC_RELAXED, __HIP_MEMORY_SCOPE_AGENT); }
DI unsigned xb_add(unsigned* p, unsigned v) { return __hip_atomic_fetch_add(p, v, __ATOMIC_RELAXED, __HIP_MEMORY_SCOPE_AGENT); }
DI unsigned xb_xcc_id() { return (unsigned)__builtin_amdgcn_s_getreg((3 << 11) | 20) & 0xFu; }
#define XB_SPIN(cond, bar) do { unsigned _sp = 0; while (cond) { __builtin_amdgcn_s_sleep(1); \
    if ((++_sp & 255u) == 0u) { if (xb_ld(&(bar)[XB_TMO])) break; if (_sp > XB_SPIN_CAP) { atomicAdd(&(bar)[XB_TMO], 1u); break; } } } } while (0)
struct XcdBarrier { unsigned* bar; unsigned x; volatile LAS unsigned* st; };
DI XcdBarrier xcd_barrier_post(unsigned* bar, volatile LAS unsigned* st) {
    XcdBarrier b; b.bar = bar; b.x = xb_xcc_id(); b.st = st;
    if (threadIdx.x == 0) (void)xb_add(&bar[XB_XCNT(b.x)], 1u);
    return b;
}
DI void xcd_barrier_complete(unsigned* bar, unsigned x, unsigned& nloc, unsigned& nx) {
    const unsigned G = gridDim.x * gridDim.y * gridDim.z;
    unsigned sum, cnt, mine, sp = 0u;
    for (;;) {
        sum = 0u; cnt = 0u; mine = 0u;
#pragma unroll
        for (unsigned j = 0; j < 16; ++j) { const unsigned c = xb_ld(&bar[XB_XCNT(j)]); sum += c; cnt += (c > 0u) ? 1u : 0u; mine = (j == x) ? c : mine; }
        if (sum == G) break;
        __builtin_amdgcn_s_sleep(1);
        if ((++sp & 255u) == 0u) { if (xb_ld(&bar[XB_TMO])) break; if (sp > XB_SPIN_CAP) { atomicAdd(&bar[XB_TMO], 1u); break; } }
    }
    nloc = mine > 0u ? mine : 1u; nx = cnt > 0u ? cnt : 1u;
}
DI void xcd_barrier(const XcdBarrier& b) {
    asm volatile("s_waitcnt vmcnt(0)" ::: "memory");
    __syncthreads();
    if (threadIdx.x == 0) {
        unsigned* bar = b.bar;
        __builtin_amdgcn_s_waitcnt(0);
        unsigned nloc = b.st[0], nx = b.st[1];
        if (nloc == 0u) { xcd_barrier_complete(bar, b.x, nloc, nx); b.st[0] = nloc; b.st[1] = nx; }
        const unsigned old = xb_add(&bar[XB_XSUB(b.x)], 1u);
        const unsigned gen = old / nloc;
        if (old + 1u == (gen + 1u) * nloc) {
            __builtin_amdgcn_fence(__ATOMIC_RELEASE, "agent");
            asm volatile("s_waitcnt vmcnt(0)" ::: "memory");
            const unsigned og = xb_add(&bar[XB_TOP], 1u);
            const unsigned tg = og / nx;
            if (og + 1u == (tg + 1u) * nx) xb_add(&bar[XB_TOPGEN], 1u);
            else XB_SPIN(xb_ld(&bar[XB_TOPGEN]) == tg, bar);
            __builtin_amdgcn_fence(__ATOMIC_ACQUIRE, "agent");
            xb_add(&bar[XB_XGEN(b.x)], 1u);
            asm volatile("s_waitcnt vmcnt(0)" ::: "memory");
        } else {
            XB_SPIN(xb_ld(&bar[XB_XGEN(b.x)]) == gen, bar);
            __builtin_amdgcn_fence(__ATOMIC_ACQUIRE, "agent");
            asm volatile("s_waitcnt vmcnt(0)" ::: "memory");
        }
    }
    __syncthreads();
}

DI void ctr_barrier(unsigned* ctr, unsigned& gen) {
    asm volatile("s_waitcnt vmcnt(0)" ::: "memory");
    __syncthreads();
    gen += 1u;
    if (threadIdx.x == 0) {
        __builtin_amdgcn_fence(__ATOMIC_RELEASE, "agent");
        asm volatile("s_waitcnt vmcnt(0)" ::: "memory");
        (void)__hip_atomic_fetch_add(ctr, 1u, __ATOMIC_RELAXED, __HIP_MEMORY_SCOPE_AGENT);
        const unsigned target = gen * gridDim.x;
        unsigned sp = 0;
        while (__hip_atomic_load(ctr, __ATOMIC_RELAXED, __HIP_MEMORY_SCOPE_AGENT) < target) {
            __builtin_amdgcn_s_sleep(1);
            if (++sp > (1u << 24)) break;
        }
        __builtin_amdgcn_fence(__ATOMIC_ACQUIRE, "agent");
        asm volatile("s_waitcnt vmcnt(0)" ::: "memory");
    }
    __syncthreads();
}

constexpr int LDT = 72;
constexpr int LDS_BYTES = 2 * 2 * 128 * LDT * 2;

template <bool AF32, class RowA>
DI void gemm_main(f32x16 (&acc)[2][2], RowA rowA, const int kmulA, const u16* __restrict__ Bf, int ldb, int n0, int K, u16* As, u16*  ) {
    constexpr int PD = 4;
    constexpr int BUFE = 128 * LDT;
    const int tid = threadIdx.x, lane = tid & 63, wave = tid >> 6;
    const int wm = wave >> 1, wn = wave & 1, r = lane & 31, hh = lane >> 5;
#pragma unroll
    for (int mi = 0; mi < 2; ++mi)
#pragma unroll
        for (int ni = 0; ni < 2; ++ni) acc[mi][ni] = zero16();
    typedef typename std::conditional<AF32, float, u16>::type TA;
    const int row0 = tid >> 3, kc = (tid & 7) * 8;
    const TA* pa[4];
#pragma unroll
    for (int i = 0; i < 4; ++i) pa[i] = (const TA*)rowA(row0 + 32 * i) + kc;
    const int kbn = ldb >> 4;
    const u16* pb = Bf + ((size_t)((n0 + wn * 64) >> 5) * kbn * 64 + lane) * 8;
    u32x4 ra[PD][4];
    bf16x8 rb[PD][8];
    auto loadA = [&](u32x4 (&xa)[4], int k0) __attribute__((always_inline)) {
#pragma unroll
        for (int i = 0; i < 4; ++i) {
            if constexpr (AF32) {
                const float* q = (const float*)pa[i] + k0 * kmulA;
                const float4 v0 = *(const float4*)q, v1 = *(const float4*)(q + 4);
                u32x4 t = {pk2(v0.x, v0.y), pk2(v0.z, v0.w), pk2(v1.x, v1.y), pk2(v1.z, v1.w)};
                xa[i] = t;
            } else {
                xa[i] = *(const u32x4*)((const u16*)pa[i] + k0 * kmulA);
            }
        }
    };
    auto loadB = [&](bf16x8 (&xb)[8], int k0) __attribute__((always_inline)) {
#pragma unroll
        for (int ni = 0; ni < 2; ++ni)
#pragma unroll
            for (int ks = 0; ks < 4; ++ks) xb[ni * 4 + ks] = *(const bf16x8*)(pb + ((size_t)ni * kbn + (k0 >> 4) + ks) * 512);
    };
    auto stores = [&](const u32x4 (&xa)[4], int p) __attribute__((always_inline)) {
        u16* sa = As + p * BUFE + row0 * LDT + kc;
#pragma unroll
        for (int i = 0; i < 4; ++i) *(u32x4*)(sa + 32 * i * LDT) = xa[i];
    };
    const int nk = K >> 6;
#pragma unroll
    for (int d = 0; d < PD; ++d) { loadA(ra[d], d * 64); loadB(rb[d], d * 64); }
    __syncthreads();
    stores(ra[0], 0);
    if (PD < nk) loadA(ra[0], PD * 64);
    __syncthreads();
    const u16* fa = As + (wm * 64 + r) * LDT + hh * 8;
    for (int kb = 0; kb < nk; kb += PD) {
#pragma unroll
        for (int u = 0; u < PD; ++u) {
            const int k = kb + u, p = u & 1;
#pragma unroll
            for (int ks = 0; ks < 4; ++ks) {
                bf16x8 a[2];
#pragma unroll
                for (int mi = 0; mi < 2; ++mi) a[mi] = *(const bf16x8*)(fa + p * BUFE + mi * 32 * LDT + ks * 16);
#pragma unroll
                for (int mi = 0; mi < 2; ++mi)
#pragma unroll
                    for (int ni = 0; ni < 2; ++ni) acc[mi][ni] = MFMA(a[mi], rb[u][ni * 4 + ks], acc[mi][ni]);
            }
            if (k + PD < nk) loadB(rb[u], (k + PD) * 64);
            if (k + 1 < nk) {
                stores(ra[(u + 1) % PD], p ^ 1);
                if (k + 1 + PD < nk) loadA(ra[(u + 1) % PD], (k + 1 + PD) * 64);
            }
            __syncthreads();
        }
    }
}

DI bool tile_decode(int v, int MTl, int NTl, int& mt, int& nt) {
    mt = v / NTl; nt = v - mt * NTl;
    return v < MTl * NTl;
}
DI int tile_bound(int MTl, int NTl) { return MTl * NTl; }

template <class RowMap>
DI void tconv(const float* __restrict__ W, int K, int N, int Npad, const float* __restrict__ g, u16* __restrict__ out, RowMap rm, int gtid, int gsz) {
    const int total = (K / 32) * Npad, kb_per_n = K >> 4;
    for (int u = gtid; u < total; u += gsz) {
        const int n = u % Npad, k32 = u / Npad;
        float v[32];
        if (n < N) {
            const float* wp = W + (size_t)(k32 * 32) * N + n;
#pragma unroll
            for (int j = 0; j < 32; ++j) v[j] = wp[(size_t)j * N];
            if (g) {
#pragma unroll
                for (int j = 0; j < 32; ++j) v[j] *= g[k32 * 32 + j];
            }
        } else {
#pragma unroll
            for (int j = 0; j < 32; ++j) v[j] = 0.f;
        }
        const int np = rm(n), nb = np >> 5, rr = np & 31;
#pragma unroll
        for (int q = 0; q < 4; ++q) {
            u32x4 o = {pk2(v[8 * q + 0], v[8 * q + 1]), pk2(v[8 * q + 2], v[8 * q + 3]), pk2(v[8 * q + 4], v[8 * q + 5]), pk2(v[8 * q + 6], v[8 * q + 7])};
            const size_t blkid = (size_t)nb * kb_per_n + k32 * 2 + (q >> 1);
            *(u32x4*)(out + (blkid * 64 + (q & 1) * 32 + rr) * 8) = o;
        }
    }
}
DI void zfill16(u16* p, size_t n_elems, int gtid, int gsz) {
    u32x4 z = {0u, 0u, 0u, 0u};
    for (size_t u = gtid; u < n_elems / 8; u += gsz) *(u32x4*)(p + u * 8) = z;
}

__global__ void __launch_bounds__(256, MINW) fwd_megakernel(Params P) {
    cg::grid_group grid = cg::this_grid();
    __shared__ __attribute__((aligned(16))) char smem[LDS_BYTES];
    __shared__ uint4 xb_words;
    if (threadIdx.x == 0) xb_words = make_uint4(0u, 0u, 0u, 0u);
    __syncthreads();
    unsigned bar_gen = 0u;
    const XcdBarrier xbar = xcd_barrier_post((unsigned*)(P.ws + O_BAR), (volatile LAS unsigned*)&xb_words);
    u16* As = (u16*)smem;
    u16* Bs = As + 128 * LDT;
    const int tid = threadIdx.x, lane = tid & 63, wave = tid >> 6;
    const int wm = wave >> 1, wn = wave & 1, r = lane & 31, hh = lane >> 5;
    const int nblk = gridDim.x, blk = blockIdx.x;
    const int gtid = blk * 256 + tid, gsz = nblk * 256;
    const int gw = blk * 4 + wave, ngw = nblk * 4;
    char* ws = P.ws;
    u64* SS = (u64*)(ws + O_SS);
    u16* HB0 = (u16*)(ws + O_HB0);
    u16* HB1 = (u16*)(ws + O_HB1);
    const float* ROPEC = (const float*)(ws + O_ROPEC);
    const float* ROPES = (const float*)(ws + O_ROPES);

    auto ph_0 = [&]() __attribute__((always_inline)) {
        auto idm = [](int n) { return n; };
        auto upm = [](int n) { return n < 2816 ? (n >> 6) * 128 + (n & 63) : ((n - 2816) >> 6) * 128 + 64 + ((n - 2816) & 63); };
        tconv(P.ab_w_in, 1024, 3080, 3200, P.ab_norm_g, (u16*)(ws + O_WABIN), idm, gtid, gsz);
        tconv(P.ab_w_out, 1024, 1024, 1024, (const float*)nullptr, (u16*)(ws + O_WABOUT), idm, gtid, gsz);
        tconv(P.nsa_w_in, 1024, 1840, 1920, P.nsa_norm_g, (u16*)(ws + O_WNSAIN), idm, gtid, gsz);
        tconv(P.w1k, 2048, 256, 256, (const float*)nullptr, (u16*)(ws + O_WC1K), idm, gtid, gsz);
        tconv(P.w1v, 2048, 256, 256, (const float*)nullptr, (u16*)(ws + O_WC1V), idm, gtid, gsz);
        tconv(P.w2k, 256, 64, 128, (const float*)nullptr, (u16*)(ws + O_WC2K), idm, gtid, gsz);
        tconv(P.w2v, 256, 64, 128, (const float*)nullptr, (u16*)(ws + O_WC2V), idm, gtid, gsz);
        tconv(P.nsa_w_out, 1024, 1024, 1024, (const float*)nullptr, (u16*)(ws + O_WNSAOUT), idm, gtid, gsz);
        for (int i = 0; i < 2; ++i) {
            tconv(P.ffn_w_up + (size_t)i * 1024 * 5632, 1024, 5632, 5632, P.ffn_norm_g + i * 1024, (u16*)(ws + O_WUP + i * SZ_WUP), upm, gtid, gsz);
            tconv(P.ffn_w_down + (size_t)i * 2816 * 1024, 2816, 1024, 1024, (const float*)nullptr, (u16*)(ws + O_WDOWN + i * SZ_WDOWN), idm, gtid, gsz);
            tconv(P.ple_w + (size_t)i * 256 * 1024, 256, 1024, 1024, (const float*)nullptr, (u16*)(ws + O_WPLE + i * SZ_WPLE), idm, gtid, gsz);
            tconv(P.ple_w_gate + (size_t)i * 1024 * 1024, 1024, 1024, 1024, P.ple_gate_norm_g + i * 1024, (u16*)(ws + O_WGATE + i * SZ_WGATE), idm, gtid, gsz);
        }
        {
            float* rc = (float*)(ws + O_ROPEC);
            float* rs = (float*)(ws + O_ROPES);
            for (int u = gtid; u < 4096 * 32; u += gsz) {
                const int pos = u >> 5, d = u & 31;
                const float inv = powf(10000.f, -(float)d / 32.f);
                const float ang = (float)pos * inv;
                const double a = (double)ang;
                const double n = rint(a * 0.15915494309189535);
                const float rr = (float)(a - n * 6.283185307179586);
                rc[u] = cosf(rr);
                rs[u] = sinf(rr);
            }
        }
        for (int u = gw; u < 512; u += ngw) {
            const int kv = u >> 8, j = u & 255;
            const float* pos = kv ? P.nsa_cmp_pos_v : P.nsa_cmp_pos_k;
            const float* W1 = kv ? P.w1v : P.w1k;
            float s = 0.f;
            for (int k = lane; k < 2048; k += 64) s += pos[k] * W1[(size_t)k * 256 + j];
            s = red32(s); s += __shfl_xor(s, 32);
            if (lane == 0) ((float*)(ws + O_BIAS1))[u] = s;
        }
        for (int u = gtid; u < 7 * MT; u += gsz) SS[MT + u] = 0ull;
        for (int row = gw; row < MT; row += ngw) {
            const float4* xr = (const float4*)(P.x + (size_t)row * DM);
            float s = 0.f;
#pragma unroll
            for (int j = 0; j < 4; ++j) {
                const float4 v = xr[lane + 64 * j];
                s += v.x * v.x + v.y * v.y + v.z * v.z + v.w * v.w;
                u32x2 o = {pk2(v.x, v.y), pk2(v.z, v.w)};
                *(u32x2*)(HB0 + (size_t)row * DM + (lane + 64 * j) * 4) = o;
            }
            s = red32(s); s += __shfl_xor(s, 32);
            if (lane == 0) SS[row] = ss_fix(s);
        }
    };

    auto ph_1 = [&]() __attribute__((always_inline)) {
        u16* Z0 = (u16*)P.out;
        u16* VT0 = (u16*)(ws + O_VT0);
        u16* KT = (u16*)(ws + O_KT);
        float* GF = (float*)(ws + O_GF);
        const u16* Wt = (const u16*)(ws + O_WABIN);
        for (int tile = blk; tile < tile_bound(128, 25); tile += nblk) {
            int mt, nt; if (!tile_decode(tile, 128, 25, mt, nt)) continue;
            const int m0 = mt * 128, n0 = nt * 128;
            f32x16 acc[2][2];
            const u16* Ab = HB0 + (size_t)m0 * DM;
            gemm_main<false>(acc, [&](int row) { return Ab + (size_t)row * DM; }, 1, Wt, 1024, n0, 1024, As, Bs);
            const int colw = n0 + wn * 64;
            float rsv[2][16], cv[2][16], sv[2][16];
#pragma unroll
            for (int mi = 0; mi < 2; ++mi)
#pragma unroll
                for (int i = 0; i < 16; ++i) {
                    const int row = m0 + wm * 64 + mi * 32 + crow(i, hh);
                    rsv[mi][i] = ss_rstd(SS[row]);
                    cv[mi][i] = (nt < 4) ? ROPEC[(row & 4095) * 32 + r] : 0.f;
                    sv[mi][i] = (nt < 4) ? ROPES[(row & 4095) * 32 + r] : 0.f;
                }
#pragma unroll
            for (int mi = 0; mi < 2; ++mi) {
#pragma unroll
                for (int i4 = 0; i4 < 4; ++i4) {
                    float v0[4], v1[4];
                    const int rowb = m0 + wm * 64 + mi * 32 + 8 * i4 + 4 * hh;
#pragma unroll
                    for (int j = 0; j < 4; ++j) {
                        const float rs = rsv[mi][i4 * 4 + j];
                        v0[j] = acc[mi][0][i4 * 4 + j] * rs;
                        v1[j] = acc[mi][1][i4 * 4 + j] * rs;
                    }
                    const int bb = rowb >> 12, t = rowb & 4095;
                    if (nt < 4) {
                        const int head = (colw & 255) >> 6;
                        const float lg = gamma_log(head);
#pragma unroll
                        for (int j = 0; j < 4; ++j) {
                            const float c = cv[mi][i4 * 4 + j], s = sv[mi][i4 * 4 + j];
                            float y0 = v0[j] * c - v1[j] * s, y1 = v0[j] * s + v1[j] * c;
                            if (nt >= 2) { const float sc = 0.125f * __expf(-(float)(((t + j) & 127) + 1) * lg); y0 *= sc; y1 *= sc; }
                            v0[j] = y0; v1[j] = y1;
                            Z0[(size_t)(rowb + j) * 2048 + colw + r] = f2bf(y0);
                            Z0[(size_t)(rowb + j) * 2048 + colw + 32 + r] = f2bf(y1);
                        }
                        if (nt >= 2) {
                            const int kc = colw - 256;
                            u32x2 o0 = {pk2(v0[0], v0[1]), pk2(v0[2], v0[3])}, o1 = {pk2(v1[0], v1[1]), pk2(v1[2], v1[3])};
                            *(u32x2*)(KT + ((size_t)(bb * 256 + kc + r)) * 4096 + t) = o0;
                            *(u32x2*)(KT + ((size_t)(bb * 256 + kc + 32 + r)) * 4096 + t) = o1;
                        }
                    } else if ((nt >= 4 && nt < 8) || (nt >= 16 && nt < 20)) {
                        const int vc = (nt < 8) ? (colw - 512) : (512 + colw - 2048);
                        u32x2 o0 = {pk2(v0[0], v0[1]), pk2(v0[2], v0[3])}, o1 = {pk2(v1[0], v1[1]), pk2(v1[2], v1[3])};
                        *(u32x2*)(VT0 + ((size_t)(bb * 1024 + vc + r)) * 4096 + t) = o0;
                        *(u32x2*)(VT0 + ((size_t)(bb * 1024 + vc + 32 + r)) * 4096 + t) = o1;
                    } else if (nt < 24) {
                        const int zc = (nt < 12) ? (512 + colw - 1024) : (nt < 16) ? (1024 + colw - 1536) : (1536 + colw - 2560);
#pragma unroll
                        for (int j = 0; j < 4; ++j) {
                            Z0[(size_t)(rowb + j) * 2048 + zc + r] = f2bf(v0[j]);
                            Z0[(size_t)(rowb + j) * 2048 + zc + 32 + r] = f2bf(v1[j]);
                        }
                    } else {
                        if (wn == 0 && r < 8) {
#pragma unroll
                            for (int j = 0; j < 4; ++j) GF[(size_t)(rowb + j) * 8 + r] = v0[j];
                        }
                    }
                }
            }
        }
    };

    auto ph_2 = [&]() __attribute__((always_inline)) {
        const u16* Z0 = (const u16*)P.out;
        const float* GF = (const float*)(ws + O_GF);
        float* GS = (float*)(ws + O_GS); float* BL = (float*)(ws + O_BL); float* PM = (float*)(ws + O_PM);
        float* BLAST = (float*)(ws + O_BLAST); float* GC = (float*)(ws + O_GC); float* NC = (float*)(ws + O_NC);
        u16* QM = (u16*)(ws + O_QM); u16* KM = (u16*)(ws + O_KM); u16* KWT = (u16*)(ws + O_KWT);
        for (int u = gw; u < 1024; u += ngw) {
            const int bh = u >> 6, c = u & 63, b = bh >> 2, h = bh & 3, t0 = c * 64;
            const size_t rowb = (size_t)b * 4096;
            const size_t row = rowb + t0 + lane;
            const float f = GF[row * 8 + 4 + h] + P.ab_fg_b[h];
            const float fc = fminf(f, 0.f) - log1pf(__expf(-fabsf(f)));
            const float ic = GF[row * 8 + h] + P.ab_ig_b[h];
            float bcs = fc;
#pragma unroll
            for (int off = 1; off < 64; off <<= 1) { const float o = __shfl_up(bcs, off); if (lane >= off) bcs += o; }
            const float g = ic - bcs;
            float pm = g;
#pragma unroll
            for (int off = 1; off < 64; off <<= 1) { const float o = __shfl_up(pm, off); if (lane >= off) pm = fmaxf(pm, o); }
            const float G = __shfl(pm, 63), bl = __shfl(bcs, 63);
            const float w = __expf(g - G);
            GS[bh * 4096 + t0 + lane] = g; BL[bh * 4096 + t0 + lane] = bcs; PM[bh * 4096 + t0 + lane] = pm;
            if (lane == 0) { BLAST[bh * 64 + c] = bl; GC[bh * 64 + c] = G; }
            {
                const int ch = 256 + h * 64 + lane;
                const float w0 = P.ab_conv_w[ch], w1 = P.ab_conv_w[512 + ch], w2 = P.ab_conv_w[1024 + ch], w3 = P.ab_conv_w[1536 + ch], cb = P.ab_conv_b[ch];
                const u16* zp = Z0 + 1024 + ch;
                float x0 = 0.f, x1 = 0.f, x2 = 0.f;
                if (t0 > 0) { x0 = bf2f(zp[(rowb + t0 - 3) * 2048]); x1 = bf2f(zp[(rowb + t0 - 2) * 2048]); x2 = bf2f(zp[(rowb + t0 - 1) * 2048]); }
                float nsum = 0.f;
                float xr[64];
#pragma unroll
                for (int s = 0; s < 64; ++s) xr[s] = bf2f(zp[(rowb + t0 + s) * 2048]);
#pragma unroll
                for (int s8 = 0; s8 < 8; ++s8) {
                    float vw[8];
#pragma unroll
                    for (int j = 0; j < 8; ++j) {
                        const int s = s8 * 8 + j;
                        const float x3 = xr[s];
                        float v = cb + w0 * x0 + w1 * x1 + w2 * x2 + w3 * x3;
                        v = v / (1.f + __expf(-v));
                        x0 = x1; x1 = x2; x2 = x3;
                        KM[(rowb + t0 + s) * 256 + h * 64 + lane] = f2bf(v);
                        const float wsv = __shfl(w, s);
                        vw[j] = v * wsv; nsum += vw[j];
                    }
                    u32x4 o = {pk2(vw[0], vw[1]), pk2(vw[2], vw[3]), pk2(vw[4], vw[5]), pk2(vw[6], vw[7])};
                    *(u32x4*)(KWT + ((size_t)(b * 256 + h * 64 + lane)) * 4096 + t0 + s8 * 8) = o;
                }
                NC[(size_t)u * 64 + lane] = nsum;
            }
            {
                const int ch = h * 64 + lane;
                const float w0 = P.ab_conv_w[ch], w1 = P.ab_conv_w[512 + ch], w2 = P.ab_conv_w[1024 + ch], w3 = P.ab_conv_w[1536 + ch], cb = P.ab_conv_b[ch];
                const u16* zp = Z0 + 1024 + ch;
                float x0 = 0.f, x1 = 0.f, x2 = 0.f;
                if (t0 > 0) { x0 = bf2f(zp[(rowb + t0 - 3) * 2048]); x1 = bf2f(zp[(rowb + t0 - 2) * 2048]); x2 = bf2f(zp[(rowb + t0 - 1) * 2048]); }
                float xr[64];
#pragma unroll
                for (int s = 0; s < 64; ++s) xr[s] = bf2f(zp[(rowb + t0 + s) * 2048]);
#pragma unroll
                for (int s = 0; s < 64; ++s) {
                    const float x3 = xr[s];
                    float v = cb + w0 * x0 + w1 * x1 + w2 * x2 + w3 * x3;
                    v = v / (1.f + __expf(-v));
                    x0 = x1; x1 = x2; x2 = x3;
                    QM[(rowb + t0 + s) * 256 + h * 64 + lane] = f2bf(v * 0.125f);
                }
            }
        }
    };

    auto ph_3 = [&]() __attribute__((always_inline)) {
        const u16* VT0 = (const u16*)(ws + O_VT0);
        const u16* KT = (const u16*)(ws + O_KT);
        const u16* KWT = (const u16*)(ws + O_KWT);
        float* KVT = (float*)(ws + O_KVT);
        float* UT = (float*)(ws + O_UT);
        for (int u = gw; u < 2048 + 4096; u += ngw) {
            f32x16 a0 = zero16(), a1 = zero16();
            if (u < 2048) {
                const int dt = u & 3, c = (u >> 2) & 31, bh = u >> 7, b = bh >> 2, h = bh & 3, t0 = c * 128;
                const u16* va = VT0 + ((size_t)(b * 1024 + h * 128 + dt * 32 + r)) * 4096 + t0 + 8 * hh;
                const u16* kb = KT + ((size_t)(b * 256 + h * 64 + r)) * 4096 + t0 + 8 * hh;
#pragma unroll
                for (int st = 0; st < 8; ++st) {
                    const bf16x8 a = ld16(va + 16 * st);
                    a0 = MFMA(a, ld16(kb + 16 * st), a0);
                    a1 = MFMA(a, ld16(kb + 32 * 4096 + 16 * st), a1);
                }
                const float cdec = __expf(128.f * gamma_log(h));
                float* o = KVT + (size_t)(bh * 32 + c) * 8192;
#pragma unroll
                for (int i = 0; i < 16; ++i) {
                    o[(dt * 32 + crow(i, hh)) * 64 + r] = cdec * a0[i];
                    o[(dt * 32 + crow(i, hh)) * 64 + 32 + r] = cdec * a1[i];
                }
            } else {
                const int v = u - 2048;
                const int dt = v & 3, c = (v >> 2) & 63, bh = v >> 8, b = bh >> 2, h = bh & 3, t0 = c * 64;
                const u16* va = VT0 + ((size_t)(b * 1024 + 512 + h * 128 + dt * 32 + r)) * 4096 + t0 + 8 * hh;
                const u16* kb = KWT + ((size_t)(b * 256 + h * 64 + r)) * 4096 + t0 + 8 * hh;
#pragma unroll
                for (int st = 0; st < 4; ++st) {
                    const bf16x8 a = ld16(va + 16 * st);
                    a0 = MFMA(a, ld16(kb + 16 * st), a0);
                    a1 = MFMA(a, ld16(kb + 32 * 4096 + 16 * st), a1);
                }
                float* o = UT + (size_t)(bh * 64 + c) * 8192;
#pragma unroll
                for (int i = 0; i < 16; ++i) {
                    o[(dt * 32 + crow(i, hh)) * 64 + r] = a0[i];
                    o[(dt * 32 + crow(i, hh)) * 64 + 32 + r] = a1[i];
                }
            }
        }
    };

    auto ph_4 = [&]() __attribute__((always_inline)) {
        const float* KVT = (const float*)(ws + O_KVT);
        const float* UT = (const float*)(ws + O_UT);
        const float* NC = (const float*)(ws + O_NC);
        const float* BLAST = (const float*)(ws + O_BLAST);
        const float* GC = (const float*)(ws + O_GC);
        u16* RT = (u16*)(ws + O_RT);
        u16* CT = (u16*)(ws + O_CT);
        float* MS = (float*)(ws + O_MS);
        float* NS = (float*)(ws + O_NS);
        for (int e = gtid; e < 131072 * 2 + 1024; e += gsz) {
            if (e < 131072) {
                const int bh = e >> 13, idx = e & 8191;
                const float cdec = __expf(128.f * gamma_log(bh & 3));
                float R = 0.f;
                float kvv[32];
#pragma unroll
                for (int c = 0; c < 32; ++c) kvv[c] = KVT[(size_t)(bh * 32 + c) * 8192 + idx];
#pragma unroll
                for (int c = 0; c < 32; ++c) {
                    RT[(size_t)(bh * 32 + c) * 8192 + idx] = f2bf(R);
                    R = cdec * R + kvv[c];
                }
            } else if (e < 262144) {
                const int e2 = e - 131072, bh = e2 >> 13, idx = e2 & 8191;
                float C = 0.f, m = 0.f;
                float utv[64];
#pragma unroll
                for (int c = 0; c < 64; ++c) utv[c] = UT[(size_t)(bh * 64 + c) * 8192 + idx];
#pragma unroll
                for (int c = 0; c < 64; ++c) {
                    const float G = GC[bh * 64 + c];
                    const float M = fmaxf(m, G);
                    const float dC = __expf(m - M), dU = __expf(G - M);
                    CT[(size_t)(bh * 64 + c) * 8192 + idx] = f2bf(C);
                    if (idx == 0) MS[bh * 64 + c] = m;
                    C = dC * C + dU * utv[c];
                    m = BLAST[bh * 64 + c] + M;
                }
            } else {
                const int e2 = e - 262144, bh = e2 >> 6, dk = e2 & 63;
                float n = 0.f, m = 0.f;
                for (int c = 0; c < 64; ++c) {
                    const float G = GC[bh * 64 + c];
                    const float M = fmaxf(m, G);
                    const float dC = __expf(m - M), dU = __expf(G - M);
                    NS[(size_t)(bh * 64 + c) * 64 + dk] = n;
                    n = dC * n + dU * NC[(size_t)(bh * 64 + c) * 64 + dk];
                    m = BLAST[bh * 64 + c] + M;
                }
            }
        }
    };

    auto ph_5 = [&]() __attribute__((always_inline)) {
        const u16* Z0 = (const u16*)P.out;
        const u16* VT0 = (const u16*)(ws + O_VT0);
        const u16* RT = (const u16*)(ws + O_RT);
        const u16* CT = (const u16*)(ws + O_CT);
        const u16* QM = (const u16*)(ws + O_QM);
        const u16* KM = (const u16*)(ws + O_KM);
        const float* GS = (const float*)(ws + O_GS); const float* BL = (const float*)(ws + O_BL); const float* PM = (const float*)(ws + O_PM);
        const float* MS = (const float*)(ws + O_MS); const float* NS = (const float*)(ws + O_NS);
        u16* MIX = HB0;
        for (int u = gw; u < 4096; u += ngw) {
            f32x16 o[4];
            if (u < 2048) {
                const int qt = u & 3, c = (u >> 2) & 31, bh = u >> 7, b = bh >> 2, h = bh & 3, t0 = c * 128, tq = t0 + qt * 32;
                const size_t rowb = (size_t)b * 4096;
                bf16x8 bq[4];
#pragma unroll
                for (int st = 0; st < 4; ++st) bq[st] = ld16(Z0 + (rowb + tq + r) * 2048 + h * 64 + 16 * st + 8 * hh);
                const u16* rt = RT + (size_t)(bh * 32 + c) * 8192;
#pragma unroll
                for (int dt = 0; dt < 4; ++dt) {
                    o[dt] = zero16();
#pragma unroll
                    for (int st = 0; st < 4; ++st) o[dt] = MFMA(ld16(rt + (dt * 32 + r) * 64 + 16 * st + 8 * hh), bq[st], o[dt]);
                }
                for (int kt = 0; kt <= qt; ++kt) {
                    f32x16 s = zero16();
#pragma unroll
                    for (int st = 0; st < 4; ++st) s = MFMA(ld16(Z0 + (rowb + t0 + kt * 32 + r) * 2048 + 256 + h * 64 + 16 * st + 8 * hh), bq[st], s);
                    if (kt == qt) {
#pragma unroll
                        for (int i = 0; i < 16; ++i) if (crow(i, hh) > r) s[i] = 0.f;
                    }
#pragma unroll
                    for (int s2 = 0; s2 < 2; ++s2) {
                        const bf16x8 pb = packp(s, s2);
#pragma unroll
                        for (int dt = 0; dt < 4; ++dt) {
                            const u16* vp = VT0 + ((size_t)(b * 1024 + h * 128 + dt * 32 + r)) * 4096 + t0 + kt * 32 + 16 * s2 + 4 * hh;
                            o[dt] = MFMA(ld8x2(vp, vp + 8), pb, o[dt]);
                        }
                    }
                }
                const float qdec = __expf((float)(qt * 32 + r + 1) * gamma_log(h));
                float ss = 0.f;
#pragma unroll
                for (int dt = 0; dt < 4; ++dt)
#pragma unroll
                    for (int i = 0; i < 16; ++i) { o[dt][i] *= qdec; ss += o[dt][i] * o[dt][i]; }
                ss += __shfl_xor(ss, 32);
                const float rs = rsqrtf(ss * (1.f / 128.f) + EPS);
                const size_t row = rowb + tq + r;
#pragma unroll
                for (int dt = 0; dt < 4; ++dt)
#pragma unroll
                    for (int i4 = 0; i4 < 4; ++i4) {
                        const int dv = dt * 32 + 8 * i4 + 4 * hh;
                        const u32x2 gv = *(const u32x2*)(Z0 + row * 2048 + 512 + h * 128 + dv);
                        const float g0 = bflo(gv.x), g1 = bfhi(gv.x), g2 = bflo(gv.y), g3 = bfhi(gv.y);
                        const float4 ng = *(const float4*)(P.ab_ret_norm_g + h * 128 + dv);
                        const float y0 = o[dt][i4 * 4 + 0] * rs * ng.x * (g0 * sigmoidf_(g0));
                        const float y1 = o[dt][i4 * 4 + 1] * rs * ng.y * (g1 * sigmoidf_(g1));
                        const float y2 = o[dt][i4 * 4 + 2] * rs * ng.z * (g2 * sigmoidf_(g2));
                        const float y3 = o[dt][i4 * 4 + 3] * rs * ng.w * (g3 * sigmoidf_(g3));
                        u32x2 ov = {pk2(y0, y1), pk2(y2, y3)};
                        *(u32x2*)(MIX + row * 1024 + h * 128 + dv) = ov;
                    }
            } else {
                const int v = u - 2048;
                const int qt = v & 1, c = (v >> 1) & 63, bh = v >> 7, b = bh >> 2, h = bh & 3, t0 = c * 64, tq = t0 + qt * 32;
                const size_t rowb = (size_t)b * 4096;
                const size_t row = rowb + tq + r;
                const float mc = MS[bh * 64 + c];
                const float Ml = fmaxf(mc, PM[bh * 4096 + tq + r]);
                const float bl = BL[bh * 4096 + tq + r];
                const float wint = __expf(mc - Ml);
                bf16x8 bq[4];
#pragma unroll
                for (int st = 0; st < 4; ++st) bq[st] = ld16(QM + row * 256 + h * 64 + 16 * st + 8 * hh);
                const u16* ct = CT + (size_t)(bh * 64 + c) * 8192;
#pragma unroll
                for (int dt = 0; dt < 4; ++dt) {
                    o[dt] = zero16();
#pragma unroll
                    for (int st = 0; st < 4; ++st) o[dt] = MFMA(ld16(ct + (dt * 32 + r) * 64 + 16 * st + 8 * hh), bq[st], o[dt]);
#pragma unroll
                    for (int i = 0; i < 16; ++i) o[dt][i] *= wint;
                }
                float qn = 0.f;
                {
                    const u16* qp = QM + row * 256 + h * 64 + 32 * hh;
                    const float* np = NS + (size_t)(bh * 64 + c) * 64 + 32 * hh;
#pragma unroll
                    for (int j = 0; j < 32; ++j) qn += bf2f(qp[j]) * np[j];
                    qn += __shfl_xor(qn, 32);
                }
                float den = 0.f;
                for (int kt = 0; kt <= qt; ++kt) {
                    f32x16 s = zero16();
#pragma unroll
                    for (int st = 0; st < 4; ++st) s = MFMA(ld16(KM + (rowb + t0 + kt * 32 + r) * 256 + h * 64 + 16 * st + 8 * hh), bq[st], s);
#pragma unroll
                    for (int i4 = 0; i4 < 4; ++i4) {
                        const float4 gg = *(const float4*)(GS + bh * 4096 + t0 + kt * 32 + 8 * i4 + 4 * hh);
                        const float ga[4] = {gg.x, gg.y, gg.z, gg.w};
#pragma unroll
                        for (int j = 0; j < 4; ++j) {
                            const int i = i4 * 4 + j;
                            float d = __expf(ga[j] - Ml);
                            if (kt == qt && crow(i, hh) > r) d = 0.f;
                            s[i] *= d; den += s[i];
                        }
                    }
#pragma unroll
                    for (int s2 = 0; s2 < 2; ++s2) {
                        const bf16x8 pb = packp(s, s2);
#pragma unroll
                        for (int dt = 0; dt < 4; ++dt) {
                            const u16* vp = VT0 + ((size_t)(b * 1024 + 512 + h * 128 + dt * 32 + r)) * 4096 + t0 + kt * 32 + 16 * s2 + 4 * hh;
                            o[dt] = MFMA(ld8x2(vp, vp + 8), pb, o[dt]);
                        }
                    }
                }
                den += __shfl_xor(den, 32);
                den += wint * qn;
                const float dinv = 1.f / fmaxf(fabsf(den), __expf(-(bl + Ml)));
                float ss = 0.f;
#pragma unroll
                for (int dt = 0; dt < 4; ++dt)
#pragma unroll
                    for (int i = 0; i < 16; ++i) { o[dt][i] *= dinv; ss += o[dt][i] * o[dt][i]; }
                ss += __shfl_xor(ss, 32);
                const float rs = rsqrtf(ss * (1.f / 128.f) + EPS);
#pragma unroll
                for (int dt = 0; dt < 4; ++dt)
#pragma unroll
                    for (int i4 = 0; i4 < 4; ++i4) {
                        const int dv = dt * 32 + 8 * i4 + 4 * hh;
                        const u32x2 gv = *(const u32x2*)(Z0 + row * 2048 + 1536 + h * 128 + dv);
                        const float4 ng = *(const float4*)(P.ab_m_norm_g + h * 128 + dv);
                        const float y0 = o[dt][i4 * 4 + 0] * rs * ng.x * sigmoidf_(bflo(gv.x));
                        const float y1 = o[dt][i4 * 4 + 1] * rs * ng.y * sigmoidf_(bfhi(gv.x));
                        const float y2 = o[dt][i4 * 4 + 2] * rs * ng.z * sigmoidf_(bflo(gv.y));
                        const float y3 = o[dt][i4 * 4 + 3] * rs * ng.w * sigmoidf_(bfhi(gv.y));
                        u32x2 ov = {pk2(y0, y1), pk2(y2, y3)};
                        *(u32x2*)(MIX + row * 1024 + 512 + h * 128 + dv) = ov;
                    }
            }
        }
    };

    auto resid_gemm = [&](const u16* A, int lda, const u16* Wt, int K, const float* resid, u16* hb_out, u64* ss_out, float scale) __attribute__((always_inline)) {
        for (int tile = blk; tile < tile_bound(128, 8); tile += nblk) {
            int mt, nt; if (!tile_decode(tile, 128, 8, mt, nt)) continue;
            const int m0 = mt * 128, n0 = nt * 128;
            f32x16 acc[2][2];
            const u16* Ab = A + (size_t)m0 * lda;
            gemm_main<false>(acc, [&](int row) { return Ab + (size_t)row * lda; }, 1, Wt, K, n0, K, As, Bs);
            const size_t rbase = (size_t)(m0 + wm * 64 + 4 * hh) * 1024 + n0 + wn * 64 + r;
            float rv[2][2][16];
#pragma unroll
            for (int mi = 0; mi < 2; ++mi)
#pragma unroll
                for (int ni = 0; ni < 2; ++ni)
#pragma unroll
                    for (int i = 0; i < 16; ++i) rv[mi][ni][i] = resid[rbase + (size_t)(mi * 32 + (i & 3) + 8 * (i >> 2)) * 1024 + ni * 32];
            float sqv[2][16];
#pragma unroll
            for (int mi = 0; mi < 2; ++mi)
#pragma unroll
                for (int i = 0; i < 16; ++i) {
                    float sq = 0.f;
#pragma unroll
                    for (int ni = 0; ni < 2; ++ni) {
                        const size_t o = rbase + (size_t)(mi * 32 + (i & 3) + 8 * (i >> 2)) * 1024 + ni * 32;
                        const float hv = rv[mi][ni][i] + scale * acc[mi][ni][i];
                        P.out[o] = hv;
                        if (hb_out) hb_out[o] = f2bf(hv);
                        sq += hv * hv;
                    }
                    sqv[mi][i] = sq;
                }
            if (ss_out) {
#pragma unroll
                for (int mi = 0; mi < 2; ++mi)
#pragma unroll
                    for (int i = 0; i < 16; ++i) {
                        const float s = red32(sqv[mi][i]);
                        if (r == 0) atomicAdd(ss_out + (m0 + wm * 64 + mi * 32 + crow(i, hh)), ss_fix(s));
                    }
            }
        }
    };
    auto ffn_up_phase = [&](int li, const u16* hb, const u64* ss_in, u64* sse, bool do_ss) __attribute__((always_inline)) {
        const u16* Wt = (const u16*)(ws + O_WUP + li * SZ_WUP);
        const u16* Wp = (const u16*)(ws + O_WPLE + li * SZ_WPLE);
        u16* ACT = (u16*)(ws + O_ACT);
        u16* ERAW = (u16*)(ws + O_ERAW);
        const float* cw = P.ffn_conv_w + li * 3 * 2816;
        const float* cb = P.ffn_conv_b + li * 2816;
        const float* pin = P.p + (size_t)li * MT * 256;
        u16* SA = (u16*)smem;
        u16* SB = SA + 128 * 66;
        for (int pass = 0; pass < 2; ++pass)
        for (int tile = blk; tile < (pass ? tile_bound(128, 8) : tile_bound(132, 44)); tile += nblk) {
            f32x16 acc[2][2];
            int mt, nt; if (!tile_decode(tile, pass ? 128 : 132, pass ? 8 : 44, mt, nt)) continue;
            if (pass == 0) {
                const int b = mt / 33, jt = mt % 33, tok0 = jt * 126 - 2, n0 = nt * 128;
                const u16* Ab = hb + (size_t)b * 4096 * DM;
                gemm_main<false>(acc, [&](int row) { int tk = tok0 + row; tk = tk < 0 ? 0 : (tk > 4095 ? 4095 : tk); return Ab + (size_t)tk * DM; }, 1, Wt, 1024, n0, 1024, As, Bs);
                __syncthreads();
#pragma unroll
                for (int mi = 0; mi < 2; ++mi)
#pragma unroll
                    for (int i = 0; i < 16; ++i) {
                        const int rl = wm * 64 + mi * 32 + crow(i, hh);
                        const int tok = tok0 + rl;
                        const int tkc = tok < 0 ? 0 : (tok > 4095 ? 4095 : tok);
                        const float rs = ss_rstd(ss_in[b * 4096 + tkc]);
#pragma unroll
                        for (int ni = 0; ni < 2; ++ni) {
                            float v = acc[mi][ni][i] * rs;
                            if (tok < 0) v = 0.f;
                            (wn == 0 ? SA : SB)[rl * 66 + ni * 32 + r] = f2bf(v);
                        }
                    }
                __syncthreads();
                for (int e = tid; e < 126 * 64; e += 256) {
                    const int rl = 2 + (e >> 6), cl = e & 63, tok = tok0 + rl;
                    if (tok < 4096) {
                        const int f = nt * 64 + cl;
                        const float a = cb[f] + cw[f] * bf2f(SA[(rl - 2) * 66 + cl]) + cw[2816 + f] * bf2f(SA[(rl - 1) * 66 + cl]) + cw[5632 + f] * bf2f(SA[rl * 66 + cl]);
                        ACT[((size_t)b * 4096 + tok) * 2816 + f] = f2bf(gelu_tanh(a) * bf2f(SB[rl * 66 + cl]));
                    }
                }
            } else {
                const int m0 = mt * 128, n0 = nt * 128;
                const float* Ab = pin + (size_t)m0 * 256;
                gemm_main<true>(acc, [&](int row) { return Ab + (size_t)row * 256; }, 1, Wp, 256, n0, 256, As, Bs);
#pragma unroll
                for (int mi = 0; mi < 2; ++mi)
#pragma unroll
                    for (int i = 0; i < 16; ++i) {
                        const size_t row = m0 + wm * 64 + mi * 32 + crow(i, hh);
                        float sq = 0.f;
#pragma unroll
                        for (int ni = 0; ni < 2; ++ni) {
                            const int col = n0 + wn * 64 + ni * 32 + r;
                            const float v = acc[mi][ni][i];
                            ERAW[row * 1024 + col] = f2bf(v);
                            sq += v * v;
                        }
                        sq = red32(sq); if (do_ss && r == 0) atomicAdd(sse + row, ss_fix(sq));
                    }
            }
        }
    };
    auto gate_phase = [&](int li, const u16* hb, const u64* ss_in, const u64* sse, u16* hb_out, u64* ss_out, float scale) __attribute__((always_inline)) {
        const u16* Wt = (const u16*)(ws + O_WGATE + li * SZ_WGATE);
        const u16* ERAW = (const u16*)(ws + O_ERAW);
        const float* eg = P.ple_norm_g + li * 1024;
        for (int tile = blk; tile < tile_bound(128, 8); tile += nblk) {
            int mt, nt; if (!tile_decode(tile, 128, 8, mt, nt)) continue;
            const int m0 = mt * 128, n0 = nt * 128;
            f32x16 acc[2][2];
            const u16* Ab = hb + (size_t)m0 * DM;
            gemm_main<false>(acc, [&](int row) { return Ab + (size_t)row * DM; }, 1, Wt, 1024, n0, 1024, As, Bs);
            const size_t rbase = (size_t)(m0 + wm * 64 + 4 * hh) * 1024 + n0 + wn * 64 + r;
            float ov[2][2][16], ev[2][2][16], rsv[2][16], rev[2][16];
#pragma unroll
            for (int mi = 0; mi < 2; ++mi)
#pragma unroll
                for (int i = 0; i < 16; ++i) {
                    const int row = m0 + wm * 64 + mi * 32 + crow(i, hh);
                    rsv[mi][i] = ss_rstd(ss_in[row]);
                    rev[mi][i] = ss_rstd(sse[row]);
#pragma unroll
                    for (int ni = 0; ni < 2; ++ni) {
                        const size_t o = rbase + (size_t)(mi * 32 + (i & 3) + 8 * (i >> 2)) * 1024 + ni * 32;
                        ov[mi][ni][i] = P.out[o];
                        ev[mi][ni][i] = bf2f(ERAW[o]);
                    }
                }
            const float eg0 = eg[n0 + wn * 64 + r], eg1 = eg[n0 + wn * 64 + 32 + r];
            float sqv[2][16];
#pragma unroll
            for (int mi = 0; mi < 2; ++mi)
#pragma unroll
                for (int i = 0; i < 16; ++i) {
                    float sq = 0.f;
#pragma unroll
                    for (int ni = 0; ni < 2; ++ni) {
                        const size_t o = rbase + (size_t)(mi * 32 + (i & 3) + 8 * (i >> 2)) * 1024 + ni * 32;
                        const float gt = sigmoidf_(acc[mi][ni][i] * rsv[mi][i]);
                        const float e = ev[mi][ni][i] * rev[mi][i] * (ni ? eg1 : eg0);
                        const float hv = ov[mi][ni][i] + scale * gt * e;
                        P.out[o] = hv;
                        if (hb_out) hb_out[o] = f2bf(hv);
                        sq += hv * hv;
                    }
                    sqv[mi][i] = sq;
                }
            if (ss_out) {
#pragma unroll
                for (int mi = 0; mi < 2; ++mi)
#pragma unroll
                    for (int i = 0; i < 16; ++i) {
                        const float s = red32(sqv[mi][i]);
                        if (r == 0) atomicAdd(ss_out + (m0 + wm * 64 + mi * 32 + crow(i, hh)), ss_fix(s));
                    }
            }
        }
    };

    auto ph_6 = [&](bool dry) __attribute__((always_inline)) { if (!dry) resid_gemm(HB0, 1024, (const u16*)(ws + O_WABOUT), 1024, P.x, HB1, SS + 1 * MT, 1.f); else resid_gemm(HB0, 1024, (const u16*)(ws + O_WABOUT), 1024, P.out, (u16*)nullptr, (u64*)nullptr, 0.f); };
    auto ph_7 = [&](bool dry) __attribute__((always_inline)) { ffn_up_phase(0, HB1, SS + 1 * MT, SS + 6 * MT, !dry); };
    auto ph_8 = [&](bool dry) __attribute__((always_inline)) { if (!dry) resid_gemm((const u16*)(ws + O_ACT), 2816, (const u16*)(ws + O_WDOWN), 2816, P.out, HB0, SS + 2 * MT, 1.f); else resid_gemm((const u16*)(ws + O_ACT), 2816, (const u16*)(ws + O_WDOWN), 2816, P.out, (u16*)nullptr, (u64*)nullptr, 0.f); };
    auto ph_9 = [&](bool dry) __attribute__((always_inline)) { if (!dry) gate_phase(0, HB0, SS + 2 * MT, SS + 6 * MT, HB1, SS + 3 * MT, 1.f); else gate_phase(0, HB0, SS + 2 * MT, SS + 6 * MT, (u16*)nullptr, (u64*)nullptr, 0.f); };

    auto ph_10 = [&]() __attribute__((always_inline)) {
        const u16* Wt = (const u16*)(ws + O_WNSAIN);
        u16* QN = (u16*)(ws + O_QN); u16* KCVC = (u16*)(ws + O_KCVC); u16* KSN = (u16*)(ws + O_KSN); u16* KWN = (u16*)(ws + O_KWN);
        u16* VST = (u16*)(ws + O_VST); u16* VWT = (u16*)(ws + O_VWT); float* GT1 = (float*)(ws + O_GT1);
        const u64* ssin = SS + 3 * MT;
        for (int tile = blk; tile < tile_bound(128, 15); tile += nblk) {
            int mt, nt; if (!tile_decode(tile, 128, 15, mt, nt)) continue;
            const int m0 = mt * 128, n0 = nt * 128;
            f32x16 acc[2][2];
            const u16* Ab = HB1 + (size_t)m0 * DM;
            gemm_main<false>(acc, [&](int row) { return Ab + (size_t)row * DM; }, 1, Wt, 1024, n0, 1024, As, Bs);
            const int colw = n0 + wn * 64;
            float rsv[2][16];
#pragma unroll
            for (int mi = 0; mi < 2; ++mi)
#pragma unroll
                for (int i = 0; i < 16; ++i) rsv[mi][i] = ss_rstd(ssin[m0 + wm * 64 + mi * 32 + crow(i, hh)]);
#pragma unroll
            for (int mi = 0; mi < 2; ++mi) {
#pragma unroll
                for (int i4 = 0; i4 < 4; ++i4) {
                    float v0[4], v1[4];
                    const int rowb = m0 + wm * 64 + mi * 32 + 8 * i4 + 4 * hh;
#pragma unroll
                    for (int j = 0; j < 4; ++j) {
                        const float rs = rsv[mi][i4 * 4 + j];
                        v0[j] = acc[mi][0][i4 * 4 + j] * rs;
                        v1[j] = acc[mi][1][i4 * 4 + j] * rs;
                    }
                    const int bb = rowb >> 12, t = rowb & 4095;
                    if (nt < 8 || nt == 10 || nt == 12) {
                        const float* gn = (nt < 8) ? P.nsa_q_norm_g : (nt == 10 ? P.nsa_k_norm_g + 64 : P.nsa_k_norm_g + 128);
                        const float g0 = gn[r], g1 = gn[32 + r];
                        const float sc = (nt < 8) ? 0.125f * 1.4426950408889634f : 1.f;
#pragma unroll
                        for (int j = 0; j < 4; ++j) {
                            const float ss = red32(v0[j] * v0[j] + v1[j] * v1[j]);
                            const float rn = rsqrtf(ss * (1.f / 64.f) + EPS) * sc;
                            const u16 y0 = f2bf(v0[j] * rn * g0), y1 = f2bf(v1[j] * rn * g1);
                            if (nt < 8) { QN[(size_t)(rowb + j) * 1024 + colw + r] = y0; QN[(size_t)(rowb + j) * 1024 + colw + 32 + r] = y1; }
                            else {
                                u16* dst = (nt == 10) ? KSN : KWN;
                                dst[(size_t)(rowb + j) * 128 + wn * 64 + r] = y0; dst[(size_t)(rowb + j) * 128 + wn * 64 + 32 + r] = y1;
                            }
                        }
                    } else if (nt == 8 || nt == 9) {
                        const int cc = (nt - 8) * 128 + wn * 64;
#pragma unroll
                        for (int j = 0; j < 4; ++j) {
                            KCVC[(size_t)(rowb + j) * 256 + cc + r] = f2bf(v0[j]);
                            KCVC[(size_t)(rowb + j) * 256 + cc + 32 + r] = f2bf(v1[j]);
                        }
                    } else if (nt == 11 || nt == 13) {
                        u16* dst = (nt == 11) ? VST : VWT;
                        u32x2 o0 = {pk2(v0[0], v0[1]), pk2(v0[2], v0[3])}, o1 = {pk2(v1[0], v1[1]), pk2(v1[2], v1[3])};
                        *(u32x2*)(dst + ((size_t)(bb * 128 + wn * 64 + r)) * 4096 + t) = o0;
                        *(u32x2*)(dst + ((size_t)(bb * 128 + wn * 64 + 32 + r)) * 4096 + t) = o1;
                    } else {
                        if (wn == 0) {
#pragma unroll
                            for (int j = 0; j < 4; ++j) {
                                GT1[(size_t)(rowb + j) * 48 + r] = sigmoidf_(v0[j] + P.nsa_gate_b[r]);
                                if (r < 16) GT1[(size_t)(rowb + j) * 48 + 32 + r] = sigmoidf_(v1[j] + P.nsa_gate_b[32 + r]);
                            }
                        }
                    }
                }
            }
        }
    };

    auto ph_11 = [&]() __attribute__((always_inline)) {
        const u16* KCVC = (const u16*)(ws + O_KCVC);
        u16* HID = (u16*)(ws + O_HID);
        const float* B1 = (const float*)(ws + O_BIAS1);
        for (int tile = RB(5, blk, nblk); tile < 64; tile += RS(5, nblk)) {
            const int kv = tile >> 5, mt = (tile >> 1) & 15, nt = tile & 1, m0 = mt * 128, n0 = nt * 128;
            const u16* Wt = (const u16*)(ws + (kv ? O_WC1V : O_WC1K));
            f32x16 acc[2][2];
            gemm_main<false>(acc, [&](int row) {
                int R = m0 + row; R = R > 2039 ? 2039 : R;
                const int bg = R / 255, n = R - bg * 255, b = bg >> 1, g = bg & 1;
                return KCVC + ((size_t)b * 4096 + 16 * n) * 256 + kv * 128 + g * 64;
            }, 4, Wt, 2048, n0, 2048, As, Bs);
#pragma unroll
            for (int mi = 0; mi < 2; ++mi)
#pragma unroll
                for (int i = 0; i < 16; ++i) {
                    const int R = m0 + wm * 64 + mi * 32 + crow(i, hh);
#pragma unroll
                    for (int ni = 0; ni < 2; ++ni) {
                        const int col = n0 + wn * 64 + ni * 32 + r;
                        if (R < 2040) HID[((size_t)kv * 2048 + R) * 256 + col] = f2bf(gelu_tanh(acc[mi][ni][i] + B1[kv * 256 + col]));
                    }
                }
        }
    };

    auto ph_12 = [&]() __attribute__((always_inline)) {
        const u16* HID = (const u16*)(ws + O_HID);
        u16* KCN = (u16*)(ws + O_KCN);
        u16* VCT = (u16*)(ws + O_VCT);
        for (int tile = RB(6, blk, nblk); tile < 32; tile += RS(6, nblk)) {
            const int kv = tile >> 4, mt = tile & 15, m0 = mt * 128;
            const u16* Wt = (const u16*)(ws + (kv ? O_WC2V : O_WC2K));
            const u16* Ab = HID + ((size_t)kv * 2048 + m0) * 256;
            f32x16 acc[2][2];
            gemm_main<false>(acc, [&](int row) { return Ab + (size_t)row * 256; }, 1, Wt, 256, 0, 256, As, Bs);
            if (wn == 0) {
#pragma unroll
                for (int mi = 0; mi < 2; ++mi)
#pragma unroll
                    for (int i = 0; i < 16; ++i) {
                        const int R = m0 + wm * 64 + mi * 32 + crow(i, hh);
                        const float v0 = acc[mi][0][i], v1 = acc[mi][1][i];
                        const float ss = red32(v0 * v0 + v1 * v1);
                        if (R < 2040) {
                            const int bg = R / 255, n = R - bg * 255;
                            if (kv == 0) {
                                const float rn = rsqrtf(ss * (1.f / 64.f) + EPS);
                                KCN[((size_t)bg * 256 + n) * 64 + r] = f2bf(v0 * rn * P.nsa_k_norm_g[r]);
                                KCN[((size_t)bg * 256 + n) * 64 + 32 + r] = f2bf(v1 * rn * P.nsa_k_norm_g[32 + r]);
                            } else {
                                VCT[((size_t)bg * 64 + r) * 256 + n] = f2bf(v0);
                                VCT[((size_t)bg * 64 + 32 + r) * 256 + n] = f2bf(v1);
                            }
                        }
                    }
            }
        }
        for (int u = gtid; u < 8 * 64; u += gsz) { KCN[((size_t)(u >> 6) * 256 + 255) * 64 + (u & 63)] = 0; VCT[((size_t)u) * 256 + 255] = 0; }
    };

    auto ph_13 = [&]() __attribute__((always_inline)) {
        const u16* QN = (const u16*)(ws + O_QN);
        const u16* KCN = (const u16*)(ws + O_KCN);
        const u16* VCT = (const u16*)(ws + O_VCT);
        const float* GT1 = (const float*)(ws + O_GT1);
        u16* OCMP = (u16*)(ws + O_OCMP);
        u64* SEL = (u64*)(ws + O_SEL);
        float* sc_lds = (float*)smem + wave * (32 * 65);
        float mbound4;
        {
            float gq = fabsf(P.nsa_q_norm_g[lane]), gk = fabsf(P.nsa_k_norm_g[lane]);
#pragma unroll
            for (int off = 1; off < 64; off <<= 1) { gq = fmaxf(gq, __shfl_xor(gq, off)); gk = fmaxf(gk, __shfl_xor(gk, off)); }
            mbound4 = 8.f * 1.4426950408889634f * gq * gk * 1.02f;
        }
        for (int u0 = blk * 4; u0 < 1024; u0 += nblk * 4) {
            const int u = u0 + wave;
            const int qt = u & 127, bg = u >> 7, b = bg >> 1, g = bg & 1, tq = qt * 32, t = tq + r;
            const size_t row = (size_t)b * 4096 + t;
            const int nkt = (tq >> 9) + 1;
            u16* kl = (u16*)smem;
            u16* vl = kl + 256 * 72;
            __syncthreads();
#pragma unroll
            for (int c8 = 0; c8 < 8; ++c8) {
                const int c = tid + 256 * c8;
                *(u32x4*)(kl + (c >> 3) * 72 + (c & 7) * 8) = *(const u32x4*)(KCN + ((size_t)bg * 256 + (c >> 3)) * 64 + (c & 7) * 8);
                *(u32x4*)(vl + (c >> 5) * 264 + (c & 31) * 8) = *(const u32x4*)(VCT + ((size_t)bg * 64 + (c >> 5)) * 256 + (c & 31) * 8);
            }
            __syncthreads();
            f32x16 imp[2];
            imp[0] = zero16(); imp[1] = zero16();
            for (int hg = 0; hg < 8; ++hg) {
                const int head = g * 8 + hg;
                bf16x8 bq[4];
#pragma unroll
                for (int st = 0; st < 4; ++st) bq[st] = ld16(QN + row * 1024 + head * 64 + 16 * st + 8 * hh);
                f32x16 ao[2], ih[2];
                ao[0] = zero16(); ao[1] = zero16(); ih[0] = zero16(); ih[1] = zero16();
                float l = 0.f;
                for (int kt = 0; kt < nkt; ++kt) {
                    f32x16 s = zero16();
#pragma unroll
                    for (int st = 0; st < 4; ++st) s = MFMA(ld16(kl + (kt * 32 + r) * 72 + 16 * st + 8 * hh), bq[st], s);
#pragma unroll
                    for (int i = 0; i < 16; ++i) {
                        const int n = kt * 32 + crow(i, hh);
                        s[i] = (16 * n + 31 > t) ? 0.f : __builtin_amdgcn_exp2f(s[i] - mbound4);
                        l += s[i];
                    }
#pragma unroll
                    for (int s2 = 0; s2 < 2; ++s2) {
                        const bf16x8 pb = packp(s, s2);
#pragma unroll
                        for (int dt = 0; dt < 2; ++dt) {
                            const u16* vp = vl + (dt * 32 + r) * 264 + kt * 32 + 16 * s2 + 4 * hh;
                            ao[dt] = MFMA(ld8x2(vp, vp + 8), pb, ao[dt]);
                        }
#pragma unroll
                        for (int bt = 0; bt < 2; ++bt) {
                            const int sb = bt * 32 + r;
                            bf16x8 ov;
#pragma unroll
                            for (int j = 0; j < 8; ++j) {
                                const int n = kt * 32 + 16 * s2 + 8 * (j >> 2) + 4 * hh + (j & 3);
                                ov[j] = (n >= 4 * sb - 1 && n <= 4 * sb + 3) ? (short)0x3F80 : (short)0;
                            }
                            ih[bt] = MFMA(ov, pb, ih[bt]);
                        }
                    }
                }
                l += __shfl_xor(l, 32);
                const float inv = (t >= 31) ? 1.f / l : 0.f;
#pragma unroll
                for (int bt = 0; bt < 2; ++bt)
#pragma unroll
                    for (int i = 0; i < 16; ++i) imp[bt][i] += ih[bt][i] * inv;
                const float g0 = GT1[row * 48 + head * 3 + 0] * inv;
#pragma unroll
                for (int dt = 0; dt < 2; ++dt)
#pragma unroll
                    for (int i4 = 0; i4 < 4; ++i4) {
                        const int d = dt * 32 + 8 * i4 + 4 * hh;
                        u32x2 ov = {pk2(ao[dt][i4 * 4 + 0] * g0, ao[dt][i4 * 4 + 1] * g0), pk2(ao[dt][i4 * 4 + 2] * g0, ao[dt][i4 * 4 + 3] * g0)};
                        *(u32x2*)(OCMP + row * 1024 + head * 64 + d) = ov;
                    }
            }
            const int cur = t >> 6;
            __syncthreads();
#pragma unroll
            for (int bt = 0; bt < 2; ++bt)
#pragma unroll
                for (int i = 0; i < 16; ++i) {
                    const int sb = bt * 32 + crow(i, hh);
                    const bool forced = (sb == 0) || (sb == cur) || (sb == cur - 1);
                    const float sc = forced ? 1e30f : (sb <= cur ? imp[bt][i] : -1e30f);
                    sc_lds[r * 65 + sb] = sc;
                }
            __syncthreads();
            for (int q = 0; q < 32; ++q) {
                const float v = sc_lds[q * 65 + lane];
                int cnt = 0;
                for (int sp = 0; sp < 64; ++sp) {
                    const float c = __shfl(v, sp);
                    cnt += ((c > v) || (c == v && sp < lane)) ? 1 : 0;
                }
                const u64 mask = __ballot(cnt < 16);
                if (lane == 0) SEL[(size_t)bg * 4096 + tq + q] = mask;
            }
        }
        __syncthreads();
    };

    auto ph_14 = [&]() __attribute__((always_inline)) {
        const u16* QN = (const u16*)(ws + O_QN);
        const u16* KSN = (const u16*)(ws + O_KSN); const u16* KWN = (const u16*)(ws + O_KWN);
        const u16* VST = (const u16*)(ws + O_VST); const u16* VWT = (const u16*)(ws + O_VWT);
        const float* GT1 = (const float*)(ws + O_GT1);
        const u16* OCMP = (const u16*)(ws + O_OCMP);
        const u64* SEL = (const u64*)(ws + O_SEL);
        u16* OBUF = (u16*)(ws + O_OBUF);
        constexpr int KST = 72, VSTR = 40, BUFEL = 32 * KST + 64 * VSTR;
        float mbound;
        {
            float gq = fabsf(P.nsa_q_norm_g[lane]);
            float gk = fmaxf(fabsf(P.nsa_k_norm_g[64 + lane]), fabsf(P.nsa_k_norm_g[128 + lane]));
#pragma unroll
            for (int off = 1; off < 64; off <<= 1) { gq = fmaxf(gq, __shfl_xor(gq, off)); gk = fmaxf(gk, __shfl_xor(gk, off)); }
            mbound = 8.f * 1.4426950408889634f * gq * gk * 1.02f;
        }
        f32x16 negm;
#pragma unroll
        for (int i = 0; i < 16; ++i) negm[i] = -mbound;
        u16* stage = (u16*)smem;
        int* tl = (int*)(stage + 2 * BUFEL);
        for (int item = blk; item < 1024; item += nblk) {
            const int kk = item / nblk, v = item - kk * nblk;
            const int q0 = v & 127, bg = (nblk == 256) ? ((v >> 7) * 4 + kk) : (item >> 7);
            const int qt = (nblk == 256) ? ((kk & 1) ? 127 - q0 : q0) : (item & 127);
            const int b = bg >> 1, g = bg & 1, tq = qt * 32, t = tq + r;
            const size_t rowb = (size_t)b * 4096, row = rowb + t;
            const int h0 = g * 8 + wave * 2;
            bf16x8 bq[2][4];
#pragma unroll
            for (int hd = 0; hd < 2; ++hd)
#pragma unroll
                for (int st = 0; st < 4; ++st) bq[hd][st] = ld16(QN + row * 1024 + (h0 + hd) * 64 + 16 * st + 8 * hh);
            const u64 selm = SEL[(size_t)bg * 4096 + t];
            unsigned ulo = (unsigned)selm, uhi = (unsigned)(selm >> 32);
#pragma unroll
            for (int off = 1; off < 32; off <<= 1) { ulo |= __shfl_xor(ulo, off); uhi |= __shfl_xor(uhi, off); }
            const u64 uni = ((u64)uhi << 32) | ulo;
            __syncthreads();
            if (tid == 0) {
                int n = 0;
                for (int kt = (qt > 16 ? qt - 16 : 0); kt <= qt; ++kt) tl[n++] = kt | (1 << 16);
                const int jmax = (tq + 31) >> 6;
                for (int j = 0; j <= jmax; ++j)
                    if ((uni >> j) & 1ull) { tl[n++] = 2 * j; if ((2 * j + 1) * 32 <= tq + 31) tl[n++] = 2 * j + 1; }
                tl[159] = n;
            }
            __syncthreads();
            const int ntile = tl[159];
            u32x4 kr[3], vr[3];
            auto ldt = [&](u32x4& kreg, u32x4& vreg, int e) __attribute__((always_inline)) {
                const int kt = e & 0xffff, br = e >> 16;
                const u16* Kp = br ? KWN : KSN;
                const u16* Vp = br ? VWT : VST;
                kreg = *(const u32x4*)(Kp + (rowb + kt * 32 + (tid >> 3)) * 128 + g * 64 + (tid & 7) * 8);
                vreg = *(const u32x4*)(Vp + ((size_t)(b * 128 + g * 64 + (tid >> 2))) * 4096 + kt * 32 + (tid & 3) * 8);
            };
            auto stt = [&](const u32x4& kreg, const u32x4& vreg, int p) __attribute__((always_inline)) {
                u16* kb = stage + p * BUFEL;
                *(u32x4*)(kb + (tid >> 3) * KST + (tid & 7) * 8) = kreg;
                *(u32x4*)(kb + 32 * KST + (tid >> 2) * VSTR + (tid & 3) * 8) = vreg;
            };
            f32x16 res[2][2], ao[2][2];
#pragma unroll
            for (int hd = 0; hd < 2; ++hd)
#pragma unroll
                for (int dt = 0; dt < 2; ++dt) { res[hd][dt] = zero16(); ao[hd][dt] = zero16(); }
            float l[2] = {0.f, 0.f};
            int curbr = 1;
            auto finalize = [&](int br) __attribute__((always_inline)) {
#pragma unroll
                for (int hd = 0; hd < 2; ++hd) {
                    const float lt = l[hd] + __shfl_xor(l[hd], 32);
                    const float gsc = GT1[row * 48 + (h0 + hd) * 3 + 1 + br] / lt;
#pragma unroll
                    for (int dt = 0; dt < 2; ++dt)
#pragma unroll
                        for (int i = 0; i < 16; ++i) { res[hd][dt][i] += ao[hd][dt][i] * gsc; ao[hd][dt][i] = 0.f; }
                    l[hd] = 0.f;
                }
            };
            ldt(kr[0], vr[0], tl[0]);
            if (1 < ntile) ldt(kr[1], vr[1], tl[1]);
            if (2 < ntile) ldt(kr[2], vr[2], tl[2]);
            stt(kr[0], vr[0], 0);
            if (3 < ntile) ldt(kr[0], vr[0], tl[3]);
            __syncthreads();
            for (int it0 = 0; it0 < ntile; it0 += 6) {
#pragma unroll
            for (int uu = 0; uu < 6; ++uu) {
                const int it = it0 + uu;
                if (it < ntile) {
                const int e = tl[it], kt = e & 0xffff, br = e >> 16, p = uu & 1;
                if (br != curbr) { finalize(curbr); curbr = br; }
                const u16* kb = stage + p * BUFEL;
                const u16* vb = kb + 32 * KST;
                f32x16 s[2];
                s[0] = negm; s[1] = negm;
#pragma unroll
                for (int st = 0; st < 4; ++st) {
                    const bf16x8 a = *(const bf16x8*)(kb + r * KST + 16 * st + 8 * hh);
                    s[0] = MFMA(a, bq[0][st], s[0]);
                    s[1] = MFMA(a, bq[1][st], s[1]);
                }
                const bool bsel = br ? true : (((selm >> (kt >> 1)) & 1ull) != 0);
                const bool interior = (kt * 32 + 31 <= tq) && (!br || kt * 32 >= tq - 480);
                const bool needmask = !interior || (__ballot(!bsel) != 0ull);
                if (needmask) {
                    if (interior) {
#pragma unroll
                        for (int i = 0; i < 16; ++i) { s[0][i] = bsel ? s[0][i] : -1e30f; s[1][i] = bsel ? s[1][i] : -1e30f; }
                    } else {
#pragma unroll
                        for (int i = 0; i < 16; ++i) {
                            const int pk = kt * 32 + crow(i, hh);
                            bool ok = bsel && (pk <= t);
                            if (br) ok = ok && (pk > t - 512);
                            if (!ok) { s[0][i] = -1e30f; s[1][i] = -1e30f; }
                        }
                    }
                }
#pragma unroll
                for (int hd = 0; hd < 2; ++hd) {
                    float ps = 0.f;
#pragma unroll
                    for (int i = 0; i < 16; ++i) { s[hd][i] = __builtin_amdgcn_exp2f(s[hd][i]); ps += s[hd][i]; }
                    l[hd] += ps;
                }
#pragma unroll
                for (int s2 = 0; s2 < 2; ++s2) {
                    const bf16x8 pb0 = packp(s[0], s2), pb1 = packp(s[1], s2);
#pragma unroll
                    for (int dt = 0; dt < 2; ++dt) {
                        const u16* vp = vb + (dt * 32 + r) * VSTR + 16 * s2 + 4 * hh;
                        const bf16x8 av = ld8x2(vp, vp + 8);
                        ao[0][dt] = MFMA(av, pb0, ao[0][dt]);
                        ao[1][dt] = MFMA(av, pb1, ao[1][dt]);
                    }
                }
                if (it + 1 < ntile) {
                    stt(kr[(uu + 1) % 3], vr[(uu + 1) % 3], p ^ 1);
                    if (it + 4 < ntile) ldt(kr[(uu + 1) % 3], vr[(uu + 1) % 3], tl[it + 4]);
                }
                __syncthreads();
                }
            }
            }
            finalize(curbr);
#pragma unroll
            for (int hd = 0; hd < 2; ++hd)
#pragma unroll
                for (int dt = 0; dt < 2; ++dt)
#pragma unroll
                    for (int i4 = 0; i4 < 4; ++i4) {
                        const int d = dt * 32 + 8 * i4 + 4 * hh;
                        const u32x2 oc = *(const u32x2*)(OCMP + row * 1024 + (h0 + hd) * 64 + d);
                        u32x2 ov = {pk2(res[hd][dt][i4 * 4 + 0] + bflo(oc.x), res[hd][dt][i4 * 4 + 1] + bfhi(oc.x)),
                                    pk2(res[hd][dt][i4 * 4 + 2] + bflo(oc.y), res[hd][dt][i4 * 4 + 3] + bfhi(oc.y))};
                        *(u32x2*)(OBUF + row * 1024 + (h0 + hd) * 64 + d) = ov;
                    }
        }
        __syncthreads();
    };

    auto ph_15 = [&](bool dry) __attribute__((always_inline)) { if (!dry) resid_gemm((const u16*)(ws + O_OBUF), 1024, (const u16*)(ws + O_WNSAOUT), 1024, P.out, HB0, SS + 4 * MT, 1.f); else resid_gemm((const u16*)(ws + O_OBUF), 1024, (const u16*)(ws + O_WNSAOUT), 1024, P.out, (u16*)nullptr, (u64*)nullptr, 0.f); };
    auto ph_16 = [&](bool dry) __attribute__((always_inline)) { ffn_up_phase(1, HB0, SS + 4 * MT, SS + 7 * MT, !dry); };
    auto ph_17 = [&](bool dry) __attribute__((always_inline)) { if (!dry) resid_gemm((const u16*)(ws + O_ACT), 2816, (const u16*)(ws + O_WDOWN + SZ_WDOWN), 2816, P.out, HB1, SS + 5 * MT, 1.f); else resid_gemm((const u16*)(ws + O_ACT), 2816, (const u16*)(ws + O_WDOWN + SZ_WDOWN), 2816, P.out, (u16*)nullptr, (u64*)nullptr, 0.f); };
    auto ph_18 = [&](bool dry) __attribute__((always_inline)) { gate_phase(1, HB1, SS + 5 * MT, SS + 7 * MT, (u16*)nullptr, (u64*)nullptr, dry ? 0.f : 1.f); };
#define RUNA(k) do { if (PH(k)) ph_##k(); GSYNC(); if ((DUPMASK >> (k)) & 1) { ph_##k(); GSYNC(); } } while (0)
#define RUNB(k) do { if (PH(k)) ph_##k(false); GSYNC(); if ((DUPMASK >> (k)) & 1) { ph_##k(true); GSYNC(); } } while (0)
    RUNA(0); RUNA(1); RUNA(2); RUNA(3); RUNA(4); RUNA(5);
    RUNB(6); RUNB(7); RUNB(8); RUNB(9);
    RUNA(10); RUNA(11); RUNA(12); RUNA(13); RUNA(14);
    RUNB(15); RUNB(16); RUNB(17);
    if (PH(18)) ph_18(false);
    if ((DUPMASK >> 18) & 1) { GSYNC(); ph_18(true); }
}

extern "C" void kernel_launch(void* const* d_in, const int* in_sizes, int n_in, void* d_out, int out_size, void* d_ws, size_t ws_size, hipStream_t stream) {
    static int grid_blocks = 0;
    if (grid_blocks == 0) {
        if (n_in != 32 || out_size != MT * DM || ws_size < WS_NEED) {
            fprintf(stderr, "kernel_launch: unexpected problem (n_in %d, out %d, ws %zu)\n", n_in, out_size, ws_size);
            grid_blocks = -1;
            return;
        }
        int dev = 0, cus = 0, per_cu = 0;
        (void)hipGetDevice(&dev);
        (void)hipDeviceGetAttribute(&cus, hipDeviceAttributeMultiprocessorCount, dev);
        (void)hipOccupancyMaxActiveBlocksPerMultiprocessor(&per_cu, fwd_megakernel, 256, 0);
        if (per_cu < 1) per_cu = 1;
        if (per_cu > 1) per_cu = 1;
        grid_blocks = cus * per_cu;
    }
    if (grid_blocks < 0) return;
    Params p{};
    const float** pp = (const float**)&p;
    for (int i = 0; i < 32; ++i) pp[i] = (const float*)d_in[i];
    p.out = (float*)d_out;
    p.ws = (char*)d_ws;
    (void)hipMemsetAsync((char*)d_ws + O_BAR, 0, 16384, stream);
    void* args[] = {&p};
    hipError_t e = hipLaunchCooperativeKernel((void*)fwd_megakernel, dim3(grid_blocks), dim3(256), args, 0, stream);
    if (e != hipSuccess) fprintf(stderr, "cooperative launch failed: %s (grid %d)\n", hipGetErrorString(e), grid_blocks);
}
```
